# Optimizing an MI355X kernel written in HIP

```python
import jax, jax.numpy as jnp
from jax import lax
import numpy as np

D_MODEL = 1024
BATCH = 16
SEQ = 4096
DEPTH = 4

GRID_W = 64
CTX_LEN = 256
CHUNK = 128
DA = 2 * D_MODEL
GA = 16
HEAD_DIM = 64
N_HEADS = D_MODEL // HEAD_DIM
N_KV_HEADS = N_HEADS // 4
Q_PER_KV = N_HEADS // N_KV_HEADS
WINDOW = 128
BLOCK = 128
ROPE_THETA = 10000.0
ROPE_PAIRS_PER_AXIS = HEAD_DIM // 4
N_EXPERTS = 16
CAPACITY_FACTOR = 2
D_FF_EXPERT = 2 * D_MODEL
EPS = 1e-6
N_A_LAYERS = (DEPTH + 1) // 2
N_B_LAYERS = DEPTH // 2

kernel_name = "hybrid_gmlp_swa_ecmoe_dit"


def rmsnorm(x, g):
    xf = x.astype(jnp.float32)
    y = xf * lax.rsqrt(jnp.mean(xf * xf, axis=-1, keepdims=True) + EPS)
    return (y * g.astype(jnp.float32)).astype(x.dtype)


def layernorm(x, g, b):
    xf = x.astype(jnp.float32)
    mu = jnp.mean(xf, axis=-1, keepdims=True)
    var = jnp.mean(jnp.square(xf - mu), axis=-1, keepdims=True)
    y = (xf - mu) * lax.rsqrt(var + EPS)
    return (y * g.astype(jnp.float32) + b.astype(jnp.float32)).astype(x.dtype)


def axial_rope(x, cos, sin):
    half = x.shape[-1] // 2
    shp = (x.shape[1],) + (1,) * (x.ndim - 3) + (half,)
    cs = cos.reshape(shp)
    sn = sin.reshape(shp)
    x1, x2 = x[..., :half], x[..., half:]
    return jnp.concatenate([x1 * cs - x2 * sn, x1 * sn + x2 * cs], axis=-1)


def chunk_gmlp(h, w_in, b_in, ln_g, ln_b, w_s, b_s, w_out):
    B, N, _ = h.shape
    z = jax.nn.gelu(h @ w_in + b_in)
    u, v = z[..., :DA], z[..., DA:]
    v = layernorm(v, ln_g, ln_b)
    vc = v.reshape(B, N // CHUNK, CHUNK, GA, DA // GA)
    sv = jnp.einsum('gpq,bnqgc->bnpgc', w_s, vc) + jnp.swapaxes(b_s, 0, 1)[None, None, :, :, None]
    return (u * sv.reshape(B, N, DA)) @ w_out


def _project_qkv(h, w_qkv):
    B, N, _ = h.shape
    qkv = h @ w_qkv
    nq = N_HEADS * HEAD_DIM
    nk = N_KV_HEADS * HEAD_DIM
    q = qkv[..., :nq].reshape(B, N, N_KV_HEADS, Q_PER_KV, HEAD_DIM)
    k = qkv[..., nq:nq + nk].reshape(B, N, N_KV_HEADS, HEAD_DIM)
    v = qkv[..., nq + nk:].reshape(B, N, N_KV_HEADS, HEAD_DIM)
    return q, k, v


def windowed_gqa(h_lat, h_ctx, w_qkv, sink, w_o, cos, sin, need_ctx_out):
    B, L, _ = h_lat.shape
    Lc = h_ctx.shape[1]
    dt = h_lat.dtype
    scale = HEAD_DIM ** -0.5
    q_l, k_l, v_l = _project_qkv(h_lat, w_qkv)
    q_c, k_c, v_c = _project_qkv(h_ctx, w_qkv)
    q_l = axial_rope(q_l, cos, sin) * scale
    k_l = axial_rope(k_l, cos, sin)
    sink_f = sink.astype(jnp.float32).reshape(N_KV_HEADS, Q_PER_KV)

    nb = L // BLOCK
    qb = q_l.reshape(B, nb, BLOCK, N_KV_HEADS, Q_PER_KV, HEAD_DIM)
    pad = ((0, 0), (BLOCK, BLOCK), (0, 0), (0, 0))
    kp = jnp.pad(k_l, pad).reshape(B, nb + 2, BLOCK, N_KV_HEADS, HEAD_DIM)
    vp = jnp.pad(v_l, pad).reshape(B, nb + 2, BLOCK, N_KV_HEADS, HEAD_DIM)
    kw = jnp.concatenate([kp[:, :-2], kp[:, 1:-1], kp[:, 2:]], axis=2)
    vw = jnp.concatenate([vp[:, :-2], vp[:, 1:-1], vp[:, 2:]], axis=2)
    iq = jnp.arange(BLOCK)[:, None]
    jk = jnp.arange(3 * BLOCK)[None, :]
    band = jnp.abs(jk - BLOCK - iq) <= WINDOW
    pos = jnp.arange(nb)[:, None] * BLOCK - BLOCK + jnp.arange(3 * BLOCK)[None, :]
    valid = (pos >= 0) & (pos < L)
    mask = (band[None] & valid[:, None, :])[None, :, None, None]
    s_w = jnp.einsum('bnqkgd,bnskd->bnkgqs', qb, kw).astype(jnp.float32)
    s_w = jnp.where(mask, s_w, -jnp.inf)
    s_c = jnp.einsum('bnqkgd,bskd->bnkgqs', qb, k_c).astype(jnp.float32)
    sk = sink_f[None, None, :, :, None, None]
    m = jnp.maximum(jnp.maximum(s_w.max(-1, keepdims=True), s_c.max(-1, keepdims=True)), sk)
    p_w = jnp.exp(s_w - m)
    p_c = jnp.exp(s_c - m)
    den = p_w.sum(-1, keepdims=True) + p_c.sum(-1, keepdims=True) + jnp.exp(sk - m)
    o = (jnp.einsum('bnkgqs,bnskd->bnqkgd', (p_w / den).astype(dt), vw)
         + jnp.einsum('bnkgqs,bskd->bnqkgd', (p_c / den).astype(dt), v_c))
    o_lat = o.reshape(B, L, N_HEADS * HEAD_DIM) @ w_o

    if not need_ctx_out:
        return o_lat, None
    s = jnp.einsum('bqkgd,bskd->bkgqs', q_c * scale, k_c).astype(jnp.float32)
    skc = sink_f[None, :, :, None, None]
    mc = jnp.maximum(s.max(-1, keepdims=True), skc)
    pc = jnp.exp(s - mc)
    pc = pc / (pc.sum(-1, keepdims=True) + jnp.exp(skc - mc))
    oc = jnp.einsum('bkgqs,bskd->bqkgd', pc.astype(dt), v_c)
    o_ctx = oc.reshape(B, Lc, N_HEADS * HEAD_DIM) @ w_o
    return o_lat, o_ctx


def expert_choice_ffn(h, w_r, w1, w3, w2):
    B, N, D = h.shape
    cap = (CAPACITY_FACTOR * N) // N_EXPERTS
    aff = jax.nn.softmax((h @ w_r).astype(jnp.float32), axis=-1)
    gates, idx = lax.top_k(jnp.swapaxes(aff, 1, 2), cap)
    xg = jax.vmap(lambda hb, ib: hb[ib])(h, idx)
    a = jnp.einsum('becd,edf->becf', xg, w1)
    b = jnp.einsum('becd,edf->becf', xg, w3)
    y = jnp.einsum('becf,efd->becd', jax.nn.silu(a) * b, w2) * gates[..., None].astype(h.dtype)
    return jax.vmap(lambda ib, yb: jnp.zeros((N, D), yb.dtype).at[ib.reshape(-1)].add(yb.reshape(-1, D)))(idx, y)


def setup_inputs(seed: int = 0) -> dict:
    key = jax.random.key(seed)
    ks = jax.random.split(key, 24)
    f32 = jnp.float32

    def nrm(k, shape, scale):
        return jax.random.normal(k, shape, f32) * scale

    D = D_MODEL
    qkv_w = (N_HEADS + 2 * N_KV_HEADS) * HEAD_DIM
    return {
        "x": nrm(ks[0], (BATCH, SEQ, D), 1.0),
        "c": nrm(ks[1], (BATCH, D), 1.0),
        "ctx": nrm(ks[2], (BATCH, CTX_LEN, D), 1.0),
        "c_ctx": nrm(ks[3], (D,), 1.0),
        "w_mod": nrm(ks[4], (DEPTH, D, 6 * D), 0.5 * D ** -0.5),
        "b_mod": nrm(ks[5], (DEPTH, 6 * D), 0.02),
        "g_norm_mix": 1.0 + nrm(ks[6], (DEPTH, D), 0.02),
        "g_norm_ffn": 1.0 + nrm(ks[7], (DEPTH, D), 0.02),
        "a_w_in": nrm(ks[8], (N_A_LAYERS, D, 2 * DA), D ** -0.5),
        "a_b_in": nrm(ks[9], (N_A_LAYERS, 2 * DA), 0.02),
        "a_ln_g": 1.0 + nrm(ks[10], (N_A_LAYERS, DA), 0.02),
        "a_ln_b": nrm(ks[11], (N_A_LAYERS, DA), 0.02),
        "a_w_s": nrm(ks[12], (N_A_LAYERS, GA, CHUNK, CHUNK), CHUNK ** -0.5),
        "a_b_s": 1.0 + nrm(ks[13], (N_A_LAYERS, GA, CHUNK), 0.02),
        "a_w_out": nrm(ks[14], (N_A_LAYERS, DA, D), DA ** -0.5),
        "b_w_qkv": nrm(ks[15], (N_B_LAYERS, D, qkv_w), D ** -0.5),
        "b_sink": nrm(ks[16], (N_B_LAYERS, N_HEADS), 0.5),
        "b_w_o": nrm(ks[17], (N_B_LAYERS, N_HEADS * HEAD_DIM, D), (N_HEADS * HEAD_DIM) ** -0.5),
        "r_w": nrm(ks[18], (DEPTH, D, N_EXPERTS), D ** -0.5),
        "e_w1": nrm(ks[19], (DEPTH, N_EXPERTS, D, D_FF_EXPERT), D ** -0.5),
        "e_w3": nrm(ks[20], (DEPTH, N_EXPERTS, D, D_FF_EXPERT), D ** -0.5),
        "e_w2": nrm(ks[21], (DEPTH, N_EXPERTS, D_FF_EXPERT, D), D_FF_EXPERT ** -0.5),
        "g_final": 1.0 + nrm(ks[22], (D,), 0.02),
    }


def reference(x, c, ctx, c_ctx, w_mod, b_mod, g_norm_mix, g_norm_ffn,
              a_w_in, a_b_in, a_ln_g, a_ln_b, a_w_s, a_b_s, a_w_out,
              b_w_qkv, b_sink, b_w_o, r_w, e_w1, e_w3, e_w2, g_final):
    L = x.shape[1]
    ROWS = L // GRID_W
    row = jnp.broadcast_to(jnp.arange(ROWS)[:, None], (ROWS, GRID_W)).reshape(-1).astype(jnp.float32)
    col = jnp.broadcast_to(jnp.arange(GRID_W)[None, :], (ROWS, GRID_W)).reshape(-1).astype(jnp.float32)
    inv_freq = ROPE_THETA ** (-jnp.arange(ROPE_PAIRS_PER_AXIS, dtype=jnp.float32) / ROPE_PAIRS_PER_AXIS)
    ang = jnp.concatenate([row[:, None] * inv_freq, col[:, None] * inv_freq], axis=-1)
    cos = jnp.cos(ang).astype(x.dtype)
    sin = jnp.sin(ang).astype(x.dtype)

    sc_lat = jax.nn.silu(c)
    sc_ctx = jax.nn.silu(c_ctx)
    xc = ctx
    for i in range(DEPTH):
        last = i == DEPTH - 1
        is_attn = i % 2 == 1
        j = i // 2
        mod_l = sc_lat @ w_mod[i] + b_mod[i]
        mod_c = sc_ctx @ w_mod[i] + b_mod[i]
        sh1, s1, g1, sh2, s2, g2 = jnp.split(mod_l[:, None, :], 6, axis=-1)
        csh1, cs1, cg1, csh2, cs2, cg2 = jnp.split(mod_c, 6, axis=-1)

        h_l = rmsnorm(x, g_norm_mix[i]) * (1.0 + s1) + sh1
        need_ctx_in = (not last) or is_attn
        h_c = rmsnorm(xc, g_norm_mix[i]) * (1.0 + cs1) + csh1 if need_ctx_in else None
        if is_attn:
            o_l, o_c = windowed_gqa(h_l, h_c, b_w_qkv[j], b_sink[j], b_w_o[j], cos, sin, not last)
        else:
            o_l = chunk_gmlp(h_l, a_w_in[j], a_b_in[j], a_ln_g[j], a_ln_b[j], a_w_s[j], a_b_s[j], a_w_out[j])
            o_c = (chunk_gmlp(h_c, a_w_in[j], a_b_in[j], a_ln_g[j], a_ln_b[j], a_w_s[j], a_b_s[j], a_w_out[j])
                   if not last else None)
        x = x + g1 * o_l

        f_l = rmsnorm(x, g_norm_ffn[i]) * (1.0 + s2) + sh2
        x = x + g2 * expert_choice_ffn(f_l, r_w[i], e_w1[i], e_w3[i], e_w2[i])
        if not last:
            xc = xc + cg1 * o_c
            f_c = rmsnorm(xc, g_norm_ffn[i]) * (1.0 + cs2) + csh2
            xc = xc + cg2 * expert_choice_ffn(f_c, r_w[i], e_w1[i], e_w3[i], e_w2[i])
    return rmsnorm(x, g_final)
```

```cpp
#include <hip/hip_runtime.h>
#include <cstdio>
#include <cstdint>

#define LAS __attribute__((address_space(3)))
#define GAS __attribute__((address_space(1)))
typedef unsigned short bf16_t;
typedef short bf16x8 __attribute__((ext_vector_type(8)));
typedef short s16x4 __attribute__((ext_vector_type(4)));
typedef float f32x4 __attribute__((ext_vector_type(4)));
typedef float f32x2 __attribute__((ext_vector_type(2)));
typedef float f32x16 __attribute__((ext_vector_type(16)));
typedef unsigned u32x4 __attribute__((ext_vector_type(4)));
typedef unsigned u32x2 __attribute__((ext_vector_type(2)));
typedef short v4i16_t __attribute__((ext_vector_type(4)));
#define DI __device__ __forceinline__

#ifndef MK_SPLIT
#define MK_SPLIT 0
#endif

constexpr int D = 1024, NB = 16, SEQ = 4096, CTX = 256, DEPTH = 4;
constexpr int ML = NB * SEQ, MC = NB * CTX, MT = ML + MC;
constexpr int DA = 2048, NE = 16, CAPL = 512, CAPC = 32;
constexpr int SLOTS_E = NB * CAPL + NB * CAPC;
constexpr int NSLOT = NE * SLOTS_E;
constexpr int DFF = 2048, NQKV = 1536;
constexpr float EPS = 1e-6f;
constexpr float LOG2E = 1.4426950408889634f;
constexpr float QSCALE = 0.125f * LOG2E;

constexpr size_t MiB = 1u << 20;
constexpr size_t WS_CTL = 0, CTL_ZERO_BYTES = 1 * MiB;
constexpr size_t WS_MOD = 1 * MiB;
constexpr size_t WS_ROPE = 3 * MiB;
constexpr size_t WS_AFF = 4 * MiB;
constexpr size_t WS_TOKSLOT = 9 * MiB;
constexpr size_t WS_ROWIDX = 14 * MiB;
constexpr size_t WS_GATE = 15 * MiB;
constexpr size_t WS_STATS = 16 * MiB;
constexpr size_t WS_XC = 34 * MiB;
constexpr size_t WS_WIN = 50 * MiB;
constexpr size_t WS_WOUT = 66 * MiB;
constexpr size_t WS_WQKV = 74 * MiB;
constexpr size_t WS_WO = 80 * MiB;
constexpr size_t WS_WSP = 84 * MiB;
constexpr size_t WS_W13 = 86 * MiB;
constexpr size_t WS_W2 = 598 * MiB;
constexpr size_t WS_H = 854 * MiB;
constexpr size_t WS_BIG = 990 * MiB;
constexpr size_t WS_Y = 1534 * MiB;
constexpr size_t WS_END = 1806 * MiB;
constexpr size_t BIG_U = 0, BIG_V = (size_t)MT * 2048 * 2;
constexpr size_t BIG_Q = 0, BIG_K = (size_t)MT * 1024 * 2, BIG_VV = BIG_K + (size_t)MT * 256 * 2, BIG_O = BIG_VV + (size_t)MT * 256 * 2;
static_assert(BIG_O + (size_t)MT * 1024 * 2 <= 544 * MiB && (size_t)NSLOT * 2048 * 2 <= 544 * MiB && BIG_V + (size_t)MT * 2048 * 2 <= 544 * MiB, "big region");
static_assert(WS_STATS + (size_t)MT * 64 * 4 <= WS_XC && WS_AFF + (size_t)MT * 64 <= WS_TOKSLOT && WS_TOKSLOT + (size_t)MT * 64 <= WS_ROWIDX, "ws map");
constexpr int CW_BAR = 4096;

constexpr int RING_BYTES = 131072;
constexpr int MISC_OFF = RING_BYTES + 320;
constexpr int LDS_BYTES = 147456;

DI unsigned pk2(float lo, float hi) { unsigned r; asm("v_cvt_pk_bf16_f32 %0, %1, %2" : "=v"(r) : "v"(lo), "v"(hi)); return r; }
DI float bflo(unsigned w) { return __uint_as_float(w << 16); }
DI float bfhi(unsigned w) { return __uint_as_float(w & 0xffff0000u); }
DI float wave_sum(float v) {
#pragma unroll
    for (int o = 1; o < 64; o <<= 1) v += __shfl_xor(v, o);
    return v;
}
DI int wave_sum_i(int v) {
#pragma unroll
    for (int o = 1; o < 64; o <<= 1) v += __shfl_xor(v, o);
    return v;
}
DI int tid_opaque() { int t = threadIdx.x; asm volatile("" : "+v"(t)); return t; }
#define LDS_WAIT() asm volatile("s_waitcnt lgkmcnt(0)" ::: "memory")
#define VM_WAIT() asm volatile("s_waitcnt vmcnt(0)" ::: "memory")
#define RLX_AGENT __ATOMIC_RELAXED, __HIP_MEMORY_SCOPE_AGENT

#define XB_TMO      128
#define XB_XCNT(j)  (256  + 64 * (j))
#define XB_XSUB(j)  (1280 + 64 * (j))
#define XB_XGEN(j)  (2304 + 64 * (j))
#define XB_TOP      3328
#define XB_TOPGEN   3392
#define XCD_BAR_WORDS 3456
#define XB_SPIN_CAP (1u << 18)
DI unsigned xb_ld(unsigned* p)              { return __hip_atomic_load(p, __ATOMIC_RELAXED, __HIP_MEMORY_SCOPE_AGENT); }
DI unsigned xb_add(unsigned* p, unsigned v) { return __hip_atomic_fetch_add(p, v, __ATOMIC_RELAXED, __HIP_MEMORY_SCOPE_AGENT); }
DI unsigned xb_xcc_id() { return (unsigned)__builtin_amdgcn_s_getreg((3 << 11) | 20) & 0xFu; }
#define XB_SPIN(cond, bar) do { unsigned _sp = 0; while (cond) { __builtin_amdgcn_s_sleep(1); \
    if ((++_sp & 255u) == 0u) { if (xb_ld(&(bar)[XB_TMO])) break; if (_sp > XB_SPIN_CAP) { atomicAdd(&(bar)[XB_TMO], 1u); break; } } } } while (0)
struct XcdBarrier { unsigned* bar; unsigned x; volatile LAS unsigned* st; };
DI XcdBarrier xcd_barrier_post(unsigned* bar, volatile LAS unsigned* st) {
    XcdBarrier b; b.bar = bar; b.x = (unsigned)__builtin_amdgcn_readfirstlane((int)xb_xcc_id()); b.st = st;
    if (threadIdx.x == 0) (void)xb_add(&bar[XB_XCNT(b.x)], 1u);
    return b;
}
DI void xcd_barrier_complete(unsigned* bar, unsigned x, unsigned& nloc, unsigned& nx) {
    const unsigned G = gridDim.x * gridDim.y * gridDim.z;
    unsigned sum, cnt, mine, sp = 0u;
    for (;;) {
        sum = 0u; cnt = 0u; mine = 0u;
#pragma unroll
        for (unsigned j = 0; j < 16; ++j) { const unsigned c = xb_ld(&bar[XB_XCNT(j)]); sum += c; cnt += (c > 0u) ? 1u : 0u; mine = (j == x) ? c : mine; }
        if (sum == G) break;
        __builtin_amdgcn_s_sleep(1);
        if ((++sp & 255u) == 0u) { if (xb_ld(&bar[XB_TMO])) break; if (sp > XB_SPIN_CAP) { atomicAdd(&bar[XB_TMO], 1u); break; } }
    }
    nloc = mine > 0u ? mine : 1u; nx = cnt > 0u ? cnt : 1u;
}
DI void xcd_barrier(const XcdBarrier& b) {
    asm volatile("s_waitcnt vmcnt(0)" ::: "memory");
    __syncthreads();
    if (threadIdx.x == 0) {
        unsigned* bar = b.bar;
        __builtin_amdgcn_s_waitcnt(0);
        unsigned bx = b.x; asm volatile("" : "+s"(bx));
        unsigned nloc = b.st[0], nx = b.st[1];
        if (nloc == 0u) { xcd_barrier_complete(bar, bx, nloc, nx); b.st[0] = nloc; b.st[1] = nx; }
        const unsigned old = xb_add(&bar[XB_XSUB(bx)], 1u);
        const unsigned gen = old / nloc;
        if (old + 1u == (gen + 1u) * nloc) {
            __builtin_amdgcn_fence(__ATOMIC_RELEASE, "agent");
            asm volatile("s_waitcnt vmcnt(0)" ::: "memory");
            const unsigned og = xb_add(&bar[XB_TOP], 1u);
            const unsigned tg = og / nx;
            if (og + 1u == (tg + 1u) * nx) xb_add(&bar[XB_TOPGEN], 1u);
            else XB_SPIN(xb_ld(&bar[XB_TOPGEN]) == tg, bar);
            __builtin_amdgcn_fence(__ATOMIC_ACQUIRE, "agent");
            xb_add(&bar[XB_XGEN(bx)], 1u);
            asm volatile("s_waitcnt vmcnt(0)" ::: "memory");
        } else {
            XB_SPIN(xb_ld(&bar[XB_XGEN(bx)]) == gen, bar);
            __builtin_amdgcn_fence(__ATOMIC_ACQUIRE, "agent");
            asm volatile("s_waitcnt vmcnt(0)" ::: "memory");
        }
    }
    __syncthreads();
}

namespace pg8 {
constexpr int BM = 256, BK = 64, HALF = 128, HTB = HALF * BK * 2, STAGE_BYTES = 8 * HTB, NXCD = 8, WGM = 8;
__host__ __device__ __forceinline__ int lds_byte(int r, int c) { const int st = (r >> 4) * 2 + (c >> 5), rr = r & 15, cc = c & 31, ob = rr * 64 + cc * 2; return st * 1024 + (ob ^ (((ob >> 9) & 1) << 5)); }
__host__ __device__ __forceinline__ void stage_rc(int b, int& R, int& C) { const int st = b / 1024, sb = b % 1024, swz = sb ^ (((sb >> 9) & 1) << 5); R = (st >> 1) * 16 + swz / 64; C = (st & 1) * 32 + (swz % 64) / 2; }
__host__ __device__ __forceinline__ int perm32(int rho) { const int n = rho >> 4, i = rho & 15; return 8 * (i >> 2) + 4 * n + (i & 3); }

struct Unit { int pm, pn, e; };
struct Gemm { const bf16_t* A; const bf16_t* Bt; const int* rowidx; };

template <int NN, int MSTRIDE>
struct GroupedOrder {
    int nM, nwg, G, c;
    __device__ void init(int nM_, int ngroups, int G_, int c_) { nM = nM_; nwg = nM_ * NN * ngroups; G = G_; c = c_; }
    __device__ bool next(int i, Unit& u) const {
        const int L = i * G + c; if (L >= nwg) return false;
        int wgid = L; { const int q = nwg / NXCD, r = nwg % NXCD, xcd = wgid % NXCD, off = wgid / NXCD; wgid = (xcd < r ? xcd * (q + 1) : r * (q + 1) + (xcd - r) * q) + off; }
        const int per = nM * NN, e = wgid / per, rr = wgid % per;
        constexpr int nig = WGM * NN; const int gid = rr / nig, fm = gid * WGM, gsz = (nM - fm) < WGM ? (nM - fm) : WGM;
        u.pm = e * MSTRIDE + fm + ((rr % nig) % gsz); u.pn = (rr % nig) / gsz; u.e = e; return true;
    }
};

DI unsigned cvt_pk_bf16(float lo, float hi) { unsigned r; asm volatile("v_cvt_pk_bf16_f32 %0, %1, %2" : "=v"(r) : "v"(lo), "v"(hi)); return r; }

template <class Epi, class Sched, bool GATHER, int K, size_t BSTRIDE>
DI void gemm_phase(LAS unsigned char* lds, const Gemm g, const Sched& S, const Epi& E) {
    const int tid = tid_opaque(), wid = __builtin_amdgcn_readfirstlane(tid >> 6), lane = tid & 63, wr = wid >> 2, wc = wid & 3, fr = lane & 15, fq = lane >> 4;
    constexpr int nt = K / BK;
    unsigned voffA[2], voffB[2];
#pragma unroll
    for (int i = 0; i < 2; ++i) { int R, C; stage_rc(tid * 16 + i * 8192, R, C); const int Rb = Epi::PERM ? ((R & ~31) + perm32(R & 31)) : R;
        voffA[i] = (unsigned)(R * K + C) * 2u; voffB[i] = (unsigned)(Rb * K + C) * 2u; }
    constexpr size_t kstep = (size_t)(BK * 2);
    constexpr size_t hstep = (size_t)HALF * K * 2;
    constexpr size_t tstep = 2 * hstep;
    const unsigned ldsw = (unsigned)wid * 1024u;
    const int aoff = lds_byte(wr * 64 + fr, fq * 8), boff = lds_byte(wc * 32 + fr, fq * 8);
#define PG8_SA(b, h) (((b) * 2 + (h)) * HTB)
#define PG8_SB(b, h) ((4 + (b) * 2 + (h)) * HTB)
#define PG8_STAGE(bufoff, gbase, voff) do { _Pragma("unroll") for (int _i = 0; _i < 2; ++_i) \
        __builtin_amdgcn_global_load_lds((const unsigned*)((const char*)(gbase) + (voff)[_i]), (LAS unsigned*)(lds + (bufoff) + ldsw + _i * 8192), 16, 0, 0); } while (0)
#define PG8_STAGE_AC(bufoff, kb, h) do { if constexpr (GATHER) PG8_STAGE(bufoff, Ab + (kb), cOff[h]); else PG8_STAGE(bufoff, cA + (h) * hstep + (kb), voffA); } while (0)
#define PG8_STAGE_AN(bufoff, kb, h) do { if constexpr (GATHER) { if (last) PG8_STAGE(bufoff, Ab + (kb), nOff[h]); else PG8_STAGE(bufoff, Ab + (kb), cOff[h]); } \
        else PG8_STAGE(bufoff, (last ? nA : cA) + (h) * hstep + (kb), voffA); } while (0)
#define PG8_LDA(dst, b, h) do { _Pragma("unroll") for (int m = 0; m < 4; ++m) _Pragma("unroll") for (int k = 0; k < 2; ++k) dst[m][k] = *(const LAS bf16x8*)(lds + PG8_SA(b, h) + aoff + m * 2048 + k * 1024); } while (0)
#define PG8_LDB(dst, b, h) do { _Pragma("unroll") for (int n = 0; n < 2; ++n) _Pragma("unroll") for (int k = 0; k < 2; ++k) dst[n][k] = *(const LAS bf16x8*)(lds + PG8_SB(b, h) + boff + n * 2048 + k * 1024); } while (0)
#define PG8_MMA(ai, bj, At, Bt) do { __builtin_amdgcn_s_setprio(1); _Pragma("unroll") for (int m = 0; m < 4; ++m) _Pragma("unroll") for (int n = 0; n < 2; ++n) _Pragma("unroll") for (int k = 0; k < 2; ++k) \
        acc[ai][bj][m][n] = __builtin_amdgcn_mfma_f32_16x16x32_bf16(Bt[n][k], At[m][k], acc[ai][bj][m][n], 0, 0, 0); __builtin_amdgcn_s_setprio(0); } while (0)
#define PG8_WAIT_V(n) asm volatile("s_waitcnt vmcnt(" #n ")" ::: "memory")
#define PG8_WAIT_L(n) asm volatile("s_waitcnt lgkmcnt(" #n ")" ::: "memory")
#define PG8_BAR __builtin_amdgcn_s_barrier()
#define PG8_SCHED __builtin_amdgcn_sched_barrier(0)
#define PG8_AOFF(dst, u) do { int _t = threadIdx.x; asm volatile("" : "+v"(_t)); _Pragma("unroll") for (int _h = 0; _h < 2; ++_h) _Pragma("unroll") for (int _i = 0; _i < 2; ++_i) { int _R, _C; stage_rc(_t * 16 + _i * 8192, _R, _C); \
        const int _row = g.rowidx[(u).pm * BM + _h * HALF + _R]; dst[_h][_i] = (unsigned)_row * (unsigned)(K * 2) + (unsigned)_C * 2u; } } while (0)
    Unit cur, nxt; int ui = 0;
    if (!S.next(0, cur)) return;
    f32x4 acc[2][2][4][2];
#pragma unroll
    for (int a = 0; a < 2; ++a)
#pragma unroll
        for (int b = 0; b < 2; ++b)
#pragma unroll
            for (int m = 0; m < 4; ++m)
#pragma unroll
                for (int n = 0; n < 2; ++n) acc[a][b][m][n] = (f32x4){0.f, 0.f, 0.f, 0.f};
    bf16x8 At[4][2], B0[2][2], B1[2][2];
    unsigned cOff[2][2], nOff[2][2];
    const char* Ab = (const char*)g.A;
    const char* cA = Ab; const char* nA = Ab;
    if constexpr (GATHER) { PG8_AOFF(cOff, cur); } else { cA = Ab + (size_t)cur.pm * tstep; }
    const char* cB = (const char*)g.Bt + (size_t)cur.e * BSTRIDE + (size_t)cur.pn * tstep;
    PG8_STAGE(PG8_SB(0, 0), cB, voffB); PG8_STAGE(PG8_SB(0, 1), cB + hstep, voffB); PG8_STAGE_AC(PG8_SA(0, 0), 0, 0); PG8_STAGE_AC(PG8_SA(0, 1), 0, 1);
    if (wr == 1) PG8_BAR;
    PG8_WAIT_V(2); PG8_BAR;
    PG8_STAGE(PG8_SB(1, 0), cB + kstep, voffB); PG8_STAGE_AC(PG8_SA(1, 0), kstep, 0); PG8_STAGE(PG8_SB(1, 1), cB + hstep + kstep, voffB);
    PG8_WAIT_V(6); PG8_BAR;
    for (;;) {
        const bool has_next = S.next(ui + 1, nxt);
        const char* nB = has_next ? (const char*)g.Bt + (size_t)nxt.e * BSTRIDE + (size_t)nxt.pn * tstep : cB;
        if constexpr (GATHER) {
            if (has_next) { PG8_AOFF(nOff, nxt); }
            else {
#pragma unroll
                for (int h = 0; h < 2; ++h)
#pragma unroll
                    for (int i = 0; i < 2; ++i) nOff[h][i] = cOff[h][i];
            }
        } else nA = has_next ? Ab + (size_t)nxt.pm * tstep : cA;
        for (int t = 0; t < nt; t += 2) {
            const bool last = (t == nt - 2);
            const size_t k1 = (size_t)(t + 1) * kstep, k2 = last ? 0 : (size_t)(t + 2) * kstep, k3 = k2 + kstep;
            const char* b2 = last ? nB : cB + (size_t)(t + 2) * kstep; const char* b3 = b2 + kstep;
            PG8_LDB(B0, 0, 0); PG8_LDB(B1, 0, 1); PG8_SCHED; PG8_LDA(At, 0, 0); PG8_STAGE_AC(PG8_SA(1, 1), k1, 1);
            PG8_WAIT_V(8); PG8_WAIT_L(0); PG8_BAR; PG8_MMA(0, 0, At, B0); PG8_MMA(0, 1, At, B1); PG8_BAR; PG8_SCHED;
            PG8_LDA(At, 0, 1); PG8_STAGE(PG8_SB(0, 0), b2, voffB); PG8_STAGE(PG8_SB(0, 1), b2 + hstep, voffB); PG8_STAGE_AN(PG8_SA(0, 0), k2, 0);
            PG8_WAIT_V(8); PG8_WAIT_L(0); PG8_BAR; PG8_MMA(1, 0, At, B0); PG8_MMA(1, 1, At, B1); PG8_BAR; PG8_SCHED;
            PG8_LDB(B0, 1, 0); PG8_LDB(B1, 1, 1); PG8_SCHED; PG8_LDA(At, 1, 0); PG8_STAGE_AN(PG8_SA(0, 1), k2, 1);
            PG8_WAIT_V(8); PG8_WAIT_L(0); PG8_BAR; PG8_MMA(0, 0, At, B0); PG8_MMA(0, 1, At, B1); PG8_BAR; PG8_SCHED;
            PG8_LDA(At, 1, 1); PG8_STAGE(PG8_SB(1, 0), b3, voffB); PG8_STAGE(PG8_SB(1, 1), b3 + hstep, voffB); PG8_STAGE_AN(PG8_SA(1, 0), k3, 0);
            PG8_WAIT_V(8); PG8_WAIT_L(0); PG8_BAR; PG8_MMA(1, 0, At, B0); PG8_MMA(1, 1, At, B1); PG8_BAR; PG8_SCHED;
        }
        if (wr == 0) PG8_BAR;
        E(acc, cur, wr, wc, fr, fq);
        if (!has_next) break;
#pragma unroll
        for (int a = 0; a < 2; ++a)
#pragma unroll
            for (int b = 0; b < 2; ++b)
#pragma unroll
                for (int m = 0; m < 4; ++m)
#pragma unroll
                    for (int n = 0; n < 2; ++n) acc[a][b][m][n] = (f32x4){0.f, 0.f, 0.f, 0.f};
        cur = nxt; cB = nB; cA = nA; ++ui;
        if constexpr (GATHER) {
#pragma unroll
            for (int h = 0; h < 2; ++h)
#pragma unroll
                for (int i = 0; i < 2; ++i) cOff[h][i] = nOff[h][i];
        }
        if (wr == 1) PG8_BAR;
    }
    PG8_WAIT_V(0);
    PG8_BAR;
#undef PG8_SA
#undef PG8_SB
#undef PG8_STAGE
#undef PG8_STAGE_AC
#undef PG8_STAGE_AN
#undef PG8_LDA
#undef PG8_LDB
#undef PG8_MMA
#undef PG8_WAIT_V
#undef PG8_WAIT_L
#undef PG8_BAR
#undef PG8_SCHED
#undef PG8_AOFF
}
}

using pg8::Unit;
DI f32x4 gelu_tanh4(f32x4 v) {
    f32x4 o;
#pragma unroll
    for (int j = 0; j < 4; ++j) { const float x = v[j]; const float t = x * (1.0f + 0.044715f * x * x) * (-2.0f * 0.7978845608028654f * LOG2E);
        const float e = __builtin_amdgcn_exp2f(t); o[j] = x * __builtin_amdgcn_rcpf(1.0f + e); }
    return o;
}
DI float silu_f(float a) { return a * __builtin_amdgcn_rcpf(1.0f + __builtin_amdgcn_exp2f(-a * LOG2E)); }

struct EpiGeluUV {
    static constexpr bool PERM = true;
    bf16_t* U; bf16_t* V; const float* bias; float* stats;
    DI void operator()(const f32x4 (&acc)[2][2][4][2], const Unit& u, int wr, int wc, int fr_in, int fq_in) const {
        int fr = fr_in, fq = fq_in; asm volatile("" : "+v"(fr), "+v"(fq));
        const int row0 = u.pm * 256 + wr * 64 + fr; const bool isV = u.pn >= 8;
        bf16_t* base = isV ? V : U; const int col0 = (u.pn & 7) * 256 + wc * 32 + 8 * fq, bcol0 = u.pn * 256 + wc * 32 + 8 * fq;
        f32x4 bv[2][2];
#pragma unroll
        for (int bj = 0; bj < 2; ++bj)
#pragma unroll
            for (int n = 0; n < 2; ++n) bv[bj][n] = *(const f32x4*)(bias + bcol0 + bj * 128 + 4 * n);
#pragma unroll
        for (int ai = 0; ai < 2; ++ai)
#pragma unroll
            for (int m = 0; m < 4; ++m) { const int row = row0 + ai * 128 + m * 16; bf16_t* rowp = base + (size_t)row * 2048 + col0; float s = 0.f, q = 0.f;
#pragma unroll
                for (int bj = 0; bj < 2; ++bj) { const f32x4 v0 = gelu_tanh4(acc[ai][bj][m][0] + bv[bj][0]), v1 = gelu_tanh4(acc[ai][bj][m][1] + bv[bj][1]);
                    s += ((v0[0] + v0[1]) + (v0[2] + v0[3])) + ((v1[0] + v1[1]) + (v1[2] + v1[3]));
                    q += ((v0[0] * v0[0] + v0[1] * v0[1]) + (v0[2] * v0[2] + v0[3] * v0[3])) + ((v1[0] * v1[0] + v1[1] * v1[1]) + (v1[2] * v1[2] + v1[3] * v1[3]));
                    u32x4 w; w.x = pg8::cvt_pk_bf16(v0[0], v0[1]); w.y = pg8::cvt_pk_bf16(v0[2], v0[3]); w.z = pg8::cvt_pk_bf16(v1[0], v1[1]); w.w = pg8::cvt_pk_bf16(v1[2], v1[3]);
                    *(u32x4*)(rowp + bj * 128) = w; }
                if (isV) { s += __shfl_xor(s, 16); s += __shfl_xor(s, 32); q += __shfl_xor(q, 16); q += __shfl_xor(q, 32);
                    if (fq == 0) *(f32x2*)(stats + ((size_t)row * 32 + (u.pn - 8) * 4 + wc) * 2) = (f32x2){s, q}; }
                asm volatile("" ::: "memory"); }
    }
};
struct EpiResAdd {
    static constexpr bool PERM = false;
    float* xl; float* xc; const float* gate;
    DI void operator()(const f32x4 (&acc)[2][2][4][2], const Unit& u, int wr, int wc, int fr_in, int fq_in) const {
        int fr = fr_in, fq = fq_in; asm volatile("" : "+v"(fr), "+v"(fq));
        const int b = u.pm < 256 ? (u.pm >> 4) : 16;
        float* xb = u.pm < 256 ? xl + (size_t)u.pm * 256 * D : xc + (size_t)(u.pm - 256) * 256 * D;
        const int r0 = wr * 64 + fr, col0 = u.pn * 256 + wc * 32 + 4 * fq;
        f32x4 gv[2][2];
#pragma unroll
        for (int bj = 0; bj < 2; ++bj)
#pragma unroll
            for (int n = 0; n < 2; ++n) gv[bj][n] = *(const f32x4*)(gate + (size_t)b * 6144 + col0 + bj * 128 + n * 16);
#pragma unroll
        for (int ai = 0; ai < 2; ++ai)
#pragma unroll
            for (int m = 0; m < 4; ++m) { float* rowp = xb + (size_t)(r0 + ai * 128 + m * 16) * D + col0;
#pragma unroll
                for (int bj = 0; bj < 2; ++bj)
#pragma unroll
                    for (int n = 0; n < 2; ++n) { f32x4* p = (f32x4*)(rowp + bj * 128 + n * 16); *p = *p + gv[bj][n] * acc[ai][bj][m][n]; }
                asm volatile("" ::: "memory"); }
    }
};
struct EpiQKV {
    static constexpr bool PERM = true;
    bf16_t *Q, *Kb, *Vb; const float* cosT; const float* sinT;
    DI void operator()(const f32x4 (&acc)[2][2][4][2], const Unit& u, int wr, int wc, int fr_in, int fq_in) const {
        int fr = fr_in, fq = fq_in; asm volatile("" : "+v"(fr), "+v"(fq));
        const int row0 = u.pm * 256 + wr * 64 + fr; const bool lat = u.pm < 256;
        const int cin = wc * 32 + 8 * fq, kk0 = 16 * (wc & 1) + 4 * fq;
        bf16_t* base; int ld; float sc; bool rope;
        if (u.pn < 4) { base = Q + u.pn * 256 + cin; ld = 1024; sc = QSCALE; rope = lat; }
        else if (u.pn == 4) { base = Kb + cin; ld = 256; sc = 1.0f; rope = lat; }
        else { base = Vb + cin; ld = 256; sc = 1.0f; rope = false; }
#pragma unroll
        for (int ai = 0; ai < 2; ++ai)
#pragma unroll
            for (int m = 0; m < 4; ++m) { const int row = row0 + ai * 128 + m * 16; bf16_t* rowp = base + (size_t)row * ld;
                f32x4 cs = (f32x4){1.f, 1.f, 1.f, 1.f}, sn = (f32x4){0.f, 0.f, 0.f, 0.f};
                if (rope) { const int t = row & 4095; cs = *(const f32x4*)(cosT + t * 32 + kk0); sn = *(const f32x4*)(sinT + t * 32 + kk0); }
#pragma unroll
                for (int bj = 0; bj < 2; ++bj) { const f32x4 x1 = acc[ai][bj][m][0], x2 = acc[ai][bj][m][1];
                    const f32x4 o1 = (x1 * cs - x2 * sn) * sc, o2 = (x1 * sn + x2 * cs) * sc;
                    u32x4 w; w.x = pg8::cvt_pk_bf16(o1[0], o1[1]); w.y = pg8::cvt_pk_bf16(o1[2], o1[3]); w.z = pg8::cvt_pk_bf16(o2[0], o2[1]); w.w = pg8::cvt_pk_bf16(o2[2], o2[3]);
                    *(u32x4*)(rowp + bj * 128) = w; }
                asm volatile("" ::: "memory"); }
    }
};
struct EpiSwiGLU {
    static constexpr bool PERM = true;
    bf16_t* Hm;
    DI void operator()(const f32x4 (&acc)[2][2][4][2], const Unit& u, int wr, int wc, int fr_in, int fq_in) const {
        int fr = fr_in, fq = fq_in; asm volatile("" : "+v"(fr), "+v"(fq));
        const int row0 = u.pm * 256 + wr * 64 + fr, col0 = u.pn * 128 + wc * 32 + 8 * fq;
#pragma unroll
        for (int ai = 0; ai < 2; ++ai)
#pragma unroll
            for (int m = 0; m < 4; ++m) { bf16_t* rowp = Hm + (size_t)(row0 + ai * 128 + m * 16) * 2048 + col0;
                const f32x4 a0 = acc[ai][0][m][0], a1 = acc[ai][0][m][1], b0 = acc[ai][1][m][0], b1 = acc[ai][1][m][1];
                u32x4 w; w.x = pg8::cvt_pk_bf16(silu_f(a0[0]) * b0[0], silu_f(a0[1]) * b0[1]); w.y = pg8::cvt_pk_bf16(silu_f(a0[2]) * b0[2], silu_f(a0[3]) * b0[3]);
                w.z = pg8::cvt_pk_bf16(silu_f(a1[0]) * b1[0], silu_f(a1[1]) * b1[1]); w.w = pg8::cvt_pk_bf16(silu_f(a1[2]) * b1[2], silu_f(a1[3]) * b1[3]);
                *(u32x4*)rowp = w; }
    }
};
struct EpiGateY {
    static constexpr bool PERM = true;
    bf16_t* Y; const float* gate;
    DI void operator()(const f32x4 (&acc)[2][2][4][2], const Unit& u, int wr, int wc, int fr_in, int fq_in) const {
        int fr = fr_in, fq = fq_in; asm volatile("" : "+v"(fr), "+v"(fq));
        const int row0 = u.pm * 256 + wr * 64 + fr, col0 = u.pn * 256 + wc * 32 + 8 * fq;
#pragma unroll
        for (int ai = 0; ai < 2; ++ai)
#pragma unroll
            for (int m = 0; m < 4; ++m) { const int row = row0 + ai * 128 + m * 16; const float gt = gate[row]; bf16_t* rowp = Y + (size_t)row * 1024 + col0;
#pragma unroll
                for (int bj = 0; bj < 2; ++bj) { const f32x4 v0 = acc[ai][bj][m][0] * gt, v1 = acc[ai][bj][m][1] * gt;
                    u32x4 w; w.x = pg8::cvt_pk_bf16(v0[0], v0[1]); w.y = pg8::cvt_pk_bf16(v0[2], v0[3]); w.z = pg8::cvt_pk_bf16(v1[0], v1[1]); w.w = pg8::cvt_pk_bf16(v1[2], v1[3]);
                    *(u32x4*)(rowp + bj * 128) = w; }
                asm volatile("" ::: "memory"); }
    }
};

DI void p0_mod(LAS unsigned char* lds, const float* c, const float* c_ctx, const float* w_mod, const float* b_mod, float* mod, int bid, int G) {
    LAS float* S = (LAS float*)lds;
    LAS float* P = (LAS float*)(lds + 17 * 1024 * 4);
    const int tid = tid_opaque(), wave = tid >> 6, lane = tid & 63;
    for (int i = tid; i < 17 * 1024; i += 512) { const int r = i >> 10, k = i & 1023; const float v = r < 16 ? c[r * 1024 + k] : c_ctx[k]; S[i] = v / (1.0f + __expf(-v)); }
    __syncthreads();
    for (int item = bid; item < 4 * 96; item += G) {
        const int l = item / 96, nb = item % 96;
        const float* w = w_mod + ((size_t)l * 1024 + wave * 128) * 6144 + nb * 64 + lane;
        float acc[17];
#pragma unroll
        for (int r = 0; r < 17; ++r) acc[r] = 0.f;
        for (int k4 = 0; k4 < 128; k4 += 4) {
            const float w0 = w[(size_t)(k4 + 0) * 6144], w1 = w[(size_t)(k4 + 1) * 6144], w2 = w[(size_t)(k4 + 2) * 6144], w3 = w[(size_t)(k4 + 3) * 6144];
#pragma unroll
            for (int r = 0; r < 17; ++r) { const f32x4 s = *(const LAS f32x4*)(S + r * 1024 + wave * 128 + k4); acc[r] += (s[0] * w0 + s[1] * w1) + (s[2] * w2 + s[3] * w3); }
        }
#pragma unroll
        for (int r = 0; r < 17; ++r) P[(wave * 17 + r) * 64 + lane] = acc[r];
        __syncthreads();
        for (int o = tid; o < 17 * 64; o += 512) { const int r = o >> 6, nn = o & 63; float s = 0.f;
#pragma unroll
            for (int w8 = 0; w8 < 8; ++w8) s += P[(w8 * 17 + r) * 64 + nn];
            mod[((size_t)l * 17 + r) * 6144 + nb * 64 + nn] = s + b_mod[l * 6144 + nb * 64 + nn]; }
        __syncthreads();
    }
}
DI int qk_phys(int d) { return 8 * ((d & 31) >> 2) + (d & 3) + 4 * (d >> 5); }
DI void cvt_item(const float* src, int ldsrc, int K, bf16_t* dst, int k0, int nsrc0, int ndst0, bool perm, LAS unsigned char* Lt, int lane) {
    const int kr = lane >> 4, nq = lane & 15;
    f32x4 v[16];
#pragma unroll
    for (int q = 0; q < 16; ++q) v[q] = *(const f32x4*)(src + (size_t)(k0 + 4 * q + kr) * ldsrc + nsrc0 + 4 * nq);
    int prow[4];
#pragma unroll
    for (int i = 0; i < 4; ++i) { const int n = 4 * nq + i; prow[i] = (perm ? qk_phys(n) : n) * 132; }
#pragma unroll
    for (int q = 0; q < 16; ++q) { const int k = 4 * q + kr; const unsigned w01 = pk2(v[q][0], v[q][1]), w23 = pk2(v[q][2], v[q][3]);
        *(LAS unsigned short*)(Lt + prow[0] + k * 2) = (unsigned short)(w01 & 0xffffu); *(LAS unsigned short*)(Lt + prow[1] + k * 2) = (unsigned short)(w01 >> 16);
        *(LAS unsigned short*)(Lt + prow[2] + k * 2) = (unsigned short)(w23 & 0xffffu); *(LAS unsigned short*)(Lt + prow[3] + k * 2) = (unsigned short)(w23 >> 16); }
    LDS_WAIT();
    const int c = lane & 7;
#pragma unroll
    for (int j = 0; j < 8; ++j) { const int n = (lane >> 3) + 8 * j; const LAS unsigned* s = (const LAS unsigned*)(Lt + n * 132 + 16 * c);
        u32x4 o; o.x = s[0]; o.y = s[1]; o.z = s[2]; o.w = s[3];
        *(u32x4*)(dst + (size_t)(ndst0 + n) * K + k0 + 8 * c) = o; }
    LDS_WAIT();
}
struct P0Args { const float *w_in, *w_out, *w_qkv, *w_o, *w1, *w3, *w2, *w_s; bf16_t *win_t, *wout_t, *wqkv_t, *wo_t, *w13_t, *w2_t, *ws_t; float* cosT; float* sinT; };
DI void p0_convert(LAS unsigned char* lds, const P0Args& a, int gw, int NGW, int lane, int wave) {
    LAS unsigned char* Lt = lds + wave * 8448;
    constexpr int I_IN = 2 * 16 * 64, I_OUT = 2 * 32 * 16, I_QKV = 2 * 16 * 24, I_O = 2 * 16 * 16, I_W1 = 64 * 16 * 32, I_W2 = 64 * 32 * 16;
    constexpr int NITEMS = I_IN + I_OUT + I_QKV + I_O + 2 * I_W1 + I_W2;
    for (int it = gw; it < NITEMS; it += NGW) {
        int r = it;
        if (r < I_IN) { const int j = r / 1024, q = r % 1024, kb = q / 64, nb = q % 64;
            cvt_item(a.w_in + (size_t)j * 1024 * 4096, 4096, 1024, a.win_t + (size_t)j * 4096 * 1024, kb * 64, nb * 64, nb * 64, false, Lt, lane); continue; } r -= I_IN;
        if (r < I_OUT) { const int j = r / 512, q = r % 512, kb = q / 16, nb = q % 16;
            cvt_item(a.w_out + (size_t)j * 2048 * 1024, 1024, 2048, a.wout_t + (size_t)j * 1024 * 2048, kb * 64, nb * 64, nb * 64, false, Lt, lane); continue; } r -= I_OUT;
        if (r < I_QKV) { const int j = r / 384, q = r % 384, kb = q / 24, nb = q % 24;
            cvt_item(a.w_qkv + (size_t)j * 1024 * 1536, 1536, 1024, a.wqkv_t + (size_t)j * 1536 * 1024, kb * 64, nb * 64, nb * 64, nb < 20, Lt, lane); continue; } r -= I_QKV;
        if (r < I_O) { const int j = r / 256, q = r % 256, kb = q / 16, nb = q % 16;
            cvt_item(a.w_o + (size_t)j * 1024 * 1024, 1024, 1024, a.wo_t + (size_t)j * 1024 * 1024, kb * 64, nb * 64, nb * 64, false, Lt, lane); continue; } r -= I_O;
        if (r < 2 * I_W1) { const int which = r / I_W1; r %= I_W1; const int le = r / 512, q = r % 512, kb = q / 32, nb = q % 32;
            const int ndst = ((nb * 64) >> 7) * 256 + ((nb * 64) & 127) + which * 128;
            cvt_item((which ? a.w3 : a.w1) + (size_t)le * 1024 * 2048, 2048, 1024, a.w13_t + (size_t)le * 4096 * 1024, kb * 64, nb * 64, ndst, false, Lt, lane); continue; } r -= 2 * I_W1;
        { const int le = r / 512, q = r % 512, kb = q / 16, nb = q % 16;
            cvt_item(a.w2 + (size_t)le * 2048 * 1024, 1024, 2048, a.w2_t + (size_t)le * 1024 * 2048, kb * 64, nb * 64, nb * 64, false, Lt, lane); }
    }
    const int gt = gw * 64 + lane, NT = NGW * 64;
    for (int i = gt; i < 2 * 16 * 128 * 128 / 8; i += NT) { const f32x4 x = *(const f32x4*)(a.w_s + (size_t)i * 8), y = *(const f32x4*)(a.w_s + (size_t)i * 8 + 4);
        u32x4 o; o.x = pk2(x[0], x[1]); o.y = pk2(x[2], x[3]); o.z = pk2(y[0], y[1]); o.w = pk2(y[2], y[3]); *(u32x4*)(a.ws_t + (size_t)i * 8) = o; }
    for (int i = gt; i < 4096 * 32; i += NT) { const int t = i >> 5, kk = i & 31; const int pos = kk < 16 ? (t >> 6) : (t & 63); const int j = kk & 15;
        const float inv = exp2f(-(float)j * (13.287712379549449f / 16.0f)); const float ang = (float)pos * inv; a.cosT[i] = cosf(ang); a.sinT[i] = sinf(ang); }
}

DI void n1_phase(int mode, int nrows, const float* xin, const float* cin, float* xl, float* xc, const bf16_t* Y, const int* tokslot, const float* mod_prev  ,
                 const float* mod_cur, const float* gmix, bf16_t* H, int gw, int NGW, int lane) {
    for (int m = gw; m < nrows; m += NGW) {
        const int b = m < ML ? (m >> 12) : 16;
        float* xr = m < ML ? xl + (size_t)m * D : xc + (size_t)(m - ML) * D;
        f32x4 v[4];
        if (mode == 0) { const float* src = m < ML ? xin + (size_t)m * D : cin + (size_t)(m - ML) * D;
#pragma unroll
            for (int j = 0; j < 4; ++j) v[j] = *(const f32x4*)(src + 4 * lane + 256 * j); }
        else {
#pragma unroll
            for (int j = 0; j < 4; ++j) v[j] = *(const f32x4*)(xr + 4 * lane + 256 * j);
            const int slot = lane < 16 ? tokslot[(size_t)lane * MT + m] : -1;
            f32x4 a[4];
#pragma unroll
            for (int j = 0; j < 4; ++j) a[j] = (f32x4){0.f, 0.f, 0.f, 0.f};
            for (int e = 0; e < 16; ++e) { const int s = __builtin_amdgcn_readlane(slot, e);
                if (s >= 0) { const bf16_t* yr = Y + (size_t)s * D;
#pragma unroll
                    for (int j = 0; j < 4; ++j) { const u32x2 w = *(const u32x2*)(yr + 4 * lane + 256 * j); a[j] += (f32x4){bflo(w.x), bfhi(w.x), bflo(w.y), bfhi(w.y)}; } } }
            const float* g2 = mod_prev + (size_t)b * 6144 + 5120;
#pragma unroll
            for (int j = 0; j < 4; ++j) v[j] += *(const f32x4*)(g2 + 4 * lane + 256 * j) * a[j];
        }
        float ss = 0.f;
#pragma unroll
        for (int j = 0; j < 4; ++j) ss += (v[j][0] * v[j][0] + v[j][1] * v[j][1]) + (v[j][2] * v[j][2] + v[j][3] * v[j][3]);
        const float rstd = 1.0f / sqrtf(wave_sum(ss) * (1.0f / D) + EPS);
        if (mode == 2) {
#pragma unroll
            for (int j = 0; j < 4; ++j) *(f32x4*)(xr + 4 * lane + 256 * j) = v[j] * rstd * *(const f32x4*)(gmix + 4 * lane + 256 * j);
        } else {
#pragma unroll
            for (int j = 0; j < 4; ++j) *(f32x4*)(xr + 4 * lane + 256 * j) = v[j];
            const float* sh = mod_cur + (size_t)b * 6144; const float* sc = sh + 1024;
#pragma unroll
            for (int j = 0; j < 4; ++j) { const int c = 4 * lane + 256 * j; const f32x4 h = v[j] * rstd * *(const f32x4*)(gmix + c) * (*(const f32x4*)(sc + c) + 1.0f) + *(const f32x4*)(sh + c);
                u32x2 w; w.x = pk2(h[0], h[1]); w.y = pk2(h[2], h[3]); *(u32x2*)(H + (size_t)m * D + c) = w; }
        }
    }
}

DI void n2_phase(LAS unsigned char* lds, int nrows, const float* xl, const float* xc, const float* mod_cur, const float* gffn, const float* w_r, bf16_t* H, float* aff, int gw, int NGW, int lane) {
    LAS float* Wt = (LAS float*)lds;
    for (int i = tid_opaque(); i < 1024 * 4; i += 512) { const int c = i >> 2, e4 = (i & 3) * 4; const f32x4 w = *(const f32x4*)(w_r + c * 16 + e4);
        Wt[(e4 + 0) * 1024 + c] = w[0]; Wt[(e4 + 1) * 1024 + c] = w[1]; Wt[(e4 + 2) * 1024 + c] = w[2]; Wt[(e4 + 3) * 1024 + c] = w[3]; }
    __syncthreads();
    for (int m = gw; m < nrows; m += NGW) {
        const int b = m < ML ? (m >> 12) : 16;
        const float* xr = m < ML ? xl + (size_t)m * D : xc + (size_t)(m - ML) * D;
        f32x4 v[4]; float ss = 0.f;
#pragma unroll
        for (int j = 0; j < 4; ++j) { v[j] = *(const f32x4*)(xr + 4 * lane + 256 * j); ss += (v[j][0] * v[j][0] + v[j][1] * v[j][1]) + (v[j][2] * v[j][2] + v[j][3] * v[j][3]); }
        const float rstd = 1.0f / sqrtf(wave_sum(ss) * (1.0f / D) + EPS);
        const float* sh = mod_cur + (size_t)b * 6144 + 3072; const float* sc = sh + 1024;
#pragma unroll
        for (int j = 0; j < 4; ++j) { const int c = 4 * lane + 256 * j; v[j] = v[j] * rstd * *(const f32x4*)(gffn + c) * (*(const f32x4*)(sc + c) + 1.0f) + *(const f32x4*)(sh + c);
            u32x2 w; w.x = pk2(v[j][0], v[j][1]); w.y = pk2(v[j][2], v[j][3]); *(u32x2*)(H + (size_t)m * D + c) = w; }
        float p[16];
#pragma unroll
        for (int e = 0; e < 16; ++e) { float s = 0.f;
#pragma unroll
            for (int j = 0; j < 4; ++j) { const f32x4 w = *(const LAS f32x4*)(Wt + e * 1024 + 4 * lane + 256 * j); s += (v[j][0] * w[0] + v[j][1] * w[1]) + (v[j][2] * w[2] + v[j][3] * w[3]); }
            p[e] = s; }
        const bool h5 = (lane & 32) != 0, h4 = (lane & 16) != 0, h3 = (lane & 8) != 0, h2 = (lane & 4) != 0;
        float q8[8], q4[4], q2[2];
#pragma unroll
        for (int i = 0; i < 8; ++i) { const float send = h5 ? p[i] : p[i + 8], keep = h5 ? p[i + 8] : p[i]; q8[i] = keep + __shfl_xor(send, 32); }
#pragma unroll
        for (int i = 0; i < 4; ++i) { const float send = h4 ? q8[i] : q8[i + 4], keep = h4 ? q8[i + 4] : q8[i]; q4[i] = keep + __shfl_xor(send, 16); }
#pragma unroll
        for (int i = 0; i < 2; ++i) { const float send = h3 ? q4[i] : q4[i + 2], keep = h3 ? q4[i + 2] : q4[i]; q2[i] = keep + __shfl_xor(send, 8); }
        float t; { const float send = h2 ? q2[0] : q2[1], keep = h2 ? q2[1] : q2[0]; t = keep + __shfl_xor(send, 4); }
        t += __shfl_xor(t, 1); t += __shfl_xor(t, 2);
        float mx = t;
#pragma unroll
        for (int o = 4; o < 64; o <<= 1) mx = fmaxf(mx, __shfl_xor(mx, o));
        const float ex = __expf(t - mx); float sm = ex;
#pragma unroll
        for (int o = 4; o < 64; o <<= 1) sm += __shfl_xor(sm, o);
        if ((lane & 3) == 0) aff[(size_t)m * 16 + (lane >> 2)] = ex / sm;
    }
    __syncthreads();
}

DI void tk_problem(LAS unsigned char* lds, const float* aff, int rowbase, int n, int cap, int e, int slotbase, int* rowidx, float* gate, int* tokslot_e) {
    LAS int* cntA = (LAS int*)lds;
    LAS int* scanA = (LAS int*)(lds + 64);
    LAS int* scanB = (LAS int*)(lds + 128);
    LAS int* totG = (LAS int*)(lds + 192);
    const int tid = tid_opaque(), wave = tid >> 6, lane = tid & 63;
    unsigned key[8];
#pragma unroll
    for (int j = 0; j < 8; ++j) { const int t = tid * 8 + j; key[j] = t < n ? __float_as_uint(aff[(size_t)(rowbase + t) * 16 + e]) : 0u; }
    unsigned prefix = 0u; int it = 0;
    for (int bit = 30; bit >= 0; --bit, ++it) {
        const unsigned cand = prefix | (1u << bit);
        int c = 0;
#pragma unroll
        for (int j = 0; j < 8; ++j) c += key[j] >= cand ? 1 : 0;
        c = wave_sum_i(c);
        if (lane == 0) cntA[(it & 1) * 8 + wave] = c;
        __syncthreads();
        int tot = 0;
#pragma unroll
        for (int w = 0; w < 8; ++w) tot += cntA[(it & 1) * 8 + w];
        if (tot >= cap) prefix = cand;
    }
    int ng = 0, neq = 0;
#pragma unroll
    for (int j = 0; j < 8; ++j) { ng += key[j] > prefix ? 1 : 0; neq += key[j] == prefix ? 1 : 0; }
    int incl = neq;
#pragma unroll
    for (int o = 1; o < 64; o <<= 1) { const int y = __shfl_up(incl, o); if (lane >= o) incl += y; }
    const int wg = wave_sum_i(ng);
    if (lane == 63) scanA[wave] = incl;
    if (lane == 0) totG[wave] = wg;
    __syncthreads();
    int eqbase = incl - neq, G = 0;
#pragma unroll
    for (int w = 0; w < 8; ++w) { if (w < wave) eqbase += scanA[w]; G += totG[w]; }
    const int need = cap - G;
    bool sel[8]; int nsel = 0, er = eqbase;
#pragma unroll
    for (int j = 0; j < 8; ++j) { const bool isg = key[j] > prefix, ise = key[j] == prefix; sel[j] = isg || (ise && er < need); er += ise ? 1 : 0; nsel += sel[j] ? 1 : 0; }
    int incl2 = nsel;
#pragma unroll
    for (int o = 1; o < 64; o <<= 1) { const int y = __shfl_up(incl2, o); if (lane >= o) incl2 += y; }
    if (lane == 63) scanB[wave] = incl2;
    __syncthreads();
    int pos = incl2 - nsel;
#pragma unroll
    for (int w = 0; w < 8; ++w) if (w < wave) pos += scanB[w];
#pragma unroll
    for (int j = 0; j < 8; ++j) { const int t = tid * 8 + j;
        if (t < n) { if (sel[j]) { const int s = slotbase + pos; rowidx[s] = rowbase + t; gate[s] = __uint_as_float(key[j]); tokslot_e[rowbase + t] = s; ++pos; } else tokslot_e[rowbase + t] = -1; } }
    __syncthreads();
}

DI s16x4 tr16(const LAS unsigned char* p) { return __builtin_bit_cast(s16x4, __builtin_amdgcn_ds_read_tr16_b64_v4i16((LAS v4i16_t*)p)); }
DI void sm_phase(LAS unsigned char* lds, bf16_t* U, const bf16_t* V, const float* stats, const bf16_t* ws_t  , const float* b_s  , const float* ln_g, const float* ln_b, int bid, int G) {
    constexpr int PITCH = 272;
    LAS unsigned char* Aimg = lds; LAS unsigned char* Bimg = lds + 128 * PITCH; LAS float* MR = (LAS float*)(lds + 2 * 128 * PITCH);
    const int tid = tid_opaque(), wid = __builtin_amdgcn_readfirstlane(tid >> 6), lane = tid & 63, wr = wid >> 2, wc = wid & 3, fr = lane & 15, fq = lane >> 4;
    for (int unit = bid; unit < (MT / 128) * 4; unit += G) {
        const int ch = unit >> 2, gq = unit & 3, row0 = ch * 128;
        if (tid < 128) { const float* sp = stats + (size_t)(row0 + tid) * 64; float s = 0.f, q = 0.f;
#pragma unroll
            for (int i = 0; i < 16; ++i) { const f32x4 x = *(const f32x4*)(sp + 4 * i); s += x[0] + x[2]; q += x[1] + x[3]; }
            const float mu = s * (1.0f / DA); const float var = fmaxf(q * (1.0f / DA) - mu * mu, 0.f);
            MR[tid * 2] = mu; MR[tid * 2 + 1] = 1.0f / sqrtf(var + EPS); }
        __syncthreads();
        for (int gi = 0; gi < 4; ++gi) {
            const int g = gq * 4 + gi, c0 = g * 128;
#pragma unroll
            for (int k = 0; k < 4; ++k) { const int id = tid + 512 * k, r = id >> 4, cc = (id & 15) * 8;
                *(LAS u32x4*)(Aimg + r * PITCH + cc * 2) = *(const u32x4*)(ws_t + ((size_t)g * 128 + r) * 128 + cc);
                const u32x4 w = *(const u32x4*)(V + (size_t)(row0 + r) * 2048 + c0 + cc);
                const float mu = MR[r * 2], rs = MR[r * 2 + 1];
                const f32x4 g0 = *(const f32x4*)(ln_g + c0 + cc), g1 = *(const f32x4*)(ln_g + c0 + cc + 4), b0 = *(const f32x4*)(ln_b + c0 + cc), b1 = *(const f32x4*)(ln_b + c0 + cc + 4);
                u32x4 o;
                o.x = pk2((bflo(w.x) - mu) * rs * g0[0] + b0[0], (bfhi(w.x) - mu) * rs * g0[1] + b0[1]); o.y = pk2((bflo(w.y) - mu) * rs * g0[2] + b0[2], (bfhi(w.y) - mu) * rs * g0[3] + b0[3]);
                o.z = pk2((bflo(w.z) - mu) * rs * g1[0] + b1[0], (bfhi(w.z) - mu) * rs * g1[1] + b1[1]); o.w = pk2((bflo(w.w) - mu) * rs * g1[2] + b1[2], (bfhi(w.w) - mu) * rs * g1[3] + b1[3]);
                *(LAS u32x4*)(Bimg + r * PITCH + cc * 2) = o; }
            __syncthreads();
            f32x4 acc[4][2];
#pragma unroll
            for (int mt = 0; mt < 4; ++mt)
#pragma unroll
                for (int nt = 0; nt < 2; ++nt) acc[mt][nt] = (f32x4){0.f, 0.f, 0.f, 0.f};
#pragma unroll
            for (int ks = 0; ks < 4; ++ks) {
                bf16x8 af[4], bfr[2];
#pragma unroll
                for (int mt = 0; mt < 4; ++mt) af[mt] = *(const LAS bf16x8*)(Aimg + (wr * 64 + mt * 16 + fr) * PITCH + (ks * 32 + 8 * fq) * 2);
#pragma unroll
                for (int nt = 0; nt < 2; ++nt) { const LAS unsigned char* p = Bimg + (ks * 32 + 8 * fq + (fr >> 2)) * PITCH + (wc * 32 + nt * 16) * 2 + 8 * (fr & 3);
                    const s16x4 lo = tr16(p), hi = tr16(p + 4 * PITCH); bfr[nt] = __builtin_shufflevector(lo, hi, 0, 1, 2, 3, 4, 5, 6, 7); }
#pragma unroll
                for (int mt = 0; mt < 4; ++mt)
#pragma unroll
                    for (int nt = 0; nt < 2; ++nt) acc[mt][nt] = __builtin_amdgcn_mfma_f32_16x16x32_bf16(bfr[nt], af[mt], acc[mt][nt], 0, 0, 0);
            }
#pragma unroll
            for (int mt = 0; mt < 4; ++mt) { const int p = wr * 64 + mt * 16 + fr; const float bs = b_s[g * 128 + p];
#pragma unroll
                for (int nt = 0; nt < 2; ++nt) { bf16_t* up = U + (size_t)(row0 + p) * 2048 + c0 + wc * 32 + nt * 16 + 4 * fq; const u32x2 w = *(const u32x2*)up;
                    u32x2 o; o.x = pk2(bflo(w.x) * (acc[mt][nt][0] + bs), bfhi(w.x) * (acc[mt][nt][1] + bs)); o.y = pk2(bflo(w.y) * (acc[mt][nt][2] + bs), bfhi(w.y) * (acc[mt][nt][3] + bs));
                    *(u32x2*)up = o; } }
            __syncthreads();
        }
    }
}

DI bf16x8 pack8(const f32x16& x, int s) {
    u32x4 p; p.x = pk2(x[8 * s], x[8 * s + 1]); p.y = pk2(x[8 * s + 2], x[8 * s + 3]); p.z = pk2(x[8 * s + 4], x[8 * s + 5]); p.w = pk2(x[8 * s + 6], x[8 * s + 7]);
    return __builtin_bit_cast(bf16x8, p);
}
DI void at_phase(LAS unsigned char* lds, const bf16_t* Q, const bf16_t* Kb, const bf16_t* Vb, bf16_t* O, const float* sink  , int nunits, int bid, int G) {
    constexpr int KP = 144;
    LAS unsigned char* Kimg = lds; LAS unsigned char* Vimg = lds + 64 * KP;
    const int tid = tid_opaque(), wid = __builtin_amdgcn_readfirstlane(tid >> 6), lane = tid & 63, r = lane & 31, h = lane >> 5;
    const int g = wid >> 1, wh = wid & 1;
    for (int unit = bid; unit < nunits; unit += G) {
        int b, kvh, qb, qrow0; bool lat;
        if (unit < 2048) { lat = true; b = unit >> 7; kvh = (unit >> 5) & 3; qb = unit & 31; qrow0 = b * 4096 + qb * 128; }
        else { const int u2 = unit - 2048; lat = false; b = u2 >> 3; kvh = (u2 >> 1) & 3; qb = u2 & 1; qrow0 = ML + b * 256 + qb * 128; }
        const int hq = kvh * 4 + g;
        bf16x8 qf[2][4];
#pragma unroll
        for (int qt = 0; qt < 2; ++qt)
#pragma unroll
            for (int ks = 0; ks < 4; ++ks) qf[qt][ks] = *(const bf16x8*)(Q + (size_t)(qrow0 + wh * 64 + qt * 32 + r) * 1024 + hq * 64 + ks * 16 + 8 * h);
        f32x16 o[2][2];
#pragma unroll
        for (int dt = 0; dt < 2; ++dt)
#pragma unroll
            for (int qt = 0; qt < 2; ++qt)
#pragma unroll
                for (int i = 0; i < 16; ++i) o[dt][qt][i] = 0.f;
        float mrun[2], lrun[2];
        { const float sk = sink[hq] * LOG2E; mrun[0] = sk; mrun[1] = sk; lrun[0] = h == 0 ? 1.f : 0.f; lrun[1] = lrun[0]; }
        for (int ti = lat ? 0 : 6; ti < 10; ++ti) {
            int krow0, mode = 0;
            if (ti < 6) { const int kb = qb - 1 + (ti >> 1); if (kb < 0 || kb > 31) continue; krow0 = b * 4096 + kb * 128 + (ti & 1) * 64; mode = ti < 2 ? 1 : (ti < 4 ? 0 : 2); }
            else krow0 = ML + b * 256 + (ti - 6) * 64;
            __syncthreads();
            { const int key = tid >> 3, dc = tid & 7;
              *(LAS u32x4*)(Kimg + key * KP + dc * 16) = *(const u32x4*)(Kb + (size_t)(krow0 + key) * 256 + kvh * 64 + dc * 8);
              *(LAS u32x4*)(Vimg + key * KP + dc * 16) = *(const u32x4*)(Vb + (size_t)(krow0 + key) * 256 + kvh * 64 + dc * 8); }
            __syncthreads();
            f32x16 s[2][2];
#pragma unroll
            for (int kt = 0; kt < 2; ++kt)
#pragma unroll
                for (int qt = 0; qt < 2; ++qt) {
#pragma unroll
                    for (int i = 0; i < 16; ++i) s[kt][qt][i] = 0.f;
#pragma unroll
                    for (int ks = 0; ks < 4; ++ks) { const bf16x8 kf = *(const LAS bf16x8*)(Kimg + (kt * 32 + r) * KP + (ks * 16 + 8 * h) * 2);
                        s[kt][qt] = __builtin_amdgcn_mfma_f32_32x32x16_bf16(kf, qf[qt][ks], s[kt][qt], 0, 0, 0); } }
            if (mode != 0) {
                const int jb = (ti & 1) * 64;
#pragma unroll
                for (int kt = 0; kt < 2; ++kt)
#pragma unroll
                    for (int qt = 0; qt < 2; ++qt) { const int iq = wh * 64 + qt * 32 + r;
#pragma unroll
                        for (int i = 0; i < 16; ++i) { const int j = jb + kt * 32 + (i & 3) + 8 * (i >> 2) + 4 * h; const bool masked = mode == 1 ? (j < iq) : (j > iq); if (masked) s[kt][qt][i] = -INFINITY; } }
            }
#pragma unroll
            for (int qt = 0; qt < 2; ++qt) {
                float mx = s[0][qt][0];
#pragma unroll
                for (int i = 1; i < 16; ++i) mx = fmaxf(mx, s[0][qt][i]);
#pragma unroll
                for (int i = 0; i < 16; ++i) mx = fmaxf(mx, s[1][qt][i]);
                mx = fmaxf(mx, __shfl_xor(mx, 32));
                const float mnew = fmaxf(mrun[qt], mx), alpha = __builtin_amdgcn_exp2f(mrun[qt] - mnew); mrun[qt] = mnew;
                float ls = 0.f;
#pragma unroll
                for (int kt = 0; kt < 2; ++kt)
#pragma unroll
                    for (int i = 0; i < 16; ++i) { const float p = __builtin_amdgcn_exp2f(s[kt][qt][i] - mnew); s[kt][qt][i] = p; ls += p; }
                lrun[qt] = lrun[qt] * alpha + ls;
#pragma unroll
                for (int dt = 0; dt < 2; ++dt)
#pragma unroll
                    for (int i = 0; i < 16; ++i) o[dt][qt][i] *= alpha;
            }
#pragma unroll
            for (int kt = 0; kt < 2; ++kt)
#pragma unroll
                for (int ss = 0; ss < 2; ++ss) {
                    bf16x8 vf[2];
#pragma unroll
                    for (int dt = 0; dt < 2; ++dt) { const LAS unsigned char* p = Vimg + (kt * 32 + 16 * ss + 4 * h + ((lane & 15) >> 2)) * KP + (dt * 32 + 16 * ((lane >> 4) & 1)) * 2 + 8 * (lane & 3);
                        const s16x4 lo = tr16(p), hi = tr16(p + 8 * KP); vf[dt] = __builtin_shufflevector(lo, hi, 0, 1, 2, 3, 4, 5, 6, 7); }
#pragma unroll
                    for (int qt = 0; qt < 2; ++qt) { const bf16x8 pf = pack8(s[kt][qt], ss);
#pragma unroll
                        for (int dt = 0; dt < 2; ++dt) o[dt][qt] = __builtin_amdgcn_mfma_f32_32x32x16_bf16(vf[dt], pf, o[dt][qt], 0, 0, 0); }
                }
        }
#pragma unroll
        for (int qt = 0; qt < 2; ++qt) { const float lt = lrun[qt] + __shfl_xor(lrun[qt], 32); const float inv = 1.0f / lt;
            bf16_t* orow = O + (size_t)(qrow0 + wh * 64 + qt * 32 + r) * 1024 + hq * 64;
#pragma unroll
            for (int dt = 0; dt < 2; ++dt)
#pragma unroll
                for (int ig = 0; ig < 4; ++ig) { u32x2 w; w.x = pk2(o[dt][qt][4 * ig] * inv, o[dt][qt][4 * ig + 1] * inv); w.y = pk2(o[dt][qt][4 * ig + 2] * inv, o[dt][qt][4 * ig + 3] * inv);
                    *(u32x2*)(orow + dt * 32 + 8 * ig + 4 * h) = w; } }
    }
    __syncthreads();
}

struct Args { const float* in[23]; float* out; unsigned char* ws; int ph_lo, ph_hi; };
static_assert(sizeof(Args) == 25 * 8 + 8, "Args has no padding");
#define AS4 __attribute__((address_space(4)))
DI unsigned long long karg(int k) { const unsigned long long AS4* kp = (const unsigned long long AS4*)__builtin_amdgcn_kernarg_segment_ptr(); asm volatile("" : "+s"(kp)); return kp[k]; }
#define KIN(k) ((const float*)(const GAS float*)karg(k))
#define KOUT() ((float*)(GAS float*)karg(23))
#define KWS() ((unsigned char*)(GAS unsigned char*)karg(24))

#ifndef DBG_ONLY
#define DBG_ONLY -1
#endif
#define SITE(n) (DBG_ONLY < 0 || DBG_ONLY == (n))

__global__ void __launch_bounds__(512, 2) mega_fwd(Args args) {
    extern __shared__ __attribute__((aligned(16))) unsigned char lds_raw[];
    LAS unsigned char* lds = (LAS unsigned char*)lds_raw;
    const int tid = threadIdx.x;
    for (int u = tid; u < (LDS_BYTES - RING_BYTES) / 4; u += 512) ((LAS unsigned*)(lds + RING_BYTES))[u] = 0u;
    __syncthreads();
    XcdBarrier bar; bar.bar = (unsigned*)(args.ws + WS_CTL) + CW_BAR; bar.x = 0; bar.st = nullptr;
    if (!MK_SPLIT) bar = xcd_barrier_post((unsigned*)(args.ws + WS_CTL) + CW_BAR, (volatile LAS unsigned*)(lds + MISC_OFF) + 8);
    const int lo = args.ph_lo, hi = args.ph_hi;
#define IN(k) (lo <= (k) && (k) < hi)
#define SEAM(k) do { if (!MK_SPLIT && IN((k) + 1)) xcd_barrier(bar); } while (0)
#define WAVE_IDS() const int tid_ = tid_opaque(); const int lane = tid_ & 63, wave = __builtin_amdgcn_readfirstlane(tid_ >> 6); const int G = gridDim.x, bid = blockIdx.x; const int gw = bid * 8 + wave, NGW = G * 8; (void)lane; (void)gw; (void)NGW; (void)G; (void)bid

    if (SITE(0) && IN(0)) {
        WAVE_IDS(); unsigned char* ws = KWS();
        p0_mod(lds, KIN(1), KIN(3), KIN(4), KIN(5), (float*)(ws + WS_MOD), bid, G);
        P0Args pa; pa.w_in = KIN(8); pa.w_out = KIN(14); pa.w_qkv = KIN(15); pa.w_o = KIN(17); pa.w1 = KIN(19); pa.w3 = KIN(20); pa.w2 = KIN(21); pa.w_s = KIN(12);
        pa.win_t = (bf16_t*)(ws + WS_WIN); pa.wout_t = (bf16_t*)(ws + WS_WOUT); pa.wqkv_t = (bf16_t*)(ws + WS_WQKV); pa.wo_t = (bf16_t*)(ws + WS_WO); pa.w13_t = (bf16_t*)(ws + WS_W13); pa.w2_t = (bf16_t*)(ws + WS_W2);
        pa.ws_t = (bf16_t*)(ws + WS_WSP); pa.cosT = (float*)(ws + WS_ROPE); pa.sinT = pa.cosT + 4096 * 32;
        p0_convert(lds, pa, gw, NGW, lane, wave);
    }
    SEAM(0);
    if (SITE(1) && IN(1)) { WAVE_IDS(); unsigned char* ws = KWS();
        n1_phase(0, MT, KIN(0), KIN(2), KOUT(), (float*)(ws + WS_XC), nullptr, nullptr, nullptr, (const float*)(ws + WS_MOD), KIN(6), (bf16_t*)(ws + WS_H), gw, NGW, lane); }
    SEAM(1);

    for (int layer = 0; layer < DEPTH; ++layer) {
        const int pb = 2 + 8 * layer, j = layer >> 1; const bool lastl = layer == DEPTH - 1;
        const int mrows = lastl ? ML : MT;
        if ((layer & 1) == 0) {
            if (SITE(2) && IN(pb + 0)) { WAVE_IDS(); unsigned char* ws = KWS();
                pg8::Gemm g{(const bf16_t*)(ws + WS_H), (const bf16_t*)(ws + WS_WIN) + (size_t)j * 4096 * 1024, nullptr}; pg8::GroupedOrder<16, 0> S; S.init(MT / 256, 1, G, bid);
                EpiGeluUV E{(bf16_t*)(ws + WS_BIG + BIG_U), (bf16_t*)(ws + WS_BIG + BIG_V), KIN(9) + (size_t)j * 4096, (float*)(ws + WS_STATS)};
                pg8::gemm_phase<EpiGeluUV, pg8::GroupedOrder<16, 0>, false, 1024, 0>(lds, g, S, E); }
            SEAM(pb + 0);
            if (SITE(3) && IN(pb + 1)) { WAVE_IDS(); unsigned char* ws = KWS();
                sm_phase(lds, (bf16_t*)(ws + WS_BIG + BIG_U), (const bf16_t*)(ws + WS_BIG + BIG_V), (const float*)(ws + WS_STATS), (const bf16_t*)(ws + WS_WSP) + (size_t)j * 16 * 128 * 128,
                         KIN(13) + (size_t)j * 16 * 128, KIN(10) + (size_t)j * 2048, KIN(11) + (size_t)j * 2048, bid, G); }
            SEAM(pb + 1);
            if (SITE(4) && IN(pb + 2)) { WAVE_IDS(); unsigned char* ws = KWS();
                pg8::Gemm g{(const bf16_t*)(ws + WS_BIG + BIG_U), (const bf16_t*)(ws + WS_WOUT) + (size_t)j * 1024 * 2048, nullptr}; pg8::GroupedOrder<4, 0> S; S.init(MT / 256, 1, G, bid);
                EpiResAdd E{KOUT(), (float*)(ws + WS_XC), (const float*)(ws + WS_MOD) + (size_t)layer * 17 * 6144 + 2048};
                pg8::gemm_phase<EpiResAdd, pg8::GroupedOrder<4, 0>, false, 2048, 0>(lds, g, S, E); }
            SEAM(pb + 2);
        } else {
            if (SITE(5) && IN(pb + 0)) { WAVE_IDS(); unsigned char* ws = KWS();
                pg8::Gemm g{(const bf16_t*)(ws + WS_H), (const bf16_t*)(ws + WS_WQKV) + (size_t)j * 1536 * 1024, nullptr}; pg8::GroupedOrder<6, 0> S; S.init(MT / 256, 1, G, bid);
                EpiQKV E{(bf16_t*)(ws + WS_BIG + BIG_Q), (bf16_t*)(ws + WS_BIG + BIG_K), (bf16_t*)(ws + WS_BIG + BIG_VV), (const float*)(ws + WS_ROPE), (const float*)(ws + WS_ROPE) + 4096 * 32};
                pg8::gemm_phase<EpiQKV, pg8::GroupedOrder<6, 0>, false, 1024, 0>(lds, g, S, E); }
            SEAM(pb + 0);
            if (SITE(6) && IN(pb + 1)) { WAVE_IDS(); unsigned char* ws = KWS();
                at_phase(lds, (const bf16_t*)(ws + WS_BIG + BIG_Q), (const bf16_t*)(ws + WS_BIG + BIG_K), (const bf16_t*)(ws + WS_BIG + BIG_VV), (bf16_t*)(ws + WS_BIG + BIG_O), KIN(16) + j * 16, lastl ? 2048 : 2048 + 128, bid, G); }
            SEAM(pb + 1);
            if (SITE(7) && IN(pb + 2)) { WAVE_IDS(); unsigned char* ws = KWS();
                pg8::Gemm g{(const bf16_t*)(ws + WS_BIG + BIG_O), (const bf16_t*)(ws + WS_WO) + (size_t)j * 1024 * 1024, nullptr}; pg8::GroupedOrder<4, 0> S; S.init(mrows / 256, 1, G, bid);
                EpiResAdd E{KOUT(), (float*)(ws + WS_XC), (const float*)(ws + WS_MOD) + (size_t)layer * 17 * 6144 + 2048};
                pg8::gemm_phase<EpiResAdd, pg8::GroupedOrder<4, 0>, false, 1024, 0>(lds, g, S, E); }
            SEAM(pb + 2);
        }
        if (SITE(8) && IN(pb + 3)) { WAVE_IDS(); unsigned char* ws = KWS();
            n2_phase(lds, mrows, KOUT(), (const float*)(ws + WS_XC), (const float*)(ws + WS_MOD) + (size_t)layer * 17 * 6144, KIN(7) + layer * 1024, KIN(18) + (size_t)layer * 1024 * 16,
                     (bf16_t*)(ws + WS_H), (float*)(ws + WS_AFF), gw, NGW, lane); }
        SEAM(pb + 3);
        if (SITE(9) && IN(pb + 4)) { WAVE_IDS(); unsigned char* ws = KWS();
            const float* aff = (const float*)(ws + WS_AFF); int* rowidx = (int*)(ws + WS_ROWIDX); float* gate = (float*)(ws + WS_GATE); int* tokslot = (int*)(ws + WS_TOKSLOT);
            for (int p = bid; p < 256; p += G) { const int b = p >> 4, e = p & 15; tk_problem(lds, aff, b * 4096, 4096, CAPL, e, e * SLOTS_E + b * CAPL, rowidx, gate, tokslot + (size_t)e * MT); }
            if (!lastl) for (int p = bid; p < 256; p += G) { const int b = p >> 4, e = p & 15; tk_problem(lds, aff, ML + b * 256, 256, CAPC, e, e * SLOTS_E + NB * CAPL + b * CAPC, rowidx, gate, tokslot + (size_t)e * MT); }
        }
        SEAM(pb + 4);
        const int nMe = lastl ? 32 : 34;
        if (SITE(10) && IN(pb + 5)) { WAVE_IDS(); unsigned char* ws = KWS();
            pg8::Gemm g{(const bf16_t*)(ws + WS_H), (const bf16_t*)(ws + WS_W13) + (size_t)layer * 16 * 4096 * 1024, (const int*)(ws + WS_ROWIDX)}; pg8::GroupedOrder<16, 34> S; S.init(nMe, 16, G, bid);
            EpiSwiGLU E{(bf16_t*)(ws + WS_BIG)};
            pg8::gemm_phase<EpiSwiGLU, pg8::GroupedOrder<16, 34>, true, 1024, (size_t)4096 * 1024 * 2>(lds, g, S, E); }
        SEAM(pb + 5);
        if (SITE(11) && IN(pb + 6)) { WAVE_IDS(); unsigned char* ws = KWS();
            pg8::Gemm g{(const bf16_t*)(ws + WS_BIG), (const bf16_t*)(ws + WS_W2) + (size_t)layer * 16 * 1024 * 2048, nullptr}; pg8::GroupedOrder<4, 34> S; S.init(nMe, 16, G, bid);
            EpiGateY E{(bf16_t*)(ws + WS_Y), (const float*)(ws + WS_GATE)};
            pg8::gemm_phase<EpiGateY, pg8::GroupedOrder<4, 34>, false, 2048, (size_t)1024 * 2048 * 2>(lds, g, S, E); }
        SEAM(pb + 6);
        if (SITE(12) && IN(pb + 7)) { WAVE_IDS(); unsigned char* ws = KWS();
            const float* modl = (const float*)(ws + WS_MOD) + (size_t)layer * 17 * 6144;
            if (!lastl) n1_phase(1, MT, nullptr, nullptr, KOUT(), (float*)(ws + WS_XC), (const bf16_t*)(ws + WS_Y), (const int*)(ws + WS_TOKSLOT), modl, modl + 17 * 6144, KIN(6) + (layer + 1) * 1024, (bf16_t*)(ws + WS_H), gw, NGW, lane);
            else n1_phase(2, ML, nullptr, nullptr, KOUT(), (float*)(ws + WS_XC), (const bf16_t*)(ws + WS_Y), (const int*)(ws + WS_TOKSLOT), modl, nullptr, KIN(22), nullptr, gw, NGW, lane);
        }
        SEAM(pb + 7);
    }
#undef IN
#undef SEAM
}

extern "C" void kernel_launch(void* const* d_in, const int* in_sizes, int n_in, void* d_out, int out_size, void* d_ws, size_t ws_size, hipStream_t stream) {
    static int grid = 0;
    if (grid == 0) {
        if (n_in != 23 || out_size != ML * D || ws_size < WS_END) { fprintf(stderr, "kernel_launch: unexpected shapes (n_in %d, out %d, ws %zu); nothing launched\n", n_in, out_size, ws_size); grid = -1; return; }
        int dev = 0, cus = 0, per_cu = 0;
        if (hipGetDevice(&dev) != hipSuccess || hipDeviceGetAttribute(&cus, hipDeviceAttributeMultiprocessorCount, dev) != hipSuccess) { grid = -1; return; }
        if (hipFuncSetAttribute((const void*)mega_fwd, hipFuncAttributeMaxDynamicSharedMemorySize, LDS_BYTES) != hipSuccess) { fprintf(stderr, "kernel_launch: hipFuncSetAttribute failed\n"); grid = -1; return; }
        if (hipOccupancyMaxActiveBlocksPerMultiprocessor(&per_cu, (const void*)mega_fwd, 512, LDS_BYTES) != hipSuccess || per_cu < 1)
            fprintf(stderr, "kernel_launch: note: occupancy query reports %d workgroups per CU\n", per_cu);
        (void)hipGetLastError();
        grid = cus;
    }
    if (grid < 0) return;
    if (hipMemsetAsync((char*)d_ws + WS_CTL, 0, CTL_ZERO_BYTES, stream) != hipSuccess) return;
    Args a{};
    for (int i = 0; i < 23; ++i) a.in[i] = (const float*)d_in[i];
    a.out = (float*)d_out; a.ws = (unsigned char*)d_ws;
    constexpr int NPH = 2 + 8 * DEPTH;
#if MK_SPLIT
    for (int p = 0; p < NPH; ++p) { a.ph_lo = p; a.ph_hi = p + 1; hipLaunchKernelGGL(mega_fwd, dim3(grid), dim3(512), LDS_BYTES, stream, a); }
#else
    a.ph_lo = 0; a.ph_hi = NPH;
    hipLaunchKernelGGL(mega_fwd, dim3(grid), dim3(512), LDS_BYTES, stream, a);
#endif
    const hipError_t le = hipPeekAtLastError();
    if (le != hipSuccess) fprintf(stderr, "kernel_launch: launch failed: %s\n", hipGetErrorName(le));
}
```

```cpp
#define E1_NT 1
#include <hip/hip_runtime.h>
#include <cstdio>
#include <cstdint>

#define LAS __attribute__((address_space(3)))
#define GAS __attribute__((address_space(1)))
typedef unsigned short bf16_t;
typedef short bf16x8 __attribute__((ext_vector_type(8)));
typedef short s16x4 __attribute__((ext_vector_type(4)));
typedef float f32x4 __attribute__((ext_vector_type(4)));
typedef float f32x2 __attribute__((ext_vector_type(2)));
typedef float f32x16 __attribute__((ext_vector_type(16)));
typedef unsigned u32x4 __attribute__((ext_vector_type(4)));
typedef unsigned u32x2 __attribute__((ext_vector_type(2)));
typedef short v4i16_t __attribute__((ext_vector_type(4)));
#define DI __device__ __forceinline__

#ifndef MK_SPLIT
#define MK_SPLIT 0
#endif

constexpr int D = 1024, NB = 16, SEQ = 4096, CTX = 256, DEPTH = 4;
constexpr int ML = NB * SEQ, MC = NB * CTX, MT = ML + MC;
constexpr int DA = 2048, NE = 16, CAPL = 512, CAPC = 32;
constexpr int SLOTS_E = NB * CAPL + NB * CAPC;
constexpr int NSLOT = NE * SLOTS_E;
constexpr int DFF = 2048, NQKV = 1536;
constexpr float EPS = 1e-6f;
constexpr float LOG2E = 1.4426950408889634f;
constexpr float W13_SCALE = 32.0f, W2_SCALE = 64.0f, Y_SCALE = 32.0f, WM_SCALE = 32.0f;
constexpr float QSCALE = 0.125f * LOG2E;

constexpr size_t MiB = 1u << 20;
constexpr size_t WS_CTL = 0, CTL_ZERO_BYTES = 1 * MiB;
constexpr size_t WS_MOD = 1 * MiB;
constexpr size_t WS_ROPE = 3 * MiB;
constexpr size_t WS_AFF = 4 * MiB;
constexpr size_t WS_TOKSLOT = 9 * MiB;
constexpr size_t WS_ROWIDX = 14 * MiB;
constexpr size_t WS_GATE = 15 * MiB;
constexpr size_t WS_STATS = 16 * MiB;
constexpr size_t WS_XC = 34 * MiB;
constexpr size_t WS_WIN = 50 * MiB;
constexpr size_t WS_WOUT = 66 * MiB;
constexpr size_t WS_WQKV = 74 * MiB;
constexpr size_t WS_WO = 80 * MiB;
constexpr size_t WS_WSP = 84 * MiB;
constexpr size_t WS_W13 = 86 * MiB;
constexpr size_t WS_W2 = 598 * MiB;
constexpr size_t WS_H = 854 * MiB;
constexpr size_t WS_BIG = 990 * MiB;
constexpr size_t WS_Y = 1534 * MiB;
constexpr size_t WS_X = 1806 * MiB;
constexpr size_t WS_END = 1942 * MiB;
constexpr size_t BIG_U = 0, BIG_V = (size_t)MT * 2048 * 2;
constexpr size_t BIG_Q = 0, BIG_K = (size_t)MT * 1024 * 2, BIG_VV = BIG_K + (size_t)MT * 256 * 2, BIG_O = BIG_VV + (size_t)MT * 256 * 2;
static_assert(BIG_O + (size_t)MT * 1024 * 2 <= 544 * MiB && (size_t)NSLOT * 2048 * 2 <= 544 * MiB && BIG_V + (size_t)MT * 2048 * 2 <= 544 * MiB, "big region");
static_assert(WS_STATS + (size_t)MT * 64 * 4 <= WS_XC && WS_AFF + (size_t)MT * 64 <= WS_TOKSLOT && WS_TOKSLOT + (size_t)MT * 64 <= WS_ROWIDX, "ws map");
constexpr int CW_BAR = 4096;
constexpr int CW_STEAL = 1024;

constexpr int RING_BYTES = 131072;
constexpr int MISC_OFF = RING_BYTES + 320;
constexpr int XCH_OFF = RING_BYTES + 1024;
constexpr int LDS_BYTES = 147456;
static_assert(MISC_OFF + 128 <= XCH_OFF && XCH_OFF + 8192 <= LDS_BYTES, "LDS map");

DI unsigned pk2(float lo, float hi) { unsigned r; asm("v_cvt_pk_bf16_f32 %0, %1, %2" : "=v"(r) : "v"(lo), "v"(hi)); return r; }
DI unsigned pk4_fp8(float a, float b, float c, float d) { int p = __builtin_amdgcn_cvt_pk_fp8_f32(a, b, 0, false); p = __builtin_amdgcn_cvt_pk_fp8_f32(c, d, p, true); return (unsigned)p; }
#ifndef E1_NT
#define E1_NT 0
#endif
#ifndef FP8_ATT
#define FP8_ATT 1
#endif
#ifndef ABL_E1
#define ABL_E1 0
#endif
#ifndef ROTK_MASK
#define ROTK_MASK 0
#endif
#ifndef FP8D_SIM
#define FP8D_SIM 0
#endif
DI float sim8(float v, bool on) { if (!FP8D_SIM || !on) return v; const int p = __builtin_amdgcn_cvt_pk_fp8_f32(v, v, 0, false); return __builtin_amdgcn_cvt_f32_fp8(p, 0); }
DI float bflo(unsigned w) { return __uint_as_float(w << 16); }
DI float bfhi(unsigned w) { return __uint_as_float(w & 0xffff0000u); }
typedef unsigned u32v2_t __attribute__((ext_vector_type(2)));
#define DPP_F(v, ctrl) __uint_as_float((unsigned)__builtin_amdgcn_mov_dpp((int)__float_as_uint(v), ctrl, 0xF, 0xF, true))
#define DPP_I(v, ctrl) __builtin_amdgcn_mov_dpp((v), ctrl, 0xF, 0xF, true)
DI float xor1_f(float v) { return DPP_F(v, 0xB1); }
DI float xor2_f(float v) { return DPP_F(v, 0x4E); }
DI float row16_sum(float v) { v += DPP_F(v, 0xB1); v += DPP_F(v, 0x4E); v += DPP_F(v, 0x141); v += DPP_F(v, 0x140); return v; }
DI float row16_max(float v) { v = fmaxf(v, DPP_F(v, 0xB1)); v = fmaxf(v, DPP_F(v, 0x4E)); v = fmaxf(v, DPP_F(v, 0x141)); v = fmaxf(v, DPP_F(v, 0x140)); return v; }
DI int row16_sum_i(int v) { v += DPP_I(v, 0xB1); v += DPP_I(v, 0x4E); v += DPP_I(v, 0x141); v += DPP_I(v, 0x140); return v; }
DI float x16_sum(float v) { const unsigned x = __float_as_uint(v); const u32v2_t r = __builtin_amdgcn_permlane16_swap(x, x, false, false); return __uint_as_float(r[0]) + __uint_as_float(r[1]); }
DI float x32_sum(float v) { const unsigned x = __float_as_uint(v); const u32v2_t r = __builtin_amdgcn_permlane32_swap(x, x, false, false); return __uint_as_float(r[0]) + __uint_as_float(r[1]); }
DI float x32_max(float v) { const unsigned x = __float_as_uint(v); const u32v2_t r = __builtin_amdgcn_permlane32_swap(x, x, false, false); return fmaxf(__uint_as_float(r[0]), __uint_as_float(r[1])); }
DI int x16_sum_i(int v) { const u32v2_t r = __builtin_amdgcn_permlane16_swap((unsigned)v, (unsigned)v, false, false); return (int)(r[0] + r[1]); }
DI int x32_sum_i(int v) { const u32v2_t r = __builtin_amdgcn_permlane32_swap((unsigned)v, (unsigned)v, false, false); return (int)(r[0] + r[1]); }
DI float wave_sum(float v) { return x32_sum(x16_sum(row16_sum(v))); }
DI int wave_sum_i(int v) { return x32_sum_i(x16_sum_i(row16_sum_i(v))); }
DI int tid_opaque() { int t = threadIdx.x; asm volatile("" : "+v"(t)); return t; }
#define LDS_WAIT() asm volatile("s_waitcnt lgkmcnt(0)" ::: "memory")
#define VM_WAIT() asm volatile("s_waitcnt vmcnt(0)" ::: "memory")
#define RLX_AGENT __ATOMIC_RELAXED, __HIP_MEMORY_SCOPE_AGENT

#define XB_TMO      128
#define XB_XCNT(j)  (256  + 64 * (j))
#define XB_XSUB(j)  (1280 + 64 * (j))
#define XB_XGEN(j)  (2304 + 64 * (j))
#define XB_TOP      3328
#define XB_TOPGEN   3392
#define XCD_BAR_WORDS 3456
#define XB_SPIN_CAP (1u << 18)
DI unsigned xb_ld(unsigned* p)              { return __hip_atomic_load(p, __ATOMIC_RELAXED, __HIP_MEMORY_SCOPE_AGENT); }
DI unsigned xb_add(unsigned* p, unsigned v) { return __hip_atomic_fetch_add(p, v, __ATOMIC_RELAXED, __HIP_MEMORY_SCOPE_AGENT); }
DI unsigned xb_xcc_id() { return (unsigned)__builtin_amdgcn_s_getreg((3 << 11) | 20) & 0xFu; }
#define XB_SPIN(cond, bar) do { unsigned _sp = 0; while (cond) { __builtin_amdgcn_s_sleep(1); \
    if ((++_sp & 255u) == 0u) { if (xb_ld(&(bar)[XB_TMO])) break; if (_sp > XB_SPIN_CAP) { atomicAdd(&(bar)[XB_TMO], 1u); break; } } } } while (0)
struct XcdBarrier { unsigned* bar; unsigned x; volatile LAS unsigned* st; };
DI XcdBarrier xcd_barrier_post(unsigned* bar, volatile LAS unsigned* st) {
    XcdBarrier b; b.bar = bar; b.x = (unsigned)__builtin_amdgcn_readfirstlane((int)xb_xcc_id()); b.st = st;
    if (threadIdx.x == 0) (void)xb_add(&bar[XB_XCNT(b.x)], 1u);
    return b;
}
DI void xcd_barrier_complete(unsigned* bar, unsigned x, unsigned& nloc, unsigned& nx) {
    const unsigned G = gridDim.x * gridDim.y * gridDim.z;
    unsigned sum, cnt, mine, sp = 0u;
    for (;;) {
        sum = 0u; cnt = 0u; mine = 0u;
#pragma unroll
        for (unsigned j = 0; j < 16; ++j) { const unsigned c = xb_ld(&bar[XB_XCNT(j)]); sum += c; cnt += (c > 0u) ? 1u : 0u; mine = (j == x) ? c : mine; }
        if (sum == G) break;
        __builtin_amdgcn_s_sleep(1);
        if ((++sp & 255u) == 0u) { if (xb_ld(&bar[XB_TMO])) break; if (sp > XB_SPIN_CAP) { atomicAdd(&bar[XB_TMO], 1u); break; } }
    }
    nloc = mine > 0u ? mine : 1u; nx = cnt > 0u ? cnt : 1u;
}
DI void xcd_barrier(const XcdBarrier& b) {
    asm volatile("s_waitcnt vmcnt(0)" ::: "memory");
    __syncthreads();
    if (threadIdx.x == 0) {
        unsigned* bar = b.bar;
        __builtin_amdgcn_s_waitcnt(0);
        unsigned bx = b.x; asm volatile("" : "+s"(bx));
        unsigned nloc = b.st[0], nx = b.st[1];
        if (nloc == 0u) { xcd_barrier_complete(bar, bx, nloc, nx); b.st[0] = nloc; b.st[1] = nx; }
        const unsigned old = xb_add(&bar[XB_XSUB(bx)], 1u);
        const unsigned gen = old / nloc;
        if (old + 1u == (gen + 1u) * nloc) {
            __builtin_amdgcn_fence(__ATOMIC_RELEASE, "agent");
            asm volatile("s_waitcnt vmcnt(0)" ::: "memory");
            const unsigned og = xb_add(&bar[XB_TOP], 1u);
            const unsigned tg = og / nx;
            if (og + 1u == (tg + 1u) * nx) xb_add(&bar[XB_TOPGEN], 1u);
            else XB_SPIN(xb_ld(&bar[XB_TOPGEN]) == tg, bar);
            __builtin_amdgcn_fence(__ATOMIC_ACQUIRE, "agent");
            xb_add(&bar[XB_XGEN(bx)], 1u);
            asm volatile("s_waitcnt vmcnt(0)" ::: "memory");
        } else {
            XB_SPIN(xb_ld(&bar[XB_XGEN(bx)]) == gen, bar);
            __builtin_amdgcn_fence(__ATOMIC_ACQUIRE, "agent");
            asm volatile("s_waitcnt vmcnt(0)" ::: "memory");
        }
    }
    __syncthreads();
}

#ifndef FP8_MMA
#define FP8_MMA 3
#endif
#ifndef EPI_TWICE
#define EPI_TWICE 0
#endif
namespace pg8 {
constexpr int BM = 256, BK = 64, HALF = 128, HTB = HALF * BK * 2, STAGE_BYTES = 8 * HTB, NXCD = 8, WGM = 8;
__host__ __device__ __forceinline__ int lds_byte(int r, int c) { const int st = (r >> 4) * 2 + (c >> 5), rr = r & 15, cc = c & 31, ob = rr * 64 + cc * 2; return st * 1024 + (ob ^ (((ob >> 9) & 1) << 5)); }
__host__ __device__ __forceinline__ void stage_rc(int b, int& R, int& C) { const int st = b / 1024, sb = b % 1024, swz = sb ^ (((sb >> 9) & 1) << 5); R = (st >> 1) * 16 + swz / 64; C = (st & 1) * 32 + (swz % 64) / 2; }
__host__ __device__ __forceinline__ int perm32(int rho) { const int n = rho >> 4, i = rho & 15; return 8 * (i >> 2) + 4 * n + (i & 3); }

struct Unit { int pm, pn, e; };
struct Gemm { const bf16_t* A; const bf16_t* Bt; const int* rowidx; };

template <int NN, int MSTRIDE, bool REV = false>
struct GroupedOrder {
    int nM, nwg, G, c;
    __device__ void init(int nM_, int ngroups, int G_, int c_) { nM = nM_; nwg = nM_ * NN * ngroups; G = G_; c = c_; }
    __device__ bool next(int i, Unit& u) const {
        const int L = i * G + c; if (L >= nwg) return false;
        int wgid = L; { const int q = nwg / NXCD, r = nwg % NXCD, xcd = wgid % NXCD; int off = wgid / NXCD; if (REV) off = (xcd < r ? q : q - 1) - off;
            wgid = (xcd < r ? xcd * (q + 1) : r * (q + 1) + (xcd - r) * q) + off; }
        const int per = nM * NN, e = wgid / per, rr = wgid % per;
        constexpr int nig = WGM * NN; const int gid = rr / nig, fm = gid * WGM, gsz = (nM - fm) < WGM ? (nM - fm) : WGM;
        u.pm = e * MSTRIDE + fm + ((rr % nig) % gsz); u.pn = (rr % nig) / gsz; u.e = e; return true;
    }
};

typedef int v8i_t __attribute__((ext_vector_type(8)));
typedef int v4i_t __attribute__((ext_vector_type(4)));
typedef long v2l_t __attribute__((ext_vector_type(2)));
DI const char* sptr(const char* p) {
    const unsigned long long v = (unsigned long long)p; const unsigned lo = (unsigned)__builtin_amdgcn_readfirstlane((int)(unsigned)v), hi = (unsigned)__builtin_amdgcn_readfirstlane((int)(unsigned)(v >> 32));
    return (const char*)(((unsigned long long)hi << 32) | lo); }
DI v8i_t ld32(const LAS unsigned char* p0, const LAS unsigned char* p1) {
    const v4i_t a = *(const LAS v4i_t*)p0, b = *(const LAS v4i_t*)p1; return __builtin_shufflevector(a, b, 0, 1, 2, 3, 4, 5, 6, 7); }
DI f32x4 mma_fp8(const v8i_t X, const v8i_t Y, f32x4 c, const int sc) {
#if FP8_MMA == 3
    asm volatile("v_mfma_scale_f32_16x16x128_f8f6f4 %0, %1, %2, %0, %3, %3 op_sel_hi:[0,0,0]" : "+v"(c) : "v"(X), "v"(Y), "v"(sc));
    return c;
#elif FP8_MMA == 2
    return __builtin_amdgcn_mfma_scale_f32_16x16x128_f8f6f4(X, Y, c, 0, 0, 0, 0x7F7F7F7F, 0, 0x7F7F7F7F);
#else
    const v4i_t xl = __builtin_shufflevector(X, X, 0, 1, 2, 3), xh = __builtin_shufflevector(X, X, 4, 5, 6, 7), yl = __builtin_shufflevector(Y, Y, 0, 1, 2, 3), yh = __builtin_shufflevector(Y, Y, 4, 5, 6, 7);
    const v2l_t x0 = __builtin_bit_cast(v2l_t, xl), x1 = __builtin_bit_cast(v2l_t, xh), y0 = __builtin_bit_cast(v2l_t, yl), y1 = __builtin_bit_cast(v2l_t, yh);
    c = __builtin_amdgcn_mfma_f32_16x16x32_fp8_fp8(x0[0], y0[0], c, 0, 0, 0); c = __builtin_amdgcn_mfma_f32_16x16x32_fp8_fp8(x0[1], y0[1], c, 0, 0, 0);
    c = __builtin_amdgcn_mfma_f32_16x16x32_fp8_fp8(x1[0], y1[0], c, 0, 0, 0); c = __builtin_amdgcn_mfma_f32_16x16x32_fp8_fp8(x1[1], y1[1], c, 0, 0, 0);
    return c;
#endif
}
DI unsigned cvt_pk_bf16(float lo, float hi) { unsigned r; asm volatile("v_cvt_pk_bf16_f32 %0, %1, %2" : "=v"(r) : "v"(lo), "v"(hi)); return r; }

template <class Epi, class Sched, bool GATHER, int K, size_t BSTRIDE, int STAG = 0, bool ALIGN = true, int ESZ = 2, bool ROTK = false, int ABL = 0>
DI void gemm_phase(LAS unsigned char* lds, const Gemm g, const Sched& S, const Epi& E) {
    if constexpr (STAG > 0) { const int ng = (int)((blockIdx.x * 5u) & 7u); for (int i = 0; i < ng; ++i) __builtin_amdgcn_s_sleep(STAG); }
    const int tid = tid_opaque(), wid = __builtin_amdgcn_readfirstlane(tid >> 6), lane = tid & 63, wr = wid >> 2, wc = wid & 3, fr = lane & 15, fq = lane >> 4;
    constexpr int RB = K * ESZ, nt = RB / 128;
    int fp8sc = 0x7F7F7F7F; asm volatile("" : "+v"(fp8sc));
    unsigned voffA[2], voffB[2];
#pragma unroll
    for (int i = 0; i < 2; ++i) { int R, C; stage_rc(tid * 16 + i * 8192, R, C); const int Rb = Epi::PERM ? ((R & ~31) + perm32(R & 31)) : R;
        voffA[i] = (unsigned)(R * RB + C * 2); voffB[i] = (unsigned)(Rb * RB + C * 2); }
    constexpr size_t kstep = (size_t)(BK * 2);
    constexpr size_t hstep = (size_t)HALF * RB;
    constexpr size_t tstep = 2 * hstep;
    const unsigned ldsw = (unsigned)wid * 1024u;
    const int aoff = lds_byte(wr * 64 + fr, fq * 8), boff = lds_byte(wc * 32 + fr, fq * 8);
#define PG8_SA(b, h) (((b) * 2 + (h)) * HTB)
#define PG8_SB(b, h) ((4 + (b) * 2 + (h)) * HTB)
#define PG8_STAGE(bufoff, gbase, voff) do { if constexpr (ABL & 1) break; const char* _gb = sptr((const char*)(gbase)); _Pragma("unroll") for (int _i = 0; _i < 2; ++_i) \
        __builtin_amdgcn_global_load_lds((const unsigned*)(_gb + (voff)[_i]), (LAS unsigned*)(lds + (bufoff) + ldsw + _i * 8192), 16, 0, 0); } while (0)
#define PG8_STAGE_AC(bufoff, kb, h) do { if constexpr (GATHER) PG8_STAGE(bufoff, Ab + (kb), cOff[h]); else PG8_STAGE(bufoff, cA + (h) * hstep + (kb), voffA); } while (0)
#define PG8_STAGE_AN(bufoff, kb, h) do { if constexpr (GATHER) { if (last) PG8_STAGE(bufoff, Ab + (kb), nOff[h]); else PG8_STAGE(bufoff, Ab + (kb), cOff[h]); } \
        else PG8_STAGE(bufoff, (last ? nA : cA) + (h) * hstep + (kb), voffA); } while (0)
#define PG8_LDA(dst, b, h) do { if constexpr ((ABL & 4) || (ABL & 32)) break; if constexpr (ESZ == 2) { _Pragma("unroll") for (int m = 0; m < 4; ++m) _Pragma("unroll") for (int k = 0; k < 2; ++k) dst[m][k] = *(const LAS bf16x8*)(lds + PG8_SA(b, h) + aoff + m * 2048 + k * 1024); } \
        else { _Pragma("unroll") for (int m = 0; m < 4; ++m) dst##8[m] = ld32(lds + PG8_SA(b, h) + aoff + m * 2048, lds + PG8_SA(b, h) + aoff + m * 2048 + 1024); } } while (0)
#define PG8_LDB(dst, b, h) do { if constexpr ((ABL & 4) || (ABL & 16)) break; if constexpr (ESZ == 2) { _Pragma("unroll") for (int n = 0; n < 2; ++n) _Pragma("unroll") for (int k = 0; k < 2; ++k) dst[n][k] = *(const LAS bf16x8*)(lds + PG8_SB(b, h) + boff + n * 2048 + k * 1024); } \
        else { _Pragma("unroll") for (int n = 0; n < 2; ++n) dst##8[n] = ld32(lds + PG8_SB(b, h) + boff + n * 2048, lds + PG8_SB(b, h) + boff + n * 2048 + 1024); } } while (0)
#define PG8_MMA(ai, bj, At, Bt) do { if constexpr (ABL & 2) break; if constexpr (!(ABL & 64)) __builtin_amdgcn_s_setprio(1); _Pragma("unroll") for (int m = 0; m < 4; ++m) _Pragma("unroll") for (int n = 0; n < 2; ++n) { \
        if constexpr (ESZ == 2) { _Pragma("unroll") for (int k = 0; k < 2; ++k) acc[ai][bj][m][n] = __builtin_amdgcn_mfma_f32_16x16x32_bf16(Bt[n][k], At[m][k], acc[ai][bj][m][n], 0, 0, 0); } \
        else acc[ai][bj][m][n] = mma_fp8(Bt##8[n], At##8[m], acc[ai][bj][m][n], fp8sc); } if constexpr (!(ABL & 64)) __builtin_amdgcn_s_setprio(0); } while (0)
#define PG8_WAIT_V(n) asm volatile("s_waitcnt vmcnt(" #n ")" ::: "memory")
#define PG8_WAIT_L(n) asm volatile("s_waitcnt lgkmcnt(" #n ")" ::: "memory")
#define PG8_BAR __builtin_amdgcn_s_barrier()
#define PG8_SCHED __builtin_amdgcn_sched_barrier(0)
#define PG8_AOFF(dst, u) do { int _t = threadIdx.x; asm volatile("" : "+v"(_t)); _Pragma("unroll") for (int _h = 0; _h < 2; ++_h) _Pragma("unroll") for (int _i = 0; _i < 2; ++_i) { int _R, _C; stage_rc(_t * 16 + _i * 8192, _R, _C); \
        const int _row = g.rowidx[(u).pm * BM + _h * HALF + _R]; dst[_h][_i] = (unsigned)_row * (unsigned)RB + (unsigned)_C * 2u; } } while (0)
    Unit cur, nxt; int ui = 0;
    if (!S.next(0, cur)) return;
#define PG8_KOFF(s_, i_) ((size_t)(ROTK ? (((s_) + (i_)) & (nt - 1)) : (i_)) * kstep)
    int rs_c = ROTK ? __builtin_amdgcn_readfirstlane((cur.pm + 2 * cur.pn) & 7) : 0, rs_n = 0; (void)rs_n;
    f32x4 acc[2][2][4][2];
#pragma unroll
    for (int a = 0; a < 2; ++a)
#pragma unroll
        for (int b = 0; b < 2; ++b)
#pragma unroll
            for (int m = 0; m < 4; ++m)
#pragma unroll
                for (int n = 0; n < 2; ++n) acc[a][b][m][n] = (f32x4){0.f, 0.f, 0.f, 0.f};
    bf16x8 At[4][2], B0[2][2], B1[2][2]; v8i_t At8[4], B08[2], B18[2]; (void)At; (void)B0; (void)B1; (void)At8; (void)B08; (void)B18;
    if constexpr (ABL & (4 | 16 | 32 | 128)) { for (int m = 0; m < 4; ++m) { At8[m] = (v8i_t){0, 0, 0, 0, 0, 0, 0, 0}; for (int k = 0; k < 2; ++k) At[m][k] = (bf16x8){0, 0, 0, 0, 0, 0, 0, 0}; } for (int n = 0; n < 2; ++n) { B08[n] = B18[n] = (v8i_t){0, 0, 0, 0, 0, 0, 0, 0}; for (int k = 0; k < 2; ++k) B0[n][k] = B1[n][k] = (bf16x8){0, 0, 0, 0, 0, 0, 0, 0}; } }
    unsigned cOff[2][2], nOff[2][2];
    const char* Ab = (const char*)g.A;
    const char* cA = Ab; const char* nA = Ab;
    if constexpr (GATHER) { PG8_AOFF(cOff, cur); } else { cA = Ab + (size_t)cur.pm * tstep; }
    const char* cB = (const char*)g.Bt + (size_t)cur.e * BSTRIDE + (size_t)cur.pn * tstep;
    { const size_t K0 = PG8_KOFF(rs_c, 0); PG8_STAGE(PG8_SB(0, 0), cB + K0, voffB); PG8_STAGE(PG8_SB(0, 1), cB + hstep + K0, voffB); PG8_STAGE_AC(PG8_SA(0, 0), K0, 0); PG8_STAGE_AC(PG8_SA(0, 1), K0, 1); }
    if (wr == 1) PG8_BAR;
    PG8_WAIT_V(2); PG8_BAR;
    { const size_t K1 = PG8_KOFF(rs_c, 1); PG8_STAGE(PG8_SB(1, 0), cB + K1, voffB); PG8_STAGE_AC(PG8_SA(1, 0), K1, 0); PG8_STAGE(PG8_SB(1, 1), cB + hstep + K1, voffB); }
    PG8_WAIT_V(6); PG8_BAR;
    for (;;) {
        const bool has_next = S.next(ui + 1, nxt);
        const char* nB = has_next ? (const char*)g.Bt + (size_t)nxt.e * BSTRIDE + (size_t)nxt.pn * tstep : cB;
        if constexpr (GATHER) {
            if (has_next) { PG8_AOFF(nOff, nxt); }
            else {
#pragma unroll
                for (int h = 0; h < 2; ++h)
#pragma unroll
                    for (int i = 0; i < 2; ++i) nOff[h][i] = cOff[h][i];
            }
        } else nA = has_next ? Ab + (size_t)nxt.pm * tstep : cA;
        if constexpr (ROTK) rs_n = has_next ? __builtin_amdgcn_readfirstlane((nxt.pm + 2 * nxt.pn) & 7) : rs_c;
#pragma unroll 1
        for (int t = 0; t < nt; t += 2) {
            const bool last = (t == nt - 2);
            const size_t k1 = PG8_KOFF(rs_c, t + 1), k2 = last ? PG8_KOFF(rs_n, 0) : PG8_KOFF(rs_c, t + 2), k3 = last ? PG8_KOFF(rs_n, 1) : PG8_KOFF(rs_c, t + 3);
            const char* b2 = (last ? nB : cB) + k2; const char* b3 = (last ? nB : cB) + k3;
            PG8_LDB(B0, 0, 0); if constexpr (!(ABL & 128)) PG8_LDB(B1, 0, 1); PG8_SCHED; PG8_LDA(At, 0, 0); PG8_STAGE_AC(PG8_SA(1, 1), k1, 1);
            PG8_WAIT_V(8); PG8_WAIT_L(0); PG8_BAR; PG8_MMA(0, 0, At, B0); PG8_MMA(0, 1, At, B1); PG8_BAR; PG8_SCHED;
            PG8_LDA(At, 0, 1); PG8_STAGE(PG8_SB(0, 0), b2, voffB); PG8_STAGE(PG8_SB(0, 1), b2 + hstep, voffB); PG8_STAGE_AN(PG8_SA(0, 0), k2, 0);
            PG8_WAIT_V(8); PG8_WAIT_L(0); PG8_BAR; PG8_MMA(1, 0, At, B0); PG8_MMA(1, 1, At, B1); PG8_BAR; PG8_SCHED;
            PG8_LDB(B0, 1, 0); if constexpr (!(ABL & 128)) PG8_LDB(B1, 1, 1); PG8_SCHED; PG8_LDA(At, 1, 0); PG8_STAGE_AN(PG8_SA(0, 1), k2, 1);
            PG8_WAIT_V(8); PG8_WAIT_L(0); PG8_BAR; PG8_MMA(0, 0, At, B0); PG8_MMA(0, 1, At, B1); PG8_BAR; PG8_SCHED;
            PG8_LDA(At, 1, 1); PG8_STAGE(PG8_SB(1, 0), b3, voffB); PG8_STAGE(PG8_SB(1, 1), b3 + hstep, voffB); PG8_STAGE_AN(PG8_SA(1, 0), k3, 0);
            PG8_WAIT_V(8); PG8_WAIT_L(0); PG8_BAR; PG8_MMA(1, 0, At, B0); PG8_MMA(1, 1, At, B1); PG8_BAR; PG8_SCHED;
        }
        if constexpr (ESZ == 1 && FP8_MMA == 3) asm volatile("s_nop 15\n\ts_nop 15\n\ts_nop 15" ::: "memory");
        if constexpr (ALIGN) { if (wr == 0) PG8_BAR; }
        if constexpr (!(ABL & 8)) E(acc, cur, wr, wc, fr, fq);
        if constexpr (GATHER) { if (EPI_TWICE) { asm volatile("" ::: "memory"); E(acc, cur, wr, wc, fr, fq); } }
        if (!has_next) break;
#pragma unroll
        for (int a = 0; a < 2; ++a)
#pragma unroll
            for (int b = 0; b < 2; ++b)
#pragma unroll
                for (int m = 0; m < 4; ++m)
#pragma unroll
                    for (int n = 0; n < 2; ++n) acc[a][b][m][n] = (f32x4){0.f, 0.f, 0.f, 0.f};
        cur = nxt; cB = nB; cA = nA; ++ui; if constexpr (ROTK) rs_c = rs_n;
        if constexpr (GATHER) {
#pragma unroll
            for (int h = 0; h < 2; ++h)
#pragma unroll
                for (int i = 0; i < 2; ++i) cOff[h][i] = nOff[h][i];
        }
        if constexpr (ALIGN) { if (wr == 1) PG8_BAR; }
    }
    PG8_WAIT_V(0);
    if constexpr (!ALIGN) { if (wr == 0) PG8_BAR; }
    PG8_BAR;
#undef PG8_SA
#undef PG8_SB
#undef PG8_STAGE
#undef PG8_STAGE_AC
#undef PG8_STAGE_AN
#undef PG8_LDA
#undef PG8_LDB
#undef PG8_MMA
#undef PG8_WAIT_V
#undef PG8_WAIT_L
#undef PG8_BAR
#undef PG8_SCHED
#undef PG8_AOFF
#undef PG8_KOFF
}
}

using pg8::Unit;
DI f32x2 gelu_tanh2(f32x2 x) {
    constexpr float K0 = -2.0f * 0.7978845608028654f * LOG2E, K1 = K0 * 0.044715f;
    const f32x2 t = x * ((x * x) * K1 + K0);
    f32x2 e; e.x = __builtin_amdgcn_exp2f(t.x); e.y = __builtin_amdgcn_exp2f(t.y);
    const f32x2 d = e + 1.0f;
    f32x2 rinv; rinv.x = __builtin_amdgcn_rcpf(d.x); rinv.y = __builtin_amdgcn_rcpf(d.y);
    return x * rinv;
}
DI f32x4 gelu_tanh4(f32x4 v) { const f32x2 a = gelu_tanh2((f32x2){v[0], v[1]}), b = gelu_tanh2((f32x2){v[2], v[3]}); return (f32x4){a.x, a.y, b.x, b.y}; }
DI f32x2 silu_mul2(f32x2 a, f32x2 b) {
    const f32x2 t = a * (-LOG2E);
    f32x2 e; e.x = __builtin_amdgcn_exp2f(t.x); e.y = __builtin_amdgcn_exp2f(t.y);
    const f32x2 d = e + 1.0f;
    f32x2 rinv; rinv.x = __builtin_amdgcn_rcpf(d.x); rinv.y = __builtin_amdgcn_rcpf(d.y);
    return (a * b) * rinv;
}
struct EpiGeluUV {
    static constexpr bool PERM = true;
    bf16_t* U; bf16_t* V; const float* bias; float* stats; LAS unsigned char* xl;
    DI void operator()(const f32x4 (&acc)[2][2][4][2], const Unit& u, int wr, int wc, int fr_in, int fq_in) const {
        int fr = fr_in, fq = fq_in; asm volatile("" : "+v"(fr), "+v"(fq));
        const int row0 = u.pm * 256 + wr * 64 + fr; const bool isV = u.pn >= 8;
        bf16_t* base = isV ? V : U; const int col0 = (u.pn & 7) * 256 + wc * 32 + 8 * fq, bcol0 = u.pn * 256 + wc * 32 + 8 * fq;
        f32x4 bv[2][2];
#pragma unroll
        for (int bj = 0; bj < 2; ++bj)
#pragma unroll
            for (int n = 0; n < 2; ++n) bv[bj][n] = *(const f32x4*)(bias + bcol0 + bj * 128 + 4 * n);
#pragma unroll
        for (int ai = 0; ai < 2; ++ai)
#pragma unroll
            for (int m = 0; m < 4; ++m) { const int row = row0 + ai * 128 + m * 16; bf16_t* rowp = base + (size_t)row * 2048 + col0; float s = 0.f, q = 0.f;
#pragma unroll
                for (int bj = 0; bj < 2; ++bj) { const f32x4 v0 = gelu_tanh4(acc[ai][bj][m][0] + bv[bj][0]), v1 = gelu_tanh4(acc[ai][bj][m][1] + bv[bj][1]);
                    s += ((v0[0] + v0[1]) + (v0[2] + v0[3])) + ((v1[0] + v1[1]) + (v1[2] + v1[3]));
                    q += ((v0[0] * v0[0] + v0[1] * v0[1]) + (v0[2] * v0[2] + v0[3] * v0[3])) + ((v1[0] * v1[0] + v1[1] * v1[1]) + (v1[2] * v1[2] + v1[3] * v1[3]));
                    u32x4 w; w.x = pg8::cvt_pk_bf16(v0[0], v0[1]); w.y = pg8::cvt_pk_bf16(v0[2], v0[3]); w.z = pg8::cvt_pk_bf16(v1[0], v1[1]); w.w = pg8::cvt_pk_bf16(v1[2], v1[3]);
                    *(u32x4*)(rowp + bj * 128) = w; }
                if (isV) { s = x32_sum(x16_sum(s)); q = x32_sum(x16_sum(q));
                    if (fq == 0) *(LAS f32x2*)(xl + ((ai * 128 + wr * 64 + m * 16 + fr) * 4 + wc) * 8) = (f32x2){s, q}; }
                asm volatile("" ::: "memory"); }
        if (isV) {
            asm volatile("s_waitcnt lgkmcnt(0)" ::: "memory"); __builtin_amdgcn_s_barrier(); asm volatile("" ::: "memory");
            const int t = (wr * 4 + wc) * 64 + fq * 16 + fr;
            if (t < 256) { const f32x4 a = *(const LAS f32x4*)(xl + t * 32), b = *(const LAS f32x4*)(xl + t * 32 + 16);
                *(f32x2*)(stats + ((size_t)(u.pm * 256 + t) * 8 + (u.pn - 8)) * 2) = (f32x2){(a[0] + a[2]) + (b[0] + b[2]), (a[1] + a[3]) + (b[1] + b[3])}; }
        }
    }
};
struct EpiResAdd {
    static constexpr bool PERM = true;
    const bf16_t* X; bf16_t* Xo; const float* gate; float asc;
    DI void operator()(const f32x4 (&acc)[2][2][4][2], const Unit& u, int wr, int wc, int fr_in, int fq_in) const {
        int fr = fr_in, fq = fq_in; asm volatile("" : "+v"(fr), "+v"(fq));
        const int b = u.pm < 256 ? (u.pm >> 4) : 16;
        const int row0 = u.pm * 256 + wr * 64 + fr, col0 = u.pn * 256 + wc * 32 + 8 * fq;
        f32x4 gv[2][2];
#pragma unroll
        for (int bj = 0; bj < 2; ++bj)
#pragma unroll
            for (int n = 0; n < 2; ++n) gv[bj][n] = *(const f32x4*)(gate + (size_t)b * 6144 + col0 + bj * 128 + 4 * n) * asc;
#pragma unroll
        for (int ai = 0; ai < 2; ++ai) {
            u32x4 xv[4][2];
#pragma unroll
            for (int m = 0; m < 4; ++m)
#pragma unroll
                for (int bj = 0; bj < 2; ++bj) xv[m][bj] = *(const u32x4*)(X + (size_t)(row0 + ai * 128 + m * 16) * D + col0 + bj * 128);
#pragma unroll
            for (int m = 0; m < 4; ++m)
#pragma unroll
                for (int bj = 0; bj < 2; ++bj) { const u32x4 w = xv[m][bj]; const f32x4 a0 = acc[ai][bj][m][0] * gv[bj][0], a1 = acc[ai][bj][m][1] * gv[bj][1];
                    u32x4 o; o.x = pk2(bflo(w.x) + a0[0], bfhi(w.x) + a0[1]); o.y = pk2(bflo(w.y) + a0[2], bfhi(w.y) + a0[3]); o.z = pk2(bflo(w.z) + a1[0], bfhi(w.z) + a1[1]); o.w = pk2(bflo(w.w) + a1[2], bfhi(w.w) + a1[3]);
                    *(u32x4*)(Xo + (size_t)(row0 + ai * 128 + m * 16) * D + col0 + bj * 128) = o; }
            asm volatile("" ::: "memory"); }
    }
};
struct EpiQKV {
    static constexpr bool PERM = true;
    bf16_t *Q, *Kb, *Vb; const float* cosT; const float* sinT;
    DI void operator()(const f32x4 (&acc)[2][2][4][2], const Unit& u, int wr, int wc, int fr_in, int fq_in) const {
        int fr = fr_in, fq = fq_in; asm volatile("" : "+v"(fr), "+v"(fq));
        const int row0 = u.pm * 256 + wr * 64 + fr; const bool lat = u.pm < 256;
        const int cin = wc * 32 + 8 * fq, kk0 = 16 * (wc & 1) + 4 * fq;
        bf16_t* base; int ld; float sc; bool rope;
        constexpr float ws_ = FP8_ATT ? 1.0f / WM_SCALE : 1.0f;
        if (u.pn < 4) { base = Q + u.pn * 256 + cin; ld = 1024; sc = QSCALE * ws_; rope = lat; }
        else if (u.pn == 4) { base = Kb + cin; ld = 256; sc = ws_; rope = lat; }
        else { base = Vb + cin; ld = 256; sc = ws_; rope = false; }
#pragma unroll
        for (int ai = 0; ai < 2; ++ai) {
            f32x4 cs[4], sn[4];
#pragma unroll
            for (int m = 0; m < 4; ++m) { cs[m] = (f32x4){1.f, 1.f, 1.f, 1.f}; sn[m] = (f32x4){0.f, 0.f, 0.f, 0.f};
                if (rope) { const int t = (row0 + ai * 128 + m * 16) & 4095; cs[m] = *(const f32x4*)(cosT + t * 32 + kk0); sn[m] = *(const f32x4*)(sinT + t * 32 + kk0); } }
#pragma unroll
            for (int m = 0; m < 4; ++m) { const int row = row0 + ai * 128 + m * 16; bf16_t* rowp = base + (size_t)row * ld;
#pragma unroll
                for (int bj = 0; bj < 2; ++bj) { const f32x4 x1 = acc[ai][bj][m][0], x2 = acc[ai][bj][m][1];
                    const f32x4 o1 = (x1 * cs[m] - x2 * sn[m]) * sc, o2 = (x1 * sn[m] + x2 * cs[m]) * sc;
                    u32x4 w; w.x = pg8::cvt_pk_bf16(o1[0], o1[1]); w.y = pg8::cvt_pk_bf16(o1[2], o1[3]); w.z = pg8::cvt_pk_bf16(o2[0], o2[1]); w.w = pg8::cvt_pk_bf16(o2[2], o2[3]);
                    *(u32x4*)(rowp + bj * 128) = w; } }
            asm volatile("" ::: "memory"); }
    }
};
struct EpiSwiGLU {
    static constexpr bool PERM = true; static constexpr int NST = 0;
    unsigned char* Hm;
    DI void operator()(const f32x4 (&acc)[2][2][4][2], const Unit& u, int wr, int wc, int fr_in, int fq_in) const {
        int fr = fr_in, fq = fq_in; asm volatile("" : "+v"(fr), "+v"(fq));
        const int row0 = u.pm * 256 + wr * 64 + fr, col0 = u.pn * 128 + wc * 32 + 8 * fq;
        constexpr float is = 1.0f / W13_SCALE;
#pragma unroll
        for (int ai = 0; ai < 2; ++ai)
#pragma unroll
            for (int m = 0; m < 4; ++m) { unsigned char* rowp = Hm + (size_t)(row0 + ai * 128 + m * 16) * 2048 + col0;
                const f32x4 a0 = acc[ai][0][m][0] * is, a1 = acc[ai][0][m][1] * is, b0 = acc[ai][1][m][0] * is, b1 = acc[ai][1][m][1] * is;
                const f32x2 h0 = silu_mul2((f32x2){a0[0], a0[1]}, (f32x2){b0[0], b0[1]}), h1 = silu_mul2((f32x2){a0[2], a0[3]}, (f32x2){b0[2], b0[3]});
                const f32x2 h2 = silu_mul2((f32x2){a1[0], a1[1]}, (f32x2){b1[0], b1[1]}), h3 = silu_mul2((f32x2){a1[2], a1[3]}, (f32x2){b1[2], b1[3]});
                u32x2 w; w.x = pk4_fp8(h0.x, h0.y, h1.x, h1.y); w.y = pk4_fp8(h2.x, h2.y, h3.x, h3.y);
                if (E1_NT) __builtin_nontemporal_store(w, (u32x2*)rowp); else *(u32x2*)rowp = w; }
    }
};
struct EpiGateY {
    static constexpr bool PERM = true;
    unsigned char* Y; const float* gate;
    DI void operator()(const f32x4 (&acc)[2][2][4][2], const Unit& u, int wr, int wc, int fr_in, int fq_in) const {
        int fr = fr_in, fq = fq_in; asm volatile("" : "+v"(fr), "+v"(fq));
        const int row0 = u.pm * 256 + wr * 64 + fr, col0 = u.pn * 256 + wc * 32 + 8 * fq;
        float gts[2][4];
#pragma unroll
        for (int ai = 0; ai < 2; ++ai)
#pragma unroll
            for (int m = 0; m < 4; ++m) gts[ai][m] = gate[row0 + ai * 128 + m * 16] * (Y_SCALE / W2_SCALE);
#pragma unroll
        for (int ai = 0; ai < 2; ++ai)
#pragma unroll
            for (int m = 0; m < 4; ++m) { const int row = row0 + ai * 128 + m * 16; const float gt = gts[ai][m]; unsigned char* rowp = Y + (size_t)row * 1024 + col0;
#pragma unroll
                for (int bj = 0; bj < 2; ++bj) { const f32x4 v0 = acc[ai][bj][m][0] * gt, v1 = acc[ai][bj][m][1] * gt;
                    u32x2 w; w.x = pk4_fp8(v0[0], v0[1], v0[2], v0[3]); w.y = pk4_fp8(v1[0], v1[1], v1[2], v1[3]);
                    *(u32x2*)(rowp + bj * 128) = w; }
                asm volatile("" ::: "memory"); }
    }
};

DI void p0_mod(LAS unsigned char* lds, const float* c, const float* c_ctx, const float* w_mod, const float* b_mod, float* mod, int bid, int G) {
    LAS float* S = (LAS float*)lds;
    LAS float* P = (LAS float*)(lds + 17 * 1024 * 4);
    const int tid = tid_opaque(), wave = tid >> 6, lane = tid & 63;
    for (int i = tid; i < 17 * 1024; i += 512) { const int r = i >> 10, k = i & 1023; const float v = r < 16 ? c[r * 1024 + k] : c_ctx[k]; S[i] = v / (1.0f + __expf(-v)); }
    __syncthreads();
    for (int item = bid; item < 4 * 96; item += G) {
        const int l = item / 96, nb = item % 96;
        const float* w = w_mod + ((size_t)l * 1024 + wave * 128) * 6144 + nb * 64 + lane;
        float acc[17];
#pragma unroll
        for (int r = 0; r < 17; ++r) acc[r] = 0.f;
        for (int k4 = 0; k4 < 128; k4 += 4) {
            const float w0 = w[(size_t)(k4 + 0) * 6144], w1 = w[(size_t)(k4 + 1) * 6144], w2 = w[(size_t)(k4 + 2) * 6144], w3 = w[(size_t)(k4 + 3) * 6144];
#pragma unroll
            for (int r = 0; r < 17; ++r) { const f32x4 s = *(const LAS f32x4*)(S + r * 1024 + wave * 128 + k4); acc[r] += (s[0] * w0 + s[1] * w1) + (s[2] * w2 + s[3] * w3); }
        }
#pragma unroll
        for (int r = 0; r < 17; ++r) P[(wave * 17 + r) * 64 + lane] = acc[r];
        __syncthreads();
        for (int o = tid; o < 17 * 64; o += 512) { const int r = o >> 6, nn = o & 63; float s = 0.f;
#pragma unroll
            for (int w8 = 0; w8 < 8; ++w8) s += P[(w8 * 17 + r) * 64 + nn];
            mod[((size_t)l * 17 + r) * 6144 + nb * 64 + nn] = s + b_mod[l * 6144 + nb * 64 + nn]; }
        __syncthreads();
    }
}
DI int qk_phys(int d) { return 8 * ((d & 31) >> 2) + (d & 3) + 4 * (d >> 5); }
DI void cvt_item(const float* src, int ldsrc, int K, bf16_t* dst, int k0, int nsrc0, int ndst0, bool perm, LAS unsigned char* Lt, int lane, bool s8 = false) {
    const int kr = lane >> 4, nq = lane & 15;
    f32x4 v[16];
#pragma unroll
    for (int q = 0; q < 16; ++q) v[q] = *(const f32x4*)(src + (size_t)(k0 + 4 * q + kr) * ldsrc + nsrc0 + 4 * nq);
    int prow[4];
#pragma unroll
    for (int i = 0; i < 4; ++i) { const int n = 4 * nq + i; prow[i] = (perm ? qk_phys(n) : n) * 132; }
#pragma unroll
    for (int q = 0; q < 16; ++q) { const int k = 4 * q + kr; if (FP8D_SIM) { for (int i = 0; i < 4; ++i) v[q][i] = sim8(v[q][i] * 32.0f, s8) * (1.0f / 32.0f); } const unsigned w01 = pk2(v[q][0], v[q][1]), w23 = pk2(v[q][2], v[q][3]);
        *(LAS unsigned short*)(Lt + prow[0] + k * 2) = (unsigned short)(w01 & 0xffffu); *(LAS unsigned short*)(Lt + prow[1] + k * 2) = (unsigned short)(w01 >> 16);
        *(LAS unsigned short*)(Lt + prow[2] + k * 2) = (unsigned short)(w23 & 0xffffu); *(LAS unsigned short*)(Lt + prow[3] + k * 2) = (unsigned short)(w23 >> 16); }
    LDS_WAIT();
    const int c = lane & 7;
#pragma unroll
    for (int j = 0; j < 8; ++j) { const int n = (lane >> 3) + 8 * j; const LAS unsigned* s = (const LAS unsigned*)(Lt + n * 132 + 16 * c);
        u32x4 o; o.x = s[0]; o.y = s[1]; o.z = s[2]; o.w = s[3];
        *(u32x4*)(dst + (size_t)(ndst0 + n) * K + k0 + 8 * c) = o; }
    LDS_WAIT();
}
struct P0Args { const float *w_in, *w_out, *w_qkv, *w_o, *w1, *w3, *w2, *w_s; bf16_t *win_t, *wout_t, *wqkv_t, *wo_t, *w13_t, *w2_t, *ws_t; float* cosT; float* sinT; };
constexpr int EXP_ITEMS = 3 * 8192, STEAL_CHUNK = 16, STEAL_NCHUNKS = EXP_ITEMS / STEAL_CHUNK;
DI void cvt_item8(const float* src, int ldsrc, int K, unsigned char* dst, int k0, int nsrc0, int ndst0, float scale, LAS unsigned char* Lt, int lane, bool perm = false) {
    const int kr = lane >> 4, nq = lane & 15;
    f32x4 v[16];
#pragma unroll
    for (int q = 0; q < 16; ++q) v[q] = *(const f32x4*)(src + (size_t)(k0 + 4 * q + kr) * ldsrc + nsrc0 + 4 * nq);
#pragma unroll
    for (int q = 0; q < 16; ++q) { const int k = 4 * q + kr; const unsigned p = pk4_fp8(v[q][0] * scale, v[q][1] * scale, v[q][2] * scale, v[q][3] * scale);
        LAS unsigned char* b = Lt + (perm ? 8 * (nq & 7) + 4 * (nq >> 3) : 4 * nq) * 68 + k;
        b[0] = (unsigned char)(p & 0xffu); b[68] = (unsigned char)((p >> 8) & 0xffu); b[136] = (unsigned char)((p >> 16) & 0xffu); b[204] = (unsigned char)(p >> 24); }
    LDS_WAIT();
    const int c = lane & 3;
#pragma unroll
    for (int j = 0; j < 4; ++j) { const int n = (lane >> 2) + 16 * j; const LAS unsigned* sp = (const LAS unsigned*)(Lt + n * 68 + 16 * c);
        u32x4 o; o.x = sp[0]; o.y = sp[1]; o.z = sp[2]; o.w = sp[3];
        *(u32x4*)(dst + (size_t)(ndst0 + n) * K + k0 + 16 * c) = o; }
    LDS_WAIT();
}
DI void cvt_expert_item(const P0Args& a, int layer, int it, LAS unsigned char* Lt, int lane) {
    const int which = it >> 13, r = it & 8191, e = r >> 9, q = r & 511; const size_t le = (size_t)layer * 16 + e;
    if (which < 2) { const int kb = q >> 5, nb = q & 31; const int ndst = ((nb * 64) >> 7) * 256 + ((nb * 64) & 127) + which * 128;
        cvt_item8((which ? a.w3 : a.w1) + le * 1024 * 2048, 2048, 1024, (unsigned char*)a.w13_t + le * 4096 * 1024, kb * 64, nb * 64, ndst, W13_SCALE, Lt, lane); }
    else { const int kb = q >> 4, nb = q & 15; cvt_item8(a.w2 + le * 2048 * 1024, 1024, 2048, (unsigned char*)a.w2_t + le * 1024 * 2048, kb * 64, nb * 64, nb * 64, W2_SCALE, Lt, lane); }
}
DI void steal_convert(LAS unsigned char* lds, unsigned* q, const P0Args& a, int layer, int max_chunks) {
    const int tid = tid_opaque(), wave = __builtin_amdgcn_readfirstlane(tid >> 6), lane = tid & 63;
    LAS unsigned* slot = (LAS unsigned*)(lds + 8 * 8448); LAS unsigned char* Lt = lds + wave * 8448;
    for (int n = 0; n < max_chunks; ++n) {
        __syncthreads();
        if (tid == 0) *slot = __hip_atomic_fetch_add(q, 1u, __ATOMIC_RELAXED, __HIP_MEMORY_SCOPE_AGENT);
        __syncthreads();
        const unsigned idx = *slot;
        if (idx >= (unsigned)STEAL_NCHUNKS) break;
#pragma unroll 1
        for (int k = 0; k < 2; ++k) cvt_expert_item(a, layer, (int)idx * STEAL_CHUNK + wave * 2 + k, Lt, lane);
    }
    __syncthreads();
}
DI void p0_convert(LAS unsigned char* lds, const P0Args& a, int gw, int NGW, int lane, int wave) {
    LAS unsigned char* Lt = lds + wave * 8448;
    constexpr int I_IN = 2 * 16 * 64, I_OUT = 2 * 32 * 16, I_QKV = 2 * 16 * 24, I_O = 2 * 16 * 16;
    constexpr int NITEMS = I_IN + I_OUT + I_QKV + I_O;
    for (int it = gw; it < NITEMS; it += NGW) {
        int r = it;
        if (r < I_IN) { const int j = r / 1024, q = r % 1024, kb = q / 64, nb = q % 64;
            cvt_item(a.w_in + (size_t)j * 1024 * 4096, 4096, 1024, a.win_t + (size_t)j * 4096 * 1024, kb * 64, nb * 64, nb * 64, false, Lt, lane, (FP8D_SIM & 1) != 0); continue; } r -= I_IN;
        if (r < I_OUT) { const int j = r / 512, q = r % 512, kb = q / 16, nb = q % 16;
            cvt_item(a.w_out + (size_t)j * 2048 * 1024, 1024, 2048, a.wout_t + (size_t)j * 1024 * 2048, kb * 64, nb * 64, nb * 64, false, Lt, lane, (FP8D_SIM & 4) != 0); continue; } r -= I_OUT;
        if (r < I_QKV) { const int j = r / 384, q = r % 384, kb = q / 24, nb = q % 24;
            if (FP8_ATT) cvt_item8(a.w_qkv + (size_t)j * 1024 * 1536, 1536, 1024, (unsigned char*)a.wqkv_t + (size_t)j * 1536 * 1024, kb * 64, nb * 64, nb * 64, WM_SCALE, Lt, lane, nb < 20);
            else cvt_item(a.w_qkv + (size_t)j * 1024 * 1536, 1536, 1024, a.wqkv_t + (size_t)j * 1536 * 1024, kb * 64, nb * 64, nb * 64, nb < 20, Lt, lane, (FP8D_SIM & 2) != 0);
            continue; } r -= I_QKV;
        if (r < I_O) { const int j = r / 256, q = r % 256, kb = q / 16, nb = q % 16;
            if (FP8_ATT) cvt_item8(a.w_o + (size_t)j * 1024 * 1024, 1024, 1024, (unsigned char*)a.wo_t + (size_t)j * 1024 * 1024, kb * 64, nb * 64, nb * 64, WM_SCALE, Lt, lane);
            else cvt_item(a.w_o + (size_t)j * 1024 * 1024, 1024, 1024, a.wo_t + (size_t)j * 1024 * 1024, kb * 64, nb * 64, nb * 64, false, Lt, lane, (FP8D_SIM & 2) != 0);
            continue; } r -= I_O;
    }
    const int gt = gw * 64 + lane, NT = NGW * 64;
    for (int i = gt; i < 2 * 16 * 128 * 128 / 8; i += NT) { const f32x4 x = *(const f32x4*)(a.w_s + (size_t)i * 8), y = *(const f32x4*)(a.w_s + (size_t)i * 8 + 4);
        u32x4 o; o.x = pk2(x[0], x[1]); o.y = pk2(x[2], x[3]); o.z = pk2(y[0], y[1]); o.w = pk2(y[2], y[3]); *(u32x4*)(a.ws_t + (size_t)i * 8) = o; }
    for (int i = gt; i < 4096 * 32; i += NT) { const int t = i >> 5, kk = i & 31; const int pos = kk < 16 ? (t >> 6) : (t & 63); const int j = kk & 15;
        const float inv = exp2f(-(float)j * (13.287712379549449f / 16.0f)); const float ang = (float)pos * inv; a.cosT[i] = cosf(ang); a.sinT[i] = sinf(ang); }
}

DI void unpack8(const u32x4 w, float (&v)[8]) { v[0] = bflo(w.x); v[1] = bfhi(w.x); v[2] = bflo(w.y); v[3] = bfhi(w.y); v[4] = bflo(w.z); v[5] = bfhi(w.z); v[6] = bflo(w.w); v[7] = bfhi(w.w); }
DI void unpack8_fp8(const u32x2 w, float (&v)[8]) { const f32x2 a = __builtin_amdgcn_cvt_pk_f32_fp8((int)w.x, false), b = __builtin_amdgcn_cvt_pk_f32_fp8((int)w.x, true), c = __builtin_amdgcn_cvt_pk_f32_fp8((int)w.y, false), d = __builtin_amdgcn_cvt_pk_f32_fp8((int)w.y, true);
    v[0] = a.x; v[1] = a.y; v[2] = b.x; v[3] = b.y; v[4] = c.x; v[5] = c.y; v[6] = d.x; v[7] = d.y; }
DI u32x4 pack8f(const float (&v)[8]) { u32x4 o; o.x = pk2(v[0], v[1]); o.y = pk2(v[2], v[3]); o.z = pk2(v[4], v[5]); o.w = pk2(v[6], v[7]); return o; }
DI void load8f(const float* p, float (&v)[8]) { const f32x4 a = *(const f32x4*)p, b = *(const f32x4*)(p + 4); v[0] = a[0]; v[1] = a[1]; v[2] = a[2]; v[3] = a[3]; v[4] = b[0]; v[5] = b[1]; v[6] = b[2]; v[7] = b[3]; }
DI void n0_phase(const float* xin, const float* cin, bf16_t* X, const float* mod_cur, const float* gmix, bf16_t* H, int gw, int NGW, int lane) {
    const int rpw = (MT + NGW - 1) / NGW; const int m0 = gw * rpw; const int m1 = (m0 + rpw) < MT ? (m0 + rpw) : MT;
    int bcur = -1; float av[2][8], shv[2][8];
#pragma unroll
    for (int j = 0; j < 2; ++j)
#pragma unroll
        for (int k = 0; k < 8; ++k) { av[j][k] = 0.f; shv[j][k] = 0.f; }
    f32x4 p0[4], p1[4];
#define N0_LOAD(dst, mm) do { const int _m = (mm); if (_m < m1) { const float* _s = (_m < ML ? xin + (size_t)_m * D : cin + (size_t)(_m - ML) * D) + 8 * lane; \
        dst[0] = *(const f32x4*)_s; dst[1] = *(const f32x4*)(_s + 4); dst[2] = *(const f32x4*)(_s + 512); dst[3] = *(const f32x4*)(_s + 516); } } while (0)
    N0_LOAD(p0, m0); N0_LOAD(p1, m0 + 1);
    for (int m = m0; m < m1; ++m) {
        const int b = m < ML ? (m >> 12) : 16;
        float v[2][8];
#pragma unroll
        for (int j = 0; j < 2; ++j)
#pragma unroll
            for (int k = 0; k < 4; ++k) { v[j][k] = p0[2 * j][k]; v[j][4 + k] = p0[2 * j + 1][k]; }
#pragma unroll
        for (int i = 0; i < 4; ++i) p0[i] = p1[i];
        N0_LOAD(p1, m + 2);
        if (b != bcur) { bcur = b;
#pragma unroll
            for (int j = 0; j < 2; ++j) { const int c = 8 * lane + 512 * j; float g8[8], s8[8]; load8f(gmix + c, g8); load8f(mod_cur + (size_t)b * 6144 + 1024 + c, s8); load8f(mod_cur + (size_t)b * 6144 + c, shv[j]);
#pragma unroll
                for (int k = 0; k < 8; ++k) av[j][k] = g8[k] * (s8[k] + 1.0f); } }
        float ss = 0.f;
#pragma unroll
        for (int j = 0; j < 2; ++j)
#pragma unroll
            for (int k = 0; k < 8; ++k) ss += v[j][k] * v[j][k];
        const float rstd = __builtin_amdgcn_rsqf(wave_sum(ss) * (1.0f / D) + EPS);
#pragma unroll
        for (int j = 0; j < 2; ++j) { const int c = 8 * lane + 512 * j; *(u32x4*)(X + (size_t)m * D + c) = pack8f(v[j]); float h[8];
#pragma unroll
            for (int k = 0; k < 8; ++k) h[k] = sim8(v[j][k] * rstd * av[j][k] + shv[j][k], (FP8D_SIM & 1) != 0);
            *(u32x4*)(H + (size_t)m * D + c) = pack8f(h); }
    }
#undef N0_LOAD
}
DI void n1_phase(int mode, int nrows, const bf16_t* X, bf16_t* Xo, float* out, const unsigned char* Y  , const int* tokslot, const float* mod_prev, const float* mod_cur, const float* gmix, bf16_t* H, int gw, int NGW, int lane, bool s8 = false, bool h8 = false) {
    const int rpw = (nrows + NGW - 1) / NGW; const int m0 = gw * rpw; const int m1 = (m0 + rpw) < nrows ? (m0 + rpw) : nrows;
    if (m0 >= m1) return;
    u32x4 xq[3][2]; int sq[3] = {-1, -1, -1};
#define N1_LOAD(qi, mm) do { const int _m = (mm); if (_m < m1) { xq[qi][0] = *(const u32x4*)(X + (size_t)_m * D + 8 * lane); xq[qi][1] = *(const u32x4*)(X + (size_t)_m * D + 8 * lane + 512); \
        sq[qi] = lane < 16 ? tokslot[(size_t)lane * MT + _m] : -1; } } while (0)
    N1_LOAD(0, m0); N1_LOAD(1, m0 + 1); N1_LOAD(2, m0 + 2);
    int bcur = -1; float g2v[2][8], av[2][8], shv[2][8];
#pragma unroll
    for (int j = 0; j < 2; ++j)
#pragma unroll
        for (int k = 0; k < 8; ++k) { g2v[j][k] = 0.f; av[j][k] = 0.f; shv[j][k] = 0.f; }
    int slotn = sq[0]; unsigned maskn = (unsigned)__builtin_amdgcn_ballot_w64(slotn >= 0) & 0xffffu; int sbn[4]; u32x2 yrn[4][2];
#define N1_GATHER() do { _Pragma("unroll") for (int i = 0; i < 4; ++i) { sbn[i] = -1; if (maskn) { const int e = __builtin_ctz(maskn); sbn[i] = __builtin_amdgcn_readlane(slotn, e); maskn &= maskn - 1u; } \
            const unsigned char* yp = Y + (size_t)(sbn[i] >= 0 ? sbn[i] : 0) * D + 8 * lane; yrn[i][0] = *(const u32x2*)yp; yrn[i][1] = *(const u32x2*)(yp + 512); } } while (0)
    N1_GATHER();
    for (int m = m0; m < m1; ++m) {
        float v[2][8];
        unpack8(xq[0][0], v[0]); unpack8(xq[0][1], v[1]);
        xq[0][0] = xq[1][0]; xq[0][1] = xq[1][1]; xq[1][0] = xq[2][0]; xq[1][1] = xq[2][1];
        const int slot = slotn; sq[0] = sq[1]; sq[1] = sq[2];
        const int b = m < ML ? (m >> 12) : 16;
        unsigned mask = maskn;
        int sb[4]; u32x2 yr[4][2];
#pragma unroll
        for (int i = 0; i < 4; ++i) { sb[i] = sbn[i]; yr[i][0] = yrn[i][0]; yr[i][1] = yrn[i][1]; }
        slotn = (m + 1 < m1) ? sq[0] : -1; maskn = (unsigned)__builtin_amdgcn_ballot_w64(slotn >= 0) & 0xffffu;
        N1_GATHER();
        N1_LOAD(2, m + 3);
        if (b != bcur) { bcur = b;
#pragma unroll
            for (int j = 0; j < 2; ++j) { const int c = 8 * lane + 512 * j; load8f(mod_prev + (size_t)b * 6144 + 5120 + c, g2v[j]);
#pragma unroll
                for (int k = 0; k < 8; ++k) g2v[j][k] *= (1.0f / Y_SCALE);
                if (mode == 1) { float g8[8], s8[8]; load8f(gmix + c, g8); load8f(mod_cur + (size_t)b * 6144 + 1024 + c, s8); load8f(mod_cur + (size_t)b * 6144 + c, shv[j]);
#pragma unroll
                    for (int k = 0; k < 8; ++k) av[j][k] = g8[k] * (s8[k] + 1.0f); }
                else load8f(gmix + c, av[j]); } }
        float a[2][8];
#pragma unroll
        for (int j = 0; j < 2; ++j)
#pragma unroll
            for (int k = 0; k < 8; ++k) a[j][k] = 0.f;
#pragma unroll
        for (int i = 0; i < 4; ++i) if (sb[i] >= 0) {
#pragma unroll
            for (int j = 0; j < 2; ++j) { float y[8]; unpack8_fp8(yr[i][j], y);
#pragma unroll
                for (int k = 0; k < 8; ++k) a[j][k] += y[k]; } }
        while (mask) { const int e = __builtin_ctz(mask); const int s1 = __builtin_amdgcn_readlane(slot, e); mask &= mask - 1u; const unsigned char* yp = Y + (size_t)s1 * D + 8 * lane;
#pragma unroll
            for (int j = 0; j < 2; ++j) { float y[8]; unpack8_fp8(*(const u32x2*)(yp + 512 * j), y);
#pragma unroll
                for (int k = 0; k < 8; ++k) a[j][k] += y[k]; } }
        float ss = 0.f;
#pragma unroll
        for (int j = 0; j < 2; ++j)
#pragma unroll
            for (int k = 0; k < 8; ++k) { v[j][k] += g2v[j][k] * a[j][k]; ss += v[j][k] * v[j][k]; }
        const float rstd = __builtin_amdgcn_rsqf(wave_sum(ss) * (1.0f / D) + EPS);
        if (mode == 2) {
#pragma unroll
            for (int j = 0; j < 2; ++j) { float* op = out + (size_t)m * D + 8 * lane + 512 * j;
                *(f32x4*)op = (f32x4){v[j][0] * rstd * av[j][0], v[j][1] * rstd * av[j][1], v[j][2] * rstd * av[j][2], v[j][3] * rstd * av[j][3]};
                *(f32x4*)(op + 4) = (f32x4){v[j][4] * rstd * av[j][4], v[j][5] * rstd * av[j][5], v[j][6] * rstd * av[j][6], v[j][7] * rstd * av[j][7]}; }
        } else {
#pragma unroll
            for (int j = 0; j < 2; ++j) { const int c = 8 * lane + 512 * j; *(u32x4*)(Xo + (size_t)m * D + c) = pack8f(v[j]); float h[8];
#pragma unroll
                for (int k = 0; k < 8; ++k) h[k] = sim8(v[j][k] * rstd * av[j][k] + shv[j][k], s8);
                if (h8) { u32x2 w8; w8.x = pk4_fp8(h[0], h[1], h[2], h[3]); w8.y = pk4_fp8(h[4], h[5], h[6], h[7]); *(u32x2*)((unsigned char*)H + (size_t)m * D + c) = w8; }
                else *(u32x4*)(H + (size_t)m * D + c) = pack8f(h); }
        }
    }
#undef N1_LOAD
#undef N1_GATHER
}

DI void n2_phase(LAS unsigned char* lds, int nrows, const bf16_t* X, const float* mod_cur, const float* gffn, const float* w_r, bf16_t* H, float* aff, int bid, int G) {
    LAS unsigned char* Whi = lds; LAS unsigned char* Wlo = lds + 32768;
    LAS float* AV = (LAS float*)(lds + 65536); LAS float* SH = AV + 1024; LAS float* BIAS = SH + 1024;
    LAS float* DP0 = BIAS + 16; LAS float* SSP0 = DP0 + 2 * 8 * 256;
    const int tid = tid_opaque(), w = __builtin_amdgcn_readfirstlane(tid >> 6), lane = tid & 63, r = lane & 15, q = lane >> 4;
    const int ngroups = nrows >> 4, gpw = (ngroups + G - 1) / G; const int g0 = bid * gpw; const int g1 = (g0 + gpw) < ngroups ? (g0 + gpw) : ngroups;
    int bcur = -1;
    u32x4 xa[4], xn[4], xn2[4];
#define N2_LOAD(dst, gg) do { const size_t _row = (size_t)(gg) * 16 + r; _Pragma("unroll") for (int i = 0; i < 4; ++i) dst[i] = *(const u32x4*)(X + _row * D + 128 * w + 32 * i + 8 * q); } while (0)
    if (g0 < g1) N2_LOAD(xn, g0);
    if (g0 + 1 < g1) N2_LOAD(xn2, g0 + 1);
    for (int g = g0; g < g1; ++g) {
        const int row0 = g * 16; const int b = row0 < ML ? (row0 >> 12) : 16;
        if (b != bcur) {
            bcur = b; __syncthreads();
            for (int c = tid; c < 1024; c += 512) { AV[c] = gffn[c] * (mod_cur[(size_t)b * 6144 + 4096 + c] + 1.0f); SH[c] = mod_cur[(size_t)b * 6144 + 3072 + c]; }
            __syncthreads();
            float sb = 0.f;
            for (int i = tid; i < 16384; i += 512) { const int c = i >> 4, e = i & 15; const float wv = w_r[i]; const float v = AV[c] * wv; sb += SH[c] * wv; const unsigned hi = pk2(v, 0.f) & 0xffffu; const float lo = v - __uint_as_float(hi << 16);
                const int off = (((c >> 5) * 16 + e) * 4 + ((c >> 3) & 3)) * 16 + (c & 7) * 2;
                *(LAS unsigned short*)(Whi + off) = (unsigned short)hi; *(LAS unsigned short*)(Wlo + off) = (unsigned short)(pk2(lo, 0.f) & 0xffffu); }
            sb = x32_sum(x16_sum(sb));
            if (q == 0) DP0[w * 16 + r] = sb;
            __syncthreads();
            if (tid < 16) { float t = 0.f;
#pragma unroll
                for (int ww = 0; ww < 8; ++ww) t += DP0[ww * 16 + tid];
                BIAS[tid] = t; }
            __syncthreads();
        }
#pragma unroll
        for (int i = 0; i < 4; ++i) { xa[i] = xn[i]; xn[i] = xn2[i]; }
        if (g + 2 < g1) N2_LOAD(xn2, g + 2);
        f32x4 acc = (f32x4){0.f, 0.f, 0.f, 0.f}; float ss = 0.f;
#pragma unroll
        for (int i = 0; i < 4; ++i) { const int ks = 4 * w + i;
            const bf16x8 wh = *(const LAS bf16x8*)(Whi + ((ks * 16 + r) * 4 + q) * 16), wl = *(const LAS bf16x8*)(Wlo + ((ks * 16 + r) * 4 + q) * 16);
            const bf16x8 a = __builtin_bit_cast(bf16x8, xa[i]);
            acc = __builtin_amdgcn_mfma_f32_16x16x32_bf16(a, wh, acc, 0, 0, 0); acc = __builtin_amdgcn_mfma_f32_16x16x32_bf16(a, wl, acc, 0, 0, 0);
            float v[8]; unpack8(xa[i], v);
#pragma unroll
            for (int k = 0; k < 8; ++k) ss += v[k] * v[k]; }
        ss = x32_sum(x16_sum(ss));
        LAS float* DP = DP0 + (g & 1) * (8 * 256); LAS float* SSP = SSP0 + (g & 1) * (8 * 16);
        if (q == 0) SSP[w * 16 + r] = ss;
#pragma unroll
        for (int k = 0; k < 4; ++k) DP[(w * 16 + 4 * q + k) * 16 + r] = acc[k];
        __syncthreads();
        float rs;
        { float s2 = 0.f;
#pragma unroll
          for (int ww = 0; ww < 8; ++ww) s2 += SSP[ww * 16 + r];
          rs = __builtin_amdgcn_rsqf(s2 * (1.0f / D) + EPS); }
        if (tid < 256) { const int row = tid >> 4, e = tid & 15; float d = 0.f;
#pragma unroll
            for (int ww = 0; ww < 8; ++ww) d += DP[(ww * 16 + row) * 16 + e];
            const float rrow = __shfl(rs, (lane & 48) | row);
            const float t = rrow * d + BIAS[e];
            float mx = t;
            mx = row16_max(mx);
            const float ex = __expf(t - mx); float sm = ex;
            sm = row16_sum(sm);
            aff[(size_t)(row0 + row) * 16 + e] = ex * __builtin_amdgcn_rcpf(sm); }
        {
#pragma unroll
          for (int i = 0; i < 4; ++i) { const int c = 128 * w + 32 * i + 8 * q; float v[8]; unpack8(xa[i], v);
              const f32x4 a0 = *(const LAS f32x4*)(AV + c), a1 = *(const LAS f32x4*)(AV + c + 4), s0 = *(const LAS f32x4*)(SH + c), s1 = *(const LAS f32x4*)(SH + c + 4);
              float h[8]; h[0] = v[0] * rs * a0[0] + s0[0]; h[1] = v[1] * rs * a0[1] + s0[1]; h[2] = v[2] * rs * a0[2] + s0[2]; h[3] = v[3] * rs * a0[3] + s0[3];
              h[4] = v[4] * rs * a1[0] + s1[0]; h[5] = v[5] * rs * a1[1] + s1[1]; h[6] = v[6] * rs * a1[2] + s1[2]; h[7] = v[7] * rs * a1[3] + s1[3];
              u32x2 w8; w8.x = pk4_fp8(h[0], h[1], h[2], h[3]); w8.y = pk4_fp8(h[4], h[5], h[6], h[7]);
              *(u32x2*)((unsigned char*)H + (size_t)(row0 + r) * D + c) = w8; } }
    }
#undef N2_LOAD
    __syncthreads();
}

DI void tk_problem(LAS unsigned char* lds, const float* aff, int rowbase, int n, int cap, int e, int slotbase, int* rowidx, float* gate, int* tokslot_e) {
    LAS int* cntA = (LAS int*)lds;
    LAS int* scanA = (LAS int*)(lds + 64);
    LAS int* scanB = (LAS int*)(lds + 128);
    LAS int* totG = (LAS int*)(lds + 192);
    const int tid = tid_opaque(), wave = tid >> 6, lane = tid & 63;
    unsigned key[8];
#pragma unroll
    for (int j = 0; j < 8; ++j) { const int t = tid * 8 + j; key[j] = t < n ? __float_as_uint(aff[(size_t)(rowbase + t) * 16 + e]) : 0u; }
    unsigned prefix = 0u; int it = 0;
    for (int bit = 30; bit >= 0; --bit, ++it) {
        const unsigned cand = prefix | (1u << bit);
        int c = 0;
#pragma unroll
        for (int j = 0; j < 8; ++j) c += key[j] >= cand ? 1 : 0;
        c = wave_sum_i(c);
        if (lane == 0) cntA[(it & 1) * 8 + wave] = c;
        __syncthreads();
        int tot = 0;
#pragma unroll
        for (int w = 0; w < 8; ++w) tot += cntA[(it & 1) * 8 + w];
        if (tot >= cap) prefix = cand;
    }
    int ng = 0, neq = 0;
#pragma unroll
    for (int j = 0; j < 8; ++j) { ng += key[j] > prefix ? 1 : 0; neq += key[j] == prefix ? 1 : 0; }
    int incl = neq;
#pragma unroll
    for (int o = 1; o < 64; o <<= 1) { const int y = __shfl_up(incl, o); if (lane >= o) incl += y; }
    const int wg = wave_sum_i(ng);
    if (lane == 63) scanA[wave] = incl;
    if (lane == 0) totG[wave] = wg;
    __syncthreads();
    int eqbase = incl - neq, G = 0;
#pragma unroll
    for (int w = 0; w < 8; ++w) { if (w < wave) eqbase += scanA[w]; G += totG[w]; }
    const int need = cap - G;
    bool sel[8]; int nsel = 0, er = eqbase;
#pragma unroll
    for (int j = 0; j < 8; ++j) { const bool isg = key[j] > prefix, ise = key[j] == prefix; sel[j] = isg || (ise && er < need); er += ise ? 1 : 0; nsel += sel[j] ? 1 : 0; }
    int incl2 = nsel;
#pragma unroll
    for (int o = 1; o < 64; o <<= 1) { const int y = __shfl_up(incl2, o); if (lane >= o) incl2 += y; }
    if (lane == 63) scanB[wave] = incl2;
    __syncthreads();
    int pos = incl2 - nsel;
#pragma unroll
    for (int w = 0; w < 8; ++w) if (w < wave) pos += scanB[w];
#pragma unroll
    for (int j = 0; j < 8; ++j) { const int t = tid * 8 + j;
        if (t < n) { if (sel[j]) { const int s = slotbase + pos; rowidx[s] = rowbase + t; gate[s] = __uint_as_float(key[j]); tokslot_e[rowbase + t] = s; ++pos; } else tokslot_e[rowbase + t] = -1; } }
    __syncthreads();
}

DI void tk_pair(LAS unsigned char* lds, const float* aff, int e, int rowbaseL, int slotbaseL, bool ctx, int rowbaseC, int slotbaseC, int* rowidx, float* gate, int* tokslot_e) {
    LAS int* cnt = (LAS int*)lds;
    LAS int* scanA = (LAS int*)(lds + 512);
    LAS int* scanB = (LAS int*)(lds + 640);
    LAS int* totG = (LAS int*)(lds + 768);
    const int tid = tid_opaque(), wave = __builtin_amdgcn_readfirstlane(tid >> 6), lane = tid & 63;
    unsigned key[8];
#pragma unroll
    for (int j = 0; j < 8; ++j) key[j] = __float_as_uint(aff[(size_t)(rowbaseL + tid * 8 + j) * 16 + e]);
    const bool hasc = ctx && tid < 256;
    const unsigned keyc = hasc ? __float_as_uint(aff[(size_t)(rowbaseC + tid) * 16 + e]) : 0u;
    unsigned pL = 0u, pC = 0u; int it = 0;
    for (int bit = 28; bit >= 0; bit -= 2, ++it) {
        LAS int* cb = cnt + (it & 1) * 48;
#pragma unroll
        for (int k = 0; k < 3; ++k) { const unsigned cL = pL | ((unsigned)(3 - k) << bit), cC = pC | ((unsigned)(3 - k) << bit);
            int n = 0;
#pragma unroll
            for (int j = 0; j < 8; ++j) n += __builtin_popcountll(__builtin_amdgcn_ballot_w64(key[j] >= cL));
            const int m = __builtin_popcountll(__builtin_amdgcn_ballot_w64(keyc >= cC));
            if (lane == 0) { cb[k * 8 + wave] = n; cb[24 + k * 8 + wave] = m; } }
        __syncthreads();
        int tL[3], tC[3];
#pragma unroll
        for (int k = 0; k < 3; ++k) { const pg8::v4i_t a = *(const LAS pg8::v4i_t*)(cb + k * 8), b = *(const LAS pg8::v4i_t*)(cb + k * 8 + 4), c = *(const LAS pg8::v4i_t*)(cb + 24 + k * 8), d = *(const LAS pg8::v4i_t*)(cb + 24 + k * 8 + 4);
            tL[k] = a[0] + a[1] + a[2] + a[3] + b[0] + b[1] + b[2] + b[3]; tC[k] = c[0] + c[1] + c[2] + c[3] + d[0] + d[1] + d[2] + d[3]; }
        const unsigned dL = tL[0] >= CAPL ? 3u : (tL[1] >= CAPL ? 2u : (tL[2] >= CAPL ? 1u : 0u)), dC = tC[0] >= CAPC ? 3u : (tC[1] >= CAPC ? 2u : (tC[2] >= CAPC ? 1u : 0u));
        pL |= dL << bit; pC |= dC << bit;
    }
    int ngL = 0, neqL = 0;
#pragma unroll
    for (int j = 0; j < 8; ++j) { ngL += key[j] > pL ? 1 : 0; neqL += key[j] == pL ? 1 : 0; }
    const int ngC = (hasc && keyc > pC) ? 1 : 0, neqC = (hasc && keyc == pC) ? 1 : 0;
    int inL = neqL, inC = neqC;
#pragma unroll
    for (int o = 1; o < 64; o <<= 1) { const int y = __shfl_up(inL, o), z = __shfl_up(inC, o); if (lane >= o) { inL += y; inC += z; } }
    const int wgL = wave_sum_i(ngL), wgC = wave_sum_i(ngC);
    if (lane == 63) { scanA[wave] = inL; scanA[8 + wave] = inC; }
    if (lane == 0) { totG[wave] = wgL; totG[8 + wave] = wgC; }
    __syncthreads();
    int ebL = inL - neqL, ebC = inC - neqC, GL = 0, GC = 0;
#pragma unroll
    for (int w = 0; w < 8; ++w) { if (w < wave) { ebL += scanA[w]; ebC += scanA[8 + w]; } GL += totG[w]; GC += totG[8 + w]; }
    const int needL = CAPL - GL, needC = CAPC - GC;
    bool sel[8]; int nsel = 0, er = ebL;
#pragma unroll
    for (int j = 0; j < 8; ++j) { const bool isg = key[j] > pL, ise = key[j] == pL; sel[j] = isg || (ise && er < needL); er += ise ? 1 : 0; nsel += sel[j] ? 1 : 0; }
    const bool selC = hasc && (keyc > pC || (keyc == pC && ebC < needC));
    int i2L = nsel, i2C = selC ? 1 : 0;
#pragma unroll
    for (int o = 1; o < 64; o <<= 1) { const int y = __shfl_up(i2L, o), z = __shfl_up(i2C, o); if (lane >= o) { i2L += y; i2C += z; } }
    if (lane == 63) { scanB[wave] = i2L; scanB[8 + wave] = i2C; }
    __syncthreads();
    int posL = i2L - nsel, posC = i2C - (selC ? 1 : 0);
#pragma unroll
    for (int w = 0; w < 8; ++w) if (w < wave) { posL += scanB[w]; posC += scanB[8 + w]; }
#pragma unroll
    for (int j = 0; j < 8; ++j) { const int t = rowbaseL + tid * 8 + j;
        if (sel[j]) { const int sl = slotbaseL + posL; rowidx[sl] = t; gate[sl] = __uint_as_float(key[j]); tokslot_e[t] = sl; ++posL; } else tokslot_e[t] = -1; }
    if (hasc) { const int t = rowbaseC + tid;
        if (selC) { const int sl = slotbaseC + posC; rowidx[sl] = t; gate[sl] = __uint_as_float(keyc); tokslot_e[t] = sl; } else tokslot_e[t] = -1; }
    __syncthreads();
}

DI int sm_chunk_of(int t) {
    if (t < 32) { const int x = t >> 2, w = t & 3; return 68 * x + 64 + w; }
    const int u = t - 32, j = 3 - (u >> 7), v = u & 127, x = v >> 4, w = v & 15; return 68 * x + 16 * j + w;
}
DI s16x4 tr16(const LAS unsigned char* p) { return __builtin_bit_cast(s16x4, __builtin_amdgcn_ds_read_tr16_b64_v4i16((LAS v4i16_t*)p)); }
DI void sm_phase(LAS unsigned char* lds, const bf16_t* U, bf16_t* Uo, const bf16_t* V, const float* stats, const bf16_t* ws_t  , const float* ws_f  , const float* b_s  ,
                 const float* ln_g, const float* ln_b, int bid, int G) {
    constexpr int PITCH = 272;
    constexpr int NUNITS = (MT / 128) * 16;
    LAS unsigned char* Aimg = lds; LAS unsigned char* Bimg = lds + 128 * PITCH; LAS float* RS = (LAS float*)(lds + 3 * 128 * PITCH);
    const int tid = tid_opaque(), wid = __builtin_amdgcn_readfirstlane(tid >> 6), lane = tid & 63, wr = wid >> 2, wc = wid & 3, fr = lane & 15, fq = lane >> 4;
    const int r4 = tid >> 2, q4 = tid & 3;
    f32x4 gam[2], bet[2]; float rsw[4], bsv[4];
    u32x4 vr[4], vr2[4]; f32x4 sr, sr2; u32x4 ur[4], ur2[4];
    int last_g = -1;
#define SM_LOAD(dv, ds, du, un) do { const int _ch = sm_chunk_of((un) >> 4), _g = (un) & 15; const size_t _r0 = (size_t)_ch * 128; const int _c0 = _g * 128; \
        _Pragma("unroll") for (int k = 0; k < 4; ++k) dv[k] = *(const u32x4*)(V + (_r0 + r4) * 2048 + _c0 + k * 32 + q4 * 8);     \
        ds = *(const f32x4*)(stats + (_r0 + r4) * 16 + q4 * 4); \
        _Pragma("unroll") for (int mt = 0; mt < 4; ++mt) du[mt] = *(const u32x4*)(U + (_r0 + wr * 64 + mt * 16 + fr) * 2048 + _c0 + wc * 32 + 8 * fq); } while (0)
    int unit = bid;
    if (unit < NUNITS) SM_LOAD(vr, sr, ur, unit);
    if (unit + G < NUNITS) SM_LOAD(vr2, sr2, ur2, unit + G);
    for (int it = 0; unit < NUNITS; unit += G, ++it) {
        const int ch = sm_chunk_of(unit >> 4), g = unit & 15; const size_t row0 = (size_t)ch * 128; const int c0 = g * 128;
        if (g != last_g) {
            __syncthreads();
#pragma unroll
            for (int k = 0; k < 4; ++k) { const int id = tid + 512 * k, r = id >> 4, cc = (id & 15) * 8; *(LAS u32x4*)(Aimg + r * PITCH + cc * 2) = *(const u32x4*)(ws_t + ((size_t)g * 128 + r) * 128 + cc); }
            if (tid < 128) { const float* wp = ws_f + ((size_t)g * 128 + tid) * 128; float s = 0.f;
#pragma unroll 8
                for (int i = 0; i < 32; ++i) { const f32x4 x = *(const f32x4*)(wp + 4 * i); s += (x[0] + x[1]) + (x[2] + x[3]); }
                RS[tid] = s; }
            __syncthreads();
#pragma unroll
            for (int mt = 0; mt < 4; ++mt) { const int p = wr * 64 + mt * 16 + fr; rsw[mt] = RS[p]; bsv[mt] = b_s[g * 128 + p]; }
#pragma unroll
            for (int nt = 0; nt < 2; ++nt) { gam[nt] = *(const f32x4*)(ln_g + c0 + wc * 32 + 8 * fq + 4 * nt); bet[nt] = *(const f32x4*)(ln_b + c0 + wc * 32 + 8 * fq + 4 * nt); }
            last_g = g;
        }
        LAS unsigned char* Bi = Bimg + (it & 1) * 128 * PITCH;
        { float s = sr[0] + sr[2], q = sr[1] + sr[3]; s += xor1_f(s); q += xor1_f(q); s += xor2_f(s); q += xor2_f(q);
          const float mu = s * (1.0f / DA); const float rs = __builtin_amdgcn_rsqf(fmaxf(q * (1.0f / DA) - mu * mu, 0.f) + EPS);
#pragma unroll
          for (int k = 0; k < 4; ++k) { const u32x4 w = vr[k]; u32x2 o0, o1;
              o0.x = pk2((bflo(w.x) - mu) * rs, (bfhi(w.x) - mu) * rs); o0.y = pk2((bflo(w.y) - mu) * rs, (bfhi(w.y) - mu) * rs);
              o1.x = pk2((bflo(w.z) - mu) * rs, (bfhi(w.z) - mu) * rs); o1.y = pk2((bflo(w.w) - mu) * rs, (bfhi(w.w) - mu) * rs);
              *(LAS u32x2*)(Bi + r4 * PITCH + (k * 32 + 4 * q4) * 2) = o0; *(LAS u32x2*)(Bi + r4 * PITCH + (k * 32 + 16 + 4 * q4) * 2) = o1; } }
        u32x4 uc[4];
#pragma unroll
        for (int mt = 0; mt < 4; ++mt) { uc[mt] = ur[mt]; ur[mt] = ur2[mt]; }
#pragma unroll
        for (int k = 0; k < 4; ++k) vr[k] = vr2[k];
        sr = sr2;
        if (unit + 2 * G < NUNITS) SM_LOAD(vr2, sr2, ur2, unit + 2 * G);
        __syncthreads();
        f32x4 acc[4][2];
#pragma unroll
        for (int mt = 0; mt < 4; ++mt)
#pragma unroll
            for (int nt = 0; nt < 2; ++nt) acc[mt][nt] = (f32x4){0.f, 0.f, 0.f, 0.f};
#pragma unroll
        for (int ks = 0; ks < 4; ++ks) {
            bf16x8 bfr[2], afr[4];
#pragma unroll
            for (int mt = 0; mt < 4; ++mt) afr[mt] = *(const LAS bf16x8*)(Aimg + (wr * 64 + mt * 16 + fr) * PITCH + (ks * 32 + 8 * fq) * 2);
#pragma unroll
            for (int nt = 0; nt < 2; ++nt) { const LAS unsigned char* p = Bi + (ks * 32 + 8 * fq + (fr >> 2)) * PITCH + (wc * 32 + nt * 16) * 2 + 8 * (fr & 3);
                const s16x4 lo = tr16(p), hi = tr16(p + 4 * PITCH); bfr[nt] = __builtin_shufflevector(lo, hi, 0, 1, 2, 3, 4, 5, 6, 7); }
#pragma unroll
            for (int mt = 0; mt < 4; ++mt)
#pragma unroll
                for (int nt = 0; nt < 2; ++nt) acc[mt][nt] = __builtin_amdgcn_mfma_f32_16x16x32_bf16(bfr[nt], afr[mt], acc[mt][nt], 0, 0, 0);
        }
#pragma unroll
        for (int mt = 0; mt < 4; ++mt) { const int p = wr * 64 + mt * 16 + fr;
            const f32x4 sv0 = gam[0] * acc[mt][0] + bet[0] * rsw[mt] + bsv[mt], sv1 = gam[1] * acc[mt][1] + bet[1] * rsw[mt] + bsv[mt]; const u32x4 w = uc[mt];
            constexpr bool S8 = (FP8D_SIM & 4) != 0; u32x4 o; o.x = pk2(sim8(bflo(w.x) * sv0[0], S8), sim8(bfhi(w.x) * sv0[1], S8)); o.y = pk2(sim8(bflo(w.y) * sv0[2], S8), sim8(bfhi(w.y) * sv0[3], S8)); o.z = pk2(sim8(bflo(w.z) * sv1[0], S8), sim8(bfhi(w.z) * sv1[1], S8)); o.w = pk2(sim8(bflo(w.w) * sv1[2], S8), sim8(bfhi(w.w) * sv1[3], S8));
            *(u32x4*)(Uo + (row0 + p) * 2048 + c0 + wc * 32 + 8 * fq) = o; }
    }
#undef SM_LOAD
    __syncthreads();
}

DI bf16x8 pack8(const f32x16& x, int s) {
    u32x4 p; p.x = pk2(x[8 * s], x[8 * s + 1]); p.y = pk2(x[8 * s + 2], x[8 * s + 3]); p.z = pk2(x[8 * s + 4], x[8 * s + 5]); p.w = pk2(x[8 * s + 6], x[8 * s + 7]);
    return __builtin_bit_cast(bf16x8, p);
}
DI void at_phase(LAS unsigned char* lds, const bf16_t* Q, const bf16_t* Kb, const bf16_t* Vb, bf16_t* O, const float* sink  , int nunits, int bid, int G) {
    constexpr int KP = 144;
    constexpr int BUFB = 2 * 64 * KP;
    const int tid = tid_opaque(), wid = __builtin_amdgcn_readfirstlane(tid >> 6), lane = tid & 63, r = lane & 31, h = lane >> 5;
    const int g = wid >> 1, wh = wid & 1;
    const int skey = tid >> 3, sdc = tid & 7;
    for (int unit = bid; unit < nunits; unit += G) {
        int b, kvh, qb, qrow0; bool lat;
        if (unit < 2048) { lat = true; b = unit >> 7; kvh = (unit >> 5) & 3; qb = unit & 31; qrow0 = b * 4096 + qb * 128; }
        else { const int u2 = unit - 2048; lat = false; b = u2 >> 3; kvh = (u2 >> 1) & 3; qb = u2 & 1; qrow0 = ML + b * 256 + qb * 128; }
        const int hq = kvh * 4 + g;
        unsigned tmask = lat ? (0x3CCu | (qb >= 1 ? 0x3u : 0u) | (qb <= 30 ? 0x30u : 0u)) : 0x3C0u;
#define AT_KROW(ti) ((ti) < 6 ? b * 4096 + (qb - 1 + ((ti) >> 1)) * 128 + ((ti) & 1) * 64 : ML + b * 256 + ((ti) - 6) * 64)
        int ti = __builtin_ctz(tmask); tmask &= tmask - 1u;
        u32x4 kreg, vreg;
        { const int kr = AT_KROW(ti); kreg = *(const u32x4*)(Kb + (size_t)(kr + skey) * 256 + kvh * 64 + sdc * 8); vreg = *(const u32x4*)(Vb + (size_t)(kr + skey) * 256 + kvh * 64 + sdc * 8); }
        LAS unsigned char* QO = lds + 2 * BUFB + wid * (64 * KP);
        bf16x8 qf[2][4];
        { u32x4 qv[8];
#pragma unroll
          for (int i = 0; i < 8; ++i) { const int row = (lane >> 3) + 8 * i; qv[i] = *(const u32x4*)(Q + (size_t)(qrow0 + wh * 64 + row) * 1024 + hq * 64 + (lane & 7) * 8); }
#pragma unroll
          for (int i = 0; i < 8; ++i) { const int row = (lane >> 3) + 8 * i; *(LAS u32x4*)(QO + row * KP + (lane & 7) * 16) = qv[i]; }
          asm volatile("s_waitcnt lgkmcnt(0)" ::: "memory");
#pragma unroll
          for (int qt = 0; qt < 2; ++qt)
#pragma unroll
              for (int ks = 0; ks < 4; ++ks) qf[qt][ks] = *(const LAS bf16x8*)(QO + (qt * 32 + r) * KP + (ks * 16 + 8 * h) * 2);
          asm volatile("s_waitcnt lgkmcnt(0)" ::: "memory"); }
        f32x16 o[2][2];
#pragma unroll
        for (int dt = 0; dt < 2; ++dt)
#pragma unroll
            for (int qt = 0; qt < 2; ++qt)
#pragma unroll
                for (int i = 0; i < 16; ++i) o[dt][qt][i] = 0.f;
        float mrun[2], lrun[2];
        { const float sk = sink[hq] * LOG2E; mrun[0] = sk; mrun[1] = sk; lrun[0] = h == 0 ? 1.f : 0.f; lrun[1] = lrun[0]; }
        __syncthreads();
        *(LAS u32x4*)(lds + skey * KP + sdc * 16) = kreg; *(LAS u32x4*)(lds + 64 * KP + skey * KP + sdc * 16) = vreg;
        int buf = 0;
        for (;;) {
            const int tn = tmask ? __builtin_ctz(tmask) : -1; tmask &= tmask - 1u;
            if (tn >= 0) { const int kr = AT_KROW(tn); kreg = *(const u32x4*)(Kb + (size_t)(kr + skey) * 256 + kvh * 64 + sdc * 8); vreg = *(const u32x4*)(Vb + (size_t)(kr + skey) * 256 + kvh * 64 + sdc * 8); }
            __syncthreads();
            const LAS unsigned char* Kimg = lds + buf * BUFB; const LAS unsigned char* Vimg = Kimg + 64 * KP;
            const int mode = ti < 2 ? 1 : (ti < 4 ? 0 : (ti < 6 ? 2 : 0));
            const bool skip = (ti == 0 && wh == 1) || (ti == 5 && wh == 0);
            if (!skip) {
            f32x16 s[2][2];
#pragma unroll
            for (int kt = 0; kt < 2; ++kt)
#pragma unroll
                for (int qt = 0; qt < 2; ++qt)
#pragma unroll
                    for (int i = 0; i < 16; ++i) s[kt][qt][i] = -mrun[qt];
            {
                const unsigned kaddr = (unsigned)(__UINTPTR_TYPE__)(Kimg + r * KP + 16 * h);
                bf16x8 k0, k1, k2;
#define AT_KRD(dst, OFF) asm volatile("ds_read_b128 %0, %1 offset:" #OFF : "=v"(dst) : "v"(kaddr))
#define AT_KW(dst, N) asm volatile("s_waitcnt lgkmcnt(" #N ")" : "+v"(dst) :: "memory")
#define AT_QK(kfv, kt, ks) do { s[kt][0] = __builtin_amdgcn_mfma_f32_32x32x16_bf16(kfv, qf[0][ks], s[kt][0], 0, 0, 0); s[kt][1] = __builtin_amdgcn_mfma_f32_32x32x16_bf16(kfv, qf[1][ks], s[kt][1], 0, 0, 0); } while (0)
                asm volatile("s_waitcnt lgkmcnt(0)" ::: "memory");
                AT_KRD(k0, 0); AT_KRD(k1, 32);
                AT_KRD(k2, 64);   AT_KW(k0, 2); AT_QK(k0, 0, 0);
                AT_KRD(k0, 96);   AT_KW(k1, 2); AT_QK(k1, 0, 1);
                AT_KRD(k1, 4608); AT_KW(k2, 2); AT_QK(k2, 0, 2);
                AT_KRD(k2, 4640); AT_KW(k0, 2); AT_QK(k0, 0, 3);
                AT_KRD(k0, 4672); AT_KW(k1, 2); AT_QK(k1, 1, 0);
                AT_KRD(k1, 4704); AT_KW(k2, 2); AT_QK(k2, 1, 1);
                                  AT_KW(k0, 1); AT_QK(k0, 1, 2);
                                  AT_KW(k1, 0); AT_QK(k1, 1, 3);
#undef AT_KRD
#undef AT_KW
#undef AT_QK
            }
            if (mode != 0) {
                const int jb = (ti & 1) * 64;
#pragma unroll
                for (int qt = 0; qt < 2; ++qt) { const int dlt = jb + 4 * h - (wh * 64 + qt * 32 + r);
                    if (mode == 1) {
#pragma unroll
                        for (int kt = 0; kt < 2; ++kt)
#pragma unroll
                            for (int i = 0; i < 16; ++i) { if (dlt < -(kt * 32 + (i & 3) + 8 * (i >> 2))) s[kt][qt][i] = -INFINITY; }
                    } else {
#pragma unroll
                        for (int kt = 0; kt < 2; ++kt)
#pragma unroll
                            for (int i = 0; i < 16; ++i) { if (dlt > -(kt * 32 + (i & 3) + 8 * (i >> 2))) s[kt][qt][i] = -INFINITY; }
                    } }
            }
            float mx[2];
#pragma unroll
            for (int qt = 0; qt < 2; ++qt) { float m0 = __builtin_fmaxf(s[0][qt][0], s[1][qt][0]);
#pragma unroll
                for (int i = 1; i < 16; ++i) m0 = __builtin_fmaxf(__builtin_fmaxf(m0, s[0][qt][i]), s[1][qt][i]);
                mx[qt] = x32_max(m0); }
            if (__builtin_amdgcn_ballot_w64(mx[0] > 8.0f || mx[1] > 8.0f) != 0ull) {
#pragma unroll
                for (int qt = 0; qt < 2; ++qt) { const float d = fmaxf(mx[qt], 0.f), alpha = __builtin_amdgcn_exp2f(-d); mrun[qt] += d; lrun[qt] *= alpha;
#pragma unroll
                    for (int kt = 0; kt < 2; ++kt)
#pragma unroll
                        for (int i = 0; i < 16; ++i) s[kt][qt][i] -= d;
#pragma unroll
                    for (int dt = 0; dt < 2; ++dt)
#pragma unroll
                        for (int i = 0; i < 16; ++i) o[dt][qt][i] *= alpha; }
            }
#pragma unroll
            for (int qt = 0; qt < 2; ++qt) { float ls = 0.f;
#pragma unroll
                for (int kt = 0; kt < 2; ++kt)
#pragma unroll
                    for (int i = 0; i < 16; ++i) { const float p = __builtin_amdgcn_exp2f(s[kt][qt][i]); s[kt][qt][i] = p; ls += p; }
                lrun[qt] += ls; }
#pragma unroll
            for (int kt = 0; kt < 2; ++kt)
#pragma unroll
                for (int ss = 0; ss < 2; ++ss) {
                    bf16x8 vf[2];
#pragma unroll
                    for (int dt = 0; dt < 2; ++dt) { const LAS unsigned char* p = Vimg + (kt * 32 + 16 * ss + 4 * h + ((lane & 15) >> 2)) * KP + (dt * 32 + 16 * ((lane >> 4) & 1)) * 2 + 8 * (lane & 3);
                        const s16x4 lo = tr16(p), hi = tr16(p + 8 * KP); vf[dt] = __builtin_shufflevector(lo, hi, 0, 1, 2, 3, 4, 5, 6, 7); }
#pragma unroll
                    for (int qt = 0; qt < 2; ++qt) { const bf16x8 pf = pack8(s[kt][qt], ss);
#pragma unroll
                        for (int dt = 0; dt < 2; ++dt) o[dt][qt] = __builtin_amdgcn_mfma_f32_32x32x16_bf16(vf[dt], pf, o[dt][qt], 0, 0, 0); }
                }
            }
            if (tn < 0) break;
            { LAS unsigned char* nb = lds + (buf ^ 1) * BUFB; *(LAS u32x4*)(nb + skey * KP + sdc * 16) = kreg; *(LAS u32x4*)(nb + 64 * KP + skey * KP + sdc * 16) = vreg; }
            buf ^= 1; ti = tn;
        }
#undef AT_KROW
#pragma unroll
        for (int qt = 0; qt < 2; ++qt) { const float lt = x32_sum(lrun[qt]); const float inv = 1.0f / lt;
#pragma unroll
            for (int dt = 0; dt < 2; ++dt)
#pragma unroll
                for (int ig = 0; ig < 4; ++ig) {
                    if (FP8_ATT) { *(LAS unsigned*)(QO + (qt * 32 + r) * KP + (dt * 32 + 8 * ig + 4 * h)) = pk4_fp8(o[dt][qt][4 * ig] * inv, o[dt][qt][4 * ig + 1] * inv, o[dt][qt][4 * ig + 2] * inv, o[dt][qt][4 * ig + 3] * inv); }
                    else { constexpr bool S8 = (FP8D_SIM & 2) != 0; u32x2 w; w.x = pk2(sim8(o[dt][qt][4 * ig] * inv, S8), sim8(o[dt][qt][4 * ig + 1] * inv, S8)); w.y = pk2(sim8(o[dt][qt][4 * ig + 2] * inv, S8), sim8(o[dt][qt][4 * ig + 3] * inv, S8));
                        *(LAS u32x2*)(QO + (qt * 32 + r) * KP + (dt * 32 + 8 * ig + 4 * h) * 2) = w; } } }
        asm volatile("s_waitcnt lgkmcnt(0)" ::: "memory");
        if (FP8_ATT) {
#pragma unroll
            for (int i = 0; i < 4; ++i) { const int row = (lane >> 2) + 16 * i; const u32x4 w = *(const LAS u32x4*)(QO + row * KP + (lane & 3) * 16);
                *(u32x4*)((unsigned char*)O + (size_t)(qrow0 + wh * 64 + row) * 1024 + hq * 64 + (lane & 3) * 16) = w; }
        } else {
#pragma unroll
        for (int i = 0; i < 8; ++i) { const int row = (lane >> 3) + 8 * i; const u32x4 w = *(const LAS u32x4*)(QO + row * KP + (lane & 7) * 16);
            *(u32x4*)(O + (size_t)(qrow0 + wh * 64 + row) * 1024 + hq * 64 + (lane & 7) * 8) = w; }
        }
        asm volatile("s_waitcnt lgkmcnt(0)" ::: "memory");
    }
    __syncthreads();
}

struct Args { const float* in[23]; float* out; unsigned char* ws; int ph_lo, ph_hi; };
static_assert(sizeof(Args) == 25 * 8 + 8, "Args has no padding");
#define AS4 __attribute__((address_space(4)))
DI unsigned long long karg(int k) { const unsigned long long AS4* kp = (const unsigned long long AS4*)__builtin_amdgcn_kernarg_segment_ptr(); asm volatile("" : "+s"(kp)); return kp[k]; }
#define KIN(k) ((const float*)(const GAS float*)karg(k))
#define KOUT() ((float*)(GAS float*)karg(23))
#define KWS() ((unsigned char*)(GAS unsigned char*)karg(24))

#ifndef DBG_ONLY
#define DBG_ONLY -1
#endif
#ifndef ALIGN_E12
#define ALIGN_E12 true
#endif
#ifndef DUP_MASK
#define DUP_MASK 0
#endif
#ifndef STAMP_MASK
#define STAMP_MASK 0
#endif
#ifndef STAMP_TMAX_US
#define STAMP_TMAX_US 5000
#endif
#define NDUP(n) (((DUP_MASK >> (n)) & 1) ? 2 : 1)
#define DUMMY(n) (NDUP(n) == 2 && dup_ == 0)
#define ST0(n) do { if (STAMP_MASK && ((STAMP_MASK >> (n)) & 1) && blockIdx.x == 0) t_st0 = __builtin_amdgcn_s_memrealtime(); } while (0)
#define ST1(n) do { if (STAMP_MASK && ((STAMP_MASK >> (n)) & 1) && blockIdx.x == 0) t_acc += __builtin_amdgcn_s_memrealtime() - t_st0; } while (0)
#define SITE(n) (DBG_ONLY < 0 || DBG_ONLY == (n))

__global__ void __launch_bounds__(512, 2) mega_fwd(Args args) {
    extern __shared__ __attribute__((aligned(16))) unsigned char lds_raw[];
    LAS unsigned char* lds = (LAS unsigned char*)lds_raw;
    const int tid = threadIdx.x;
    for (int u = tid; u < (LDS_BYTES - RING_BYTES) / 4; u += 512) ((LAS unsigned*)(lds + RING_BYTES))[u] = 0u;
    __syncthreads();
    XcdBarrier bar; bar.bar = (unsigned*)(args.ws + WS_CTL) + CW_BAR; bar.x = 0; bar.st = nullptr;
    if (!MK_SPLIT) bar = xcd_barrier_post((unsigned*)(args.ws + WS_CTL) + CW_BAR, (volatile LAS unsigned*)(lds + MISC_OFF) + 8);
    const int lo = args.ph_lo, hi = args.ph_hi;
    unsigned long long t_st0 = 0, t_acc = 0; (void)t_st0; (void)t_acc;
#define IN(k) (lo <= (k) && (k) < hi)
#ifndef SEAM_REP
#define SEAM_REP 1
#endif
#define SEAM(k) do { if (!MK_SPLIT && IN((k) + 1)) { for (int rep_ = 0; rep_ < SEAM_REP; ++rep_) xcd_barrier(bar); } } while (0)
#ifndef STEAL
#define STEAL 1
#endif
#define STEAL_ARGS() P0Args sa; sa.w1 = KIN(19); sa.w3 = KIN(20); sa.w2 = KIN(21); sa.w13_t = (bf16_t*)(ws + WS_W13); sa.w2_t = (bf16_t*)(ws + WS_W2); unsigned* sq = (unsigned*)(ws + WS_CTL) + CW_STEAL
#define STEAL_TAIL(nunits, budget, own) do { if (STEAL && ((nunits) % G) != 0 && bid >= ((nunits) % G)) { STEAL_ARGS(); \
        if (own) steal_convert(lds, sq + 64 * layer, sa, layer, (budget)); else if (layer < DEPTH - 1) steal_convert(lds, sq + 64 * (layer + 1), sa, layer + 1, (budget)); } } while (0)
#define WAVE_IDS() const int tid_ = tid_opaque(); const int lane = tid_ & 63, wave = __builtin_amdgcn_readfirstlane(tid_ >> 6); const int G = gridDim.x, bid = blockIdx.x; const int gw = bid * 8 + wave, NGW = G * 8; (void)lane; (void)gw; (void)NGW; (void)G; (void)bid

    ST0(0); for (int dup_ = 0; dup_ < NDUP(0); ++dup_) if (SITE(0) && IN(0)) { if (dup_) __syncthreads();
        WAVE_IDS(); unsigned char* ws = KWS();
        p0_mod(lds, KIN(1), KIN(3), KIN(4), KIN(5), (float*)(ws + WS_MOD), bid, G);
        P0Args pa; pa.w_in = KIN(8); pa.w_out = KIN(14); pa.w_qkv = KIN(15); pa.w_o = KIN(17); pa.w1 = KIN(19); pa.w3 = KIN(20); pa.w2 = KIN(21); pa.w_s = KIN(12);
        pa.win_t = (bf16_t*)(ws + WS_WIN); pa.wout_t = (bf16_t*)(ws + WS_WOUT); pa.wqkv_t = (bf16_t*)(ws + WS_WQKV); pa.wo_t = (bf16_t*)(ws + WS_WO); pa.w13_t = (bf16_t*)(ws + WS_W13); pa.w2_t = (bf16_t*)(ws + WS_W2);
        pa.ws_t = (bf16_t*)(ws + WS_WSP); pa.cosT = (float*)(ws + WS_ROPE); pa.sinT = pa.cosT + 4096 * 32;
        p0_convert(lds, pa, gw, NGW, lane, wave);
    }
    SEAM(0); ST1(0);
    ST0(1); for (int dup_ = 0; dup_ < NDUP(1); ++dup_) if (SITE(1) && IN(1)) { if (dup_) __syncthreads(); WAVE_IDS(); unsigned char* ws = KWS();
        n0_phase(KIN(0), KIN(2), DUMMY(1) ? (bf16_t*)(ws + WS_BIG) : (bf16_t*)(ws + WS_X), (const float*)(ws + WS_MOD), KIN(6), DUMMY(1) ? (bf16_t*)(ws + WS_BIG + 300 * MiB) : (bf16_t*)(ws + WS_H), gw, NGW, lane); }
    SEAM(1); ST1(1);

    for (int layer = 0; layer < DEPTH; ++layer) {
        const int pb = 2 + 8 * layer, j = layer >> 1; const bool lastl = layer == DEPTH - 1;
        const int mrows = lastl ? ML : MT;
        if ((layer & 1) == 0) {
            ST0(2); for (int dup_ = 0; dup_ < NDUP(2); ++dup_) if (SITE(2) && IN(pb + 0)) { if (dup_) __syncthreads(); WAVE_IDS(); unsigned char* ws = KWS();
                pg8::Gemm g{(const bf16_t*)(ws + WS_H), (const bf16_t*)(ws + WS_WIN) + (size_t)j * 4096 * 1024, nullptr}; pg8::GroupedOrder<16, 0> S; S.init(MT / 256, 1, G, bid);
                EpiGeluUV E{(bf16_t*)(ws + WS_BIG + BIG_U), (bf16_t*)(ws + WS_BIG + BIG_V), KIN(9) + (size_t)j * 4096, (float*)(ws + WS_STATS), lds + XCH_OFF};
                pg8::gemm_phase<EpiGeluUV, pg8::GroupedOrder<16, 0>, false, 1024, 0, 0, true, 2, (ROTK_MASK & 4) != 0>(lds, g, S, E); }
            SEAM(pb + 0); ST1(2);
            ST0(3); for (int dup_ = 0; dup_ < NDUP(3); ++dup_) if (SITE(3) && IN(pb + 1)) { if (dup_) __syncthreads(); WAVE_IDS(); unsigned char* ws = KWS();
                sm_phase(lds, (const bf16_t*)(ws + WS_BIG + BIG_U), DUMMY(3) ? (bf16_t*)(ws + WS_Y) : (bf16_t*)(ws + WS_BIG + BIG_U), (const bf16_t*)(ws + WS_BIG + BIG_V), (const float*)(ws + WS_STATS), (const bf16_t*)(ws + WS_WSP) + (size_t)j * 16 * 128 * 128,
                         KIN(12) + (size_t)j * 16 * 128 * 128, KIN(13) + (size_t)j * 16 * 128, KIN(10) + (size_t)j * 2048, KIN(11) + (size_t)j * 2048, bid, G); }
            SEAM(pb + 1); ST1(3);
            ST0(4); for (int dup_ = 0; dup_ < NDUP(4); ++dup_) if (SITE(4) && IN(pb + 2)) { if (dup_) __syncthreads(); WAVE_IDS(); unsigned char* ws = KWS();
                pg8::Gemm g{(const bf16_t*)(ws + WS_BIG + BIG_U), (const bf16_t*)(ws + WS_WOUT) + (size_t)j * 1024 * 2048, nullptr}; pg8::GroupedOrder<4, 0> S; S.init(MT / 256, 1, G, bid);
                EpiResAdd E{(const bf16_t*)(ws + WS_X), DUMMY(4) ? (bf16_t*)(ws + WS_Y) : (bf16_t*)(ws + WS_X), (const float*)(ws + WS_MOD) + (size_t)layer * 17 * 6144 + 2048, 1.0f};
                pg8::gemm_phase<EpiResAdd, pg8::GroupedOrder<4, 0>, false, 2048, 0, 0, true, 2, (ROTK_MASK & 8) != 0>(lds, g, S, E); if (dup_ == NDUP(4) - 1) STEAL_TAIL((MT / 256) * 4, 8, true); }
            SEAM(pb + 2); ST1(4);
        } else {
            ST0(5); for (int dup_ = 0; dup_ < NDUP(5); ++dup_) if (SITE(5) && IN(pb + 0)) { if (dup_) __syncthreads(); WAVE_IDS(); unsigned char* ws = KWS();
                pg8::Gemm g{(const bf16_t*)(ws + WS_H), (const bf16_t*)(ws + WS_WQKV + (size_t)j * 1536 * 1024 * (FP8_ATT ? 1 : 2)), nullptr}; pg8::GroupedOrder<6, 0> S; S.init(MT / 256, 1, G, bid);
                EpiQKV E{(bf16_t*)(ws + WS_BIG + BIG_Q), (bf16_t*)(ws + WS_BIG + BIG_K), (bf16_t*)(ws + WS_BIG + BIG_VV), (const float*)(ws + WS_ROPE), (const float*)(ws + WS_ROPE) + 4096 * 32};
                pg8::gemm_phase<EpiQKV, pg8::GroupedOrder<6, 0>, false, 1024, 0, 0, true, FP8_ATT ? 1 : 2, (ROTK_MASK & 16) != 0>(lds, g, S, E); if (dup_ == NDUP(5) - 1) STEAL_TAIL((MT / 256) * 6, 2, true); }
            SEAM(pb + 0); ST1(5);
            ST0(6); for (int dup_ = 0; dup_ < NDUP(6); ++dup_) if (SITE(6) && IN(pb + 1)) { if (dup_) __syncthreads(); WAVE_IDS(); unsigned char* ws = KWS();
                at_phase(lds, (const bf16_t*)(ws + WS_BIG + BIG_Q), (const bf16_t*)(ws + WS_BIG + BIG_K), (const bf16_t*)(ws + WS_BIG + BIG_VV), (bf16_t*)(ws + WS_BIG + BIG_O), KIN(16) + j * 16, lastl ? 2048 : 2048 + 128, bid, G); if (dup_ == NDUP(6) - 1) STEAL_TAIL(lastl ? 2048 : 2048 + 128, 5, true); }
            SEAM(pb + 1); ST1(6);
            ST0(7); for (int dup_ = 0; dup_ < NDUP(7); ++dup_) if (SITE(7) && IN(pb + 2)) { if (dup_) __syncthreads(); WAVE_IDS(); unsigned char* ws = KWS();
                pg8::Gemm g{(const bf16_t*)(ws + WS_BIG + BIG_O), (const bf16_t*)(ws + WS_WO + (size_t)j * 1024 * 1024 * (FP8_ATT ? 1 : 2)), nullptr}; pg8::GroupedOrder<4, 0> S; S.init(mrows / 256, 1, G, bid);
                EpiResAdd E{(const bf16_t*)(ws + WS_X), DUMMY(7) ? (bf16_t*)(ws + WS_Y) : (bf16_t*)(ws + WS_X), (const float*)(ws + WS_MOD) + (size_t)layer * 17 * 6144 + 2048, FP8_ATT ? 1.0f / WM_SCALE : 1.0f};
                pg8::gemm_phase<EpiResAdd, pg8::GroupedOrder<4, 0>, false, 1024, 0, 0, true, FP8_ATT ? 1 : 2, (ROTK_MASK & 32) != 0>(lds, g, S, E); if (dup_ == NDUP(7) - 1) STEAL_TAIL((mrows / 256) * 4, 1, true); }
            SEAM(pb + 2); ST1(7);
        }
        ST0(8); for (int dup_ = 0; dup_ < NDUP(8); ++dup_) if (SITE(8) && IN(pb + 3)) { if (dup_) __syncthreads(); WAVE_IDS(); unsigned char* ws = KWS();
            n2_phase(lds, mrows, (const bf16_t*)(ws + WS_X), (const float*)(ws + WS_MOD) + (size_t)layer * 17 * 6144, KIN(7) + layer * 1024, KIN(18) + (size_t)layer * 1024 * 16,
                     (bf16_t*)(ws + WS_H), (float*)(ws + WS_AFF), bid, G); }
        SEAM(pb + 3); ST1(8);
        ST0(9); for (int dup_ = 0; dup_ < NDUP(9); ++dup_) if (SITE(9) && IN(pb + 4)) { if (dup_) __syncthreads(); WAVE_IDS(); unsigned char* ws = KWS();
            const float* aff = (const float*)(ws + WS_AFF); int* rowidx = (int*)(ws + WS_ROWIDX); float* gate = (float*)(ws + WS_GATE); int* tokslot = (int*)(ws + WS_TOKSLOT);
            for (int p = bid; p < 256; p += G) { const int b = p >> 4, e = p & 15; tk_pair(lds, aff, e, b * 4096, e * SLOTS_E + b * CAPL, !lastl, ML + b * 256, e * SLOTS_E + NB * CAPL + b * CAPC, rowidx, gate, tokslot + (size_t)e * MT); }
            if (STEAL && dup_ == NDUP(9) - 1) { STEAL_ARGS(); steal_convert(lds, sq + 64 * layer, sa, layer, STEAL_NCHUNKS); }
        }
        SEAM(pb + 4); ST1(9);
        const int nMe = lastl ? 32 : 34;
        ST0(10); for (int dup_ = 0; dup_ < NDUP(10); ++dup_) if (SITE(10) && IN(pb + 5)) { if (dup_) __syncthreads(); WAVE_IDS(); unsigned char* ws = KWS();
            pg8::Gemm g{(const bf16_t*)(ws + WS_H), (const bf16_t*)(ws + WS_W13 + (size_t)layer * 16 * 4096 * 1024), (const int*)(ws + WS_ROWIDX)}; pg8::GroupedOrder<16, 34> S; S.init(nMe, 16, G, bid);
            EpiSwiGLU E{(unsigned char*)(ws + WS_BIG)};
#if ABL_E1
            { EpiSwiGLU Ed{(unsigned char*)(ws + WS_Y)}; pg8::gemm_phase<EpiSwiGLU, pg8::GroupedOrder<16, 34>, true, 1024, (size_t)4096 * 1024, 0, ALIGN_E12, 1, (ROTK_MASK & 1) != 0, (ABL_E1) & 255>(lds, g, S, Ed); __syncthreads(); }
#endif
            pg8::gemm_phase<EpiSwiGLU, pg8::GroupedOrder<16, 34>, true, 1024, (size_t)4096 * 1024, 0, ALIGN_E12, 1, (ROTK_MASK & 1) != 0>(lds, g, S, E); }
        SEAM(pb + 5); ST1(10);
        ST0(11); for (int dup_ = 0; dup_ < NDUP(11); ++dup_) if (SITE(11) && IN(pb + 6)) { if (dup_) __syncthreads(); WAVE_IDS(); unsigned char* ws = KWS();
            pg8::Gemm g{(const bf16_t*)(ws + WS_BIG), (const bf16_t*)(ws + WS_W2 + (size_t)layer * 16 * 1024 * 2048), nullptr}; pg8::GroupedOrder<4, 34, true> S; S.init(nMe, 16, G, bid);
            EpiGateY E{(unsigned char*)(ws + WS_Y), (const float*)(ws + WS_GATE)};
            pg8::gemm_phase<EpiGateY, pg8::GroupedOrder<4, 34, true>, false, 2048, (size_t)1024 * 2048, 0, ALIGN_E12, 1, (ROTK_MASK & 2) != 0>(lds, g, S, E); if (dup_ == NDUP(11) - 1) STEAL_TAIL(nMe * 4 * 16, 4, false); }
        SEAM(pb + 6); ST1(11);
        ST0(12); for (int dup_ = 0; dup_ < NDUP(12); ++dup_) if (SITE(12) && IN(pb + 7)) { if (dup_) __syncthreads(); WAVE_IDS(); unsigned char* ws = KWS();
            const float* modl = (const float*)(ws + WS_MOD) + (size_t)layer * 17 * 6144;
            if (!lastl) n1_phase(1, MT, (const bf16_t*)(ws + WS_X), DUMMY(12) ? (bf16_t*)(ws + WS_BIG) : (bf16_t*)(ws + WS_X), nullptr, (const unsigned char*)(ws + WS_Y), (const int*)(ws + WS_TOKSLOT), modl, modl + 17 * 6144, KIN(6) + (layer + 1) * 1024,
                                 DUMMY(12) ? (bf16_t*)(ws + WS_BIG + 300 * MiB) : (bf16_t*)(ws + WS_H), gw, NGW, lane, ((layer + 1) & 1) ? (FP8D_SIM & 2) != 0 : (FP8D_SIM & 1) != 0, FP8_ATT && ((layer + 1) & 1));
            else n1_phase(2, ML, (const bf16_t*)(ws + WS_X), nullptr, DUMMY(12) ? (float*)(ws + WS_BIG) : KOUT(), (const unsigned char*)(ws + WS_Y), (const int*)(ws + WS_TOKSLOT), modl, nullptr, KIN(22), nullptr, gw, NGW, lane);
        }
        SEAM(pb + 7); ST1(12);
    }
#undef IN
#undef SEAM
}

extern "C" void kernel_launch(void* const* d_in, const int* in_sizes, int n_in, void* d_out, int out_size, void* d_ws, size_t ws_size, hipStream_t stream) {
    static int grid = 0;
    if (grid == 0) {
        if (n_in != 23 || out_size != ML * D || ws_size < WS_END) { fprintf(stderr, "kernel_launch: unexpected shapes (n_in %d, out %d, ws %zu); nothing launched\n", n_in, out_size, ws_size); grid = -1; return; }
        int dev = 0, cus = 0, per_cu = 0;
        if (hipGetDevice(&dev) != hipSuccess || hipDeviceGetAttribute(&cus, hipDeviceAttributeMultiprocessorCount, dev) != hipSuccess) { grid = -1; return; }
        if (hipFuncSetAttribute((const void*)mega_fwd, hipFuncAttributeMaxDynamicSharedMemorySize, LDS_BYTES) != hipSuccess) { fprintf(stderr, "kernel_launch: hipFuncSetAttribute failed\n"); grid = -1; return; }
        if (hipOccupancyMaxActiveBlocksPerMultiprocessor(&per_cu, (const void*)mega_fwd, 512, LDS_BYTES) != hipSuccess || per_cu < 1)
            fprintf(stderr, "kernel_launch: note: occupancy query reports %d workgroups per CU\n", per_cu);
        (void)hipGetLastError();
        grid = cus;
    }
    if (grid < 0) return;
    if (hipMemsetAsync((char*)d_ws + WS_CTL, 0, CTL_ZERO_BYTES, stream) != hipSuccess) return;
    Args a{};
    for (int i = 0; i < 23; ++i) a.in[i] = (const float*)d_in[i];
    a.out = (float*)d_out; a.ws = (unsigned char*)d_ws;
    constexpr int NPH = 2 + 8 * DEPTH;
#if MK_SPLIT
    for (int p = 0; p < NPH; ++p) { a.ph_lo = p; a.ph_hi = p + 1; hipLaunchKernelGGL(mega_fwd, dim3(grid), dim3(512), LDS_BYTES, stream, a); }
#else
    a.ph_lo = 0; a.ph_hi = NPH;
    hipLaunchKernelGGL(mega_fwd, dim3(grid), dim3(512), LDS_BYTES, stream, a);
#endif
    const hipError_t le = hipPeekAtLastError();
    if (le != hipSuccess) fprintf(stderr, "kernel_launch: launch failed: %s\n", hipGetErrorName(le));
}
```

```cpp
#include <hip/hip_runtime.h>
#include <cstdio>
#include <cstdint>

#define LAS __attribute__((address_space(3)))
#define GAS __attribute__((address_space(1)))
typedef unsigned short bf16_t;
typedef short bf16x8 __attribute__((ext_vector_type(8)));
typedef short s16x4 __attribute__((ext_vector_type(4)));
typedef float f32x4 __attribute__((ext_vector_type(4)));
typedef float f32x2 __attribute__((ext_vector_type(2)));
typedef float f32x16 __attribute__((ext_vector_type(16)));
typedef unsigned u32x4 __attribute__((ext_vector_type(4)));
typedef unsigned u32x2 __attribute__((ext_vector_type(2)));
typedef short v4i16_t __attribute__((ext_vector_type(4)));
#define DI __device__ __forceinline__

#ifndef MK_SPLIT
#define MK_SPLIT 0
#endif

constexpr int D = 1024, NB = 16, SEQ = 4096, CTX = 256, DEPTH = 4;
constexpr int ML = NB * SEQ, MC = NB * CTX, MT = ML + MC;
constexpr int DA = 2048, NE = 16, CAPL = 512, CAPC = 32;
constexpr int SLOTS_E = NB * CAPL + NB * CAPC;
constexpr int NSLOT = NE * SLOTS_E;
constexpr int DFF = 2048, NQKV = 1536;
constexpr float EPS = 1e-6f;
constexpr float LOG2E = 1.4426950408889634f;
constexpr float W13_SCALE = 32.0f, W2_SCALE = 64.0f, Y_SCALE = 32.0f, WM_SCALE = 32.0f;
constexpr float QSCALE = 0.125f * LOG2E;

constexpr size_t MiB = 1u << 20;
constexpr size_t WS_CTL = 0, CTL_ZERO_BYTES = 1 * MiB;
constexpr size_t WS_MOD = 1 * MiB;
constexpr size_t WS_ROPE = 3 * MiB;
constexpr size_t WS_AFF = 4 * MiB;
constexpr size_t WS_TOKSLOT = 9 * MiB;
constexpr size_t WS_ROWIDX = 14 * MiB;
constexpr size_t WS_GATE = 15 * MiB;
constexpr size_t WS_STATS = 16 * MiB;
constexpr size_t WS_XC = 34 * MiB;
constexpr size_t WS_WIN = 50 * MiB;
constexpr size_t WS_WOUT = 66 * MiB;
constexpr size_t WS_WQKV = 74 * MiB;
constexpr size_t WS_WO = 80 * MiB;
constexpr size_t WS_WSP = 84 * MiB;
constexpr size_t WS_W13 = 86 * MiB;
constexpr size_t WS_W2 = 598 * MiB;
constexpr size_t WS_H = 854 * MiB;
constexpr size_t WS_BIG = 990 * MiB;
constexpr size_t WS_Y = 1534 * MiB;
constexpr size_t WS_X = 1806 * MiB;
constexpr size_t WS_END = 1942 * MiB;
constexpr size_t BIG_U = 0, BIG_V = (size_t)MT * 2048 * 2;
constexpr size_t BIG_Q = 0, BIG_K = (size_t)MT * 1024 * 2, BIG_VV = BIG_K + (size_t)MT * 256 * 2, BIG_O = BIG_VV + (size_t)MT * 256 * 2;
static_assert(BIG_O + (size_t)MT * 1024 * 2 <= 544 * MiB && (size_t)NSLOT * 2048 * 2 <= 544 * MiB && BIG_V + (size_t)MT * 2048 * 2 <= 544 * MiB, "big region");
static_assert(WS_STATS + (size_t)MT * 64 * 4 <= WS_XC && WS_AFF + (size_t)MT * 64 <= WS_TOKSLOT && WS_TOKSLOT + (size_t)MT * 64 <= WS_ROWIDX, "ws map");
constexpr int CW_BAR = 4096;
constexpr int CW_STEAL = 1024;

constexpr int RING_BYTES = 131072;
constexpr int MISC_OFF = RING_BYTES + 320;
constexpr int XCH_OFF = RING_BYTES + 1024;
constexpr int LDS_BYTES = 147456;
static_assert(MISC_OFF + 128 <= XCH_OFF && XCH_OFF + 8192 <= LDS_BYTES, "LDS map");

DI unsigned pk2(float lo, float hi) { unsigned r; asm("v_cvt_pk_bf16_f32 %0, %1, %2" : "=v"(r) : "v"(lo), "v"(hi)); return r; }
DI unsigned pk4_fp8(float a, float b, float c, float d) { int p = __builtin_amdgcn_cvt_pk_fp8_f32(a, b, 0, false); p = __builtin_amdgcn_cvt_pk_fp8_f32(c, d, p, true); return (unsigned)p; }
#ifndef FP8_ATT
#define FP8_ATT 1
#endif
#ifndef ABL_E1
#define ABL_E1 0
#endif
#ifndef ROTK_MASK
#define ROTK_MASK 0
#endif
#ifndef FP8D_SIM
#define FP8D_SIM 0
#endif
DI float sim8(float v, bool on) { if (!FP8D_SIM || !on) return v; const int p = __builtin_amdgcn_cvt_pk_fp8_f32(v, v, 0, false); return __builtin_amdgcn_cvt_f32_fp8(p, 0); }
DI float bflo(unsigned w) { return __uint_as_float(w << 16); }
DI float bfhi(unsigned w) { return __uint_as_float(w & 0xffff0000u); }
typedef unsigned u32v2_t __attribute__((ext_vector_type(2)));
#define DPP_F(v, ctrl) __uint_as_float((unsigned)__builtin_amdgcn_mov_dpp((int)__float_as_uint(v), ctrl, 0xF, 0xF, true))
#define DPP_I(v, ctrl) __builtin_amdgcn_mov_dpp((v), ctrl, 0xF, 0xF, true)
DI float xor1_f(float v) { return DPP_F(v, 0xB1); }
DI float xor2_f(float v) { return DPP_F(v, 0x4E); }
DI float row16_sum(float v) { v += DPP_F(v, 0xB1); v += DPP_F(v, 0x4E); v += DPP_F(v, 0x141); v += DPP_F(v, 0x140); return v; }
DI float row16_max(float v) { v = fmaxf(v, DPP_F(v, 0xB1)); v = fmaxf(v, DPP_F(v, 0x4E)); v = fmaxf(v, DPP_F(v, 0x141)); v = fmaxf(v, DPP_F(v, 0x140)); return v; }
DI int row16_sum_i(int v) { v += DPP_I(v, 0xB1); v += DPP_I(v, 0x4E); v += DPP_I(v, 0x141); v += DPP_I(v, 0x140); return v; }
DI float x16_sum(float v) { const unsigned x = __float_as_uint(v); const u32v2_t r = __builtin_amdgcn_permlane16_swap(x, x, false, false); return __uint_as_float(r[0]) + __uint_as_float(r[1]); }
DI float x32_sum(float v) { const unsigned x = __float_as_uint(v); const u32v2_t r = __builtin_amdgcn_permlane32_swap(x, x, false, false); return __uint_as_float(r[0]) + __uint_as_float(r[1]); }
DI float x32_max(float v) { const unsigned x = __float_as_uint(v); const u32v2_t r = __builtin_amdgcn_permlane32_swap(x, x, false, false); return fmaxf(__uint_as_float(r[0]), __uint_as_float(r[1])); }
DI int x16_sum_i(int v) { const u32v2_t r = __builtin_amdgcn_permlane16_swap((unsigned)v, (unsigned)v, false, false); return (int)(r[0] + r[1]); }
DI int x32_sum_i(int v) { const u32v2_t r = __builtin_amdgcn_permlane32_swap((unsigned)v, (unsigned)v, false, false); return (int)(r[0] + r[1]); }
DI float wave_sum(float v) { return x32_sum(x16_sum(row16_sum(v))); }
DI int wave_sum_i(int v) { return x32_sum_i(x16_sum_i(row16_sum_i(v))); }
DI int tid_opaque() { int t = threadIdx.x; asm volatile("" : "+v"(t)); return t; }
#define LDS_WAIT() asm volatile("s_waitcnt lgkmcnt(0)" ::: "memory")
#define VM_WAIT() asm volatile("s_waitcnt vmcnt(0)" ::: "memory")
#define RLX_AGENT __ATOMIC_RELAXED, __HIP_MEMORY_SCOPE_AGENT

#define XB_TMO      128
#define XB_XCNT(j)  (256  + 64 * (j))
#define XB_XSUB(j)  (1280 + 64 * (j))
#define XB_XGEN(j)  (2304 + 64 * (j))
#define XB_TOP      3328
#define XB_TOPGEN   3392
#define XCD_BAR_WORDS 3456
#define XB_SPIN_CAP (1u << 18)
DI unsigned xb_ld(unsigned* p)              { return __hip_atomic_load(p, __ATOMIC_RELAXED, __HIP_MEMORY_SCOPE_AGENT); }
DI unsigned xb_add(unsigned* p, unsigned v) { return __hip_atomic_fetch_add(p, v, __ATOMIC_RELAXED, __HIP_MEMORY_SCOPE_AGENT); }
DI unsigned xb_xcc_id() { return (unsigned)__builtin_amdgcn_s_getreg((3 << 11) | 20) & 0xFu; }
#define XB_SPIN(cond, bar) do { unsigned _sp = 0; while (cond) { __builtin_amdgcn_s_sleep(1); \
    if ((++_sp & 255u) == 0u) { if (xb_ld(&(bar)[XB_TMO])) break; if (_sp > XB_SPIN_CAP) { atomicAdd(&(bar)[XB_TMO], 1u); break; } } } } while (0)
struct XcdBarrier { unsigned* bar; unsigned x; volatile LAS unsigned* st; };
DI XcdBarrier xcd_barrier_post(unsigned* bar, volatile LAS unsigned* st) {
    XcdBarrier b; b.bar = bar; b.x = (unsigned)__builtin_amdgcn_readfirstlane((int)xb_xcc_id()); b.st = st;
    if (threadIdx.x == 0) (void)xb_add(&bar[XB_XCNT(b.x)], 1u);
    return b;
}
DI void xcd_barrier_complete(unsigned* bar, unsigned x, unsigned& nloc, unsigned& nx) {
    const unsigned G = gridDim.x * gridDim.y * gridDim.z;
    unsigned sum, cnt, mine, sp = 0u;
    for (;;) {
        sum = 0u; cnt = 0u; mine = 0u;
#pragma unroll
        for (unsigned j = 0; j < 16; ++j) { const unsigned c = xb_ld(&bar[XB_XCNT(j)]); sum += c; cnt += (c > 0u) ? 1u : 0u; mine = (j == x) ? c : mine; }
        if (sum == G) break;
        __builtin_amdgcn_s_sleep(1);
        if ((++sp & 255u) == 0u) { if (xb_ld(&bar[XB_TMO])) break; if (sp > XB_SPIN_CAP) { atomicAdd(&bar[XB_TMO], 1u); break; } }
    }
    nloc = mine > 0u ? mine : 1u; nx = cnt > 0u ? cnt : 1u;
}
DI void xcd_barrier(const XcdBarrier& b) {
    asm volatile("s_waitcnt vmcnt(0)" ::: "memory");
    __syncthreads();
    if (threadIdx.x == 0) {
        unsigned* bar = b.bar;
        __builtin_amdgcn_s_waitcnt(0);
        unsigned bx = b.x; asm volatile("" : "+s"(bx));
        unsigned nloc = b.st[0], nx = b.st[1];
        if (nloc == 0u) { xcd_barrier_complete(bar, bx, nloc, nx); b.st[0] = nloc; b.st[1] = nx; }
        const unsigned old = xb_add(&bar[XB_XSUB(bx)], 1u);
        const unsigned gen = old / nloc;
        if (old + 1u == (gen + 1u) * nloc) {
            __builtin_amdgcn_fence(__ATOMIC_RELEASE, "agent");
            asm volatile("s_waitcnt vmcnt(0)" ::: "memory");
            const unsigned og = xb_add(&bar[XB_TOP], 1u);
            const unsigned tg = og / nx;
            if (og + 1u == (tg + 1u) * nx) xb_add(&bar[XB_TOPGEN], 1u);
            else XB_SPIN(xb_ld(&bar[XB_TOPGEN]) == tg, bar);
            __builtin_amdgcn_fence(__ATOMIC_ACQUIRE, "agent");
            xb_add(&bar[XB_XGEN(bx)], 1u);
            asm volatile("s_waitcnt vmcnt(0)" ::: "memory");
        } else {
            XB_SPIN(xb_ld(&bar[XB_XGEN(bx)]) == gen, bar);
            __builtin_amdgcn_fence(__ATOMIC_ACQUIRE, "agent");
            asm volatile("s_waitcnt vmcnt(0)" ::: "memory");
        }
    }
    __syncthreads();
}

#ifndef FP8_MMA
#define FP8_MMA 3
#endif
#ifndef EPI_TWICE
#define EPI_TWICE 0
#endif
namespace pg8 {
constexpr int BM = 256, BK = 64, HALF = 128, HTB = HALF * BK * 2, STAGE_BYTES = 8 * HTB, NXCD = 8, WGM = 8;
__host__ __device__ __forceinline__ int lds_byte(int r, int c) { const int st = (r >> 4) * 2 + (c >> 5), rr = r & 15, cc = c & 31, ob = rr * 64 + cc * 2; return st * 1024 + (ob ^ (((ob >> 9) & 1) << 5)); }
__host__ __device__ __forceinline__ void stage_rc(int b, int& R, int& C) { const int st = b / 1024, sb = b % 1024, swz = sb ^ (((sb >> 9) & 1) << 5); R = (st >> 1) * 16 + swz / 64; C = (st & 1) * 32 + (swz % 64) / 2; }
__host__ __device__ __forceinline__ int perm32(int rho) { const int n = rho >> 4, i = rho & 15; return 8 * (i >> 2) + 4 * n + (i & 3); }

struct Unit { int pm, pn, e; };
struct Gemm { const bf16_t* A; const bf16_t* Bt; const int* rowidx; };

template <int NN, int MSTRIDE, bool REV = false>
struct GroupedOrder {
    int nM, nwg, G, c;
    __device__ void init(int nM_, int ngroups, int G_, int c_) { nM = nM_; nwg = nM_ * NN * ngroups; G = G_; c = c_; }
    __device__ bool next(int i, Unit& u) const {
        const int L = i * G + c; if (L >= nwg) return false;
        int wgid = L; { const int q = nwg / NXCD, r = nwg % NXCD, xcd = wgid % NXCD; int off = wgid / NXCD; if (REV) off = (xcd < r ? q : q - 1) - off;
            wgid = (xcd < r ? xcd * (q + 1) : r * (q + 1) + (xcd - r) * q) + off; }
        const int per = nM * NN, e = wgid / per, rr = wgid % per;
        constexpr int nig = WGM * NN; const int gid = rr / nig, fm = gid * WGM, gsz = (nM - fm) < WGM ? (nM - fm) : WGM;
        u.pm = e * MSTRIDE + fm + ((rr % nig) % gsz); u.pn = (rr % nig) / gsz; u.e = e; return true;
    }
};

typedef int v8i_t __attribute__((ext_vector_type(8)));
typedef int v4i_t __attribute__((ext_vector_type(4)));
typedef long v2l_t __attribute__((ext_vector_type(2)));
DI const char* sptr(const char* p) {
    const unsigned long long v = (unsigned long long)p; const unsigned lo = (unsigned)__builtin_amdgcn_readfirstlane((int)(unsigned)v), hi = (unsigned)__builtin_amdgcn_readfirstlane((int)(unsigned)(v >> 32));
    return (const char*)(((unsigned long long)hi << 32) | lo); }
DI v8i_t ld32(const LAS unsigned char* p0, const LAS unsigned char* p1) {
    const v4i_t a = *(const LAS v4i_t*)p0, b = *(const LAS v4i_t*)p1; return __builtin_shufflevector(a, b, 0, 1, 2, 3, 4, 5, 6, 7); }
DI f32x4 mma_fp8(const v8i_t X, const v8i_t Y, f32x4 c, const int sc) {
#if FP8_MMA == 3
    asm volatile("v_mfma_scale_f32_16x16x128_f8f6f4 %0, %1, %2, %0, %3, %3 op_sel_hi:[0,0,0]" : "+v"(c) : "v"(X), "v"(Y), "v"(sc));
    return c;
#elif FP8_MMA == 2
    return __builtin_amdgcn_mfma_scale_f32_16x16x128_f8f6f4(X, Y, c, 0, 0, 0, 0x7F7F7F7F, 0, 0x7F7F7F7F);
#else
    const v4i_t xl = __builtin_shufflevector(X, X, 0, 1, 2, 3), xh = __builtin_shufflevector(X, X, 4, 5, 6, 7), yl = __builtin_shufflevector(Y, Y, 0, 1, 2, 3), yh = __builtin_shufflevector(Y, Y, 4, 5, 6, 7);
    const v2l_t x0 = __builtin_bit_cast(v2l_t, xl), x1 = __builtin_bit_cast(v2l_t, xh), y0 = __builtin_bit_cast(v2l_t, yl), y1 = __builtin_bit_cast(v2l_t, yh);
    c = __builtin_amdgcn_mfma_f32_16x16x32_fp8_fp8(x0[0], y0[0], c, 0, 0, 0); c = __builtin_amdgcn_mfma_f32_16x16x32_fp8_fp8(x0[1], y0[1], c, 0, 0, 0);
    c = __builtin_amdgcn_mfma_f32_16x16x32_fp8_fp8(x1[0], y1[0], c, 0, 0, 0); c = __builtin_amdgcn_mfma_f32_16x16x32_fp8_fp8(x1[1], y1[1], c, 0, 0, 0);
    return c;
#endif
}
DI unsigned cvt_pk_bf16(float lo, float hi) { unsigned r; asm volatile("v_cvt_pk_bf16_f32 %0, %1, %2" : "=v"(r) : "v"(lo), "v"(hi)); return r; }

template <class Epi, class Sched, bool GATHER, int K, size_t BSTRIDE, int STAG = 0, bool ALIGN = true, int ESZ = 2, bool ROTK = false, int ABL = 0>
DI void gemm_phase(LAS unsigned char* lds, const Gemm g, const Sched& S, const Epi& E) {
    if constexpr (STAG > 0) { const int ng = (int)((blockIdx.x * 5u) & 7u); for (int i = 0; i < ng; ++i) __builtin_amdgcn_s_sleep(STAG); }
    const int tid = tid_opaque(), wid = __builtin_amdgcn_readfirstlane(tid >> 6), lane = tid & 63, wr = wid >> 2, wc = wid & 3, fr = lane & 15, fq = lane >> 4;
    constexpr int RB = K * ESZ, nt = RB / 128;
    int fp8sc = 0x7F7F7F7F; asm volatile("" : "+v"(fp8sc));
    unsigned voffA[2], voffB[2];
#pragma unroll
    for (int i = 0; i < 2; ++i) { int R, C; stage_rc(tid * 16 + i * 8192, R, C); const int Rb = Epi::PERM ? ((R & ~31) + perm32(R & 31)) : R;
        voffA[i] = (unsigned)(R * RB + C * 2); voffB[i] = (unsigned)(Rb * RB + C * 2); }
    constexpr size_t kstep = (size_t)(BK * 2);
    constexpr size_t hstep = (size_t)HALF * RB;
    constexpr size_t tstep = 2 * hstep;
    const unsigned ldsw = (unsigned)wid * 1024u;
    const int aoff = lds_byte(wr * 64 + fr, fq * 8), boff = lds_byte(wc * 32 + fr, fq * 8);
#define PG8_SA(b, h) (((b) * 2 + (h)) * HTB)
#define PG8_SB(b, h) ((4 + (b) * 2 + (h)) * HTB)
#define PG8_STAGE(bufoff, gbase, voff) do { if constexpr (ABL & 1) break; const char* _gb = sptr((const char*)(gbase)); _Pragma("unroll") for (int _i = 0; _i < 2; ++_i) \
        __builtin_amdgcn_global_load_lds((const unsigned*)(_gb + (voff)[_i]), (LAS unsigned*)(lds + (bufoff) + ldsw + _i * 8192), 16, 0, 0); } while (0)
#define PG8_STAGE_AC(bufoff, kb, h) do { if constexpr (GATHER) PG8_STAGE(bufoff, Ab + (kb), cOff[h]); else PG8_STAGE(bufoff, cA + (h) * hstep + (kb), voffA); } while (0)
#define PG8_STAGE_AN(bufoff, kb, h) do { if constexpr (GATHER) { if (last) PG8_STAGE(bufoff, Ab + (kb), nOff[h]); else PG8_STAGE(bufoff, Ab + (kb), cOff[h]); } \
        else PG8_STAGE(bufoff, (last ? nA : cA) + (h) * hstep + (kb), voffA); } while (0)
#define PG8_LDA(dst, b, h) do { if constexpr ((ABL & 4) || (ABL & 32)) break; if constexpr (ESZ == 2) { _Pragma("unroll") for (int m = 0; m < 4; ++m) _Pragma("unroll") for (int k = 0; k < 2; ++k) dst[m][k] = *(const LAS bf16x8*)(lds + PG8_SA(b, h) + aoff + m * 2048 + k * 1024); } \
        else { _Pragma("unroll") for (int m = 0; m < 4; ++m) dst##8[m] = ld32(lds + PG8_SA(b, h) + aoff + m * 2048, lds + PG8_SA(b, h) + aoff + m * 2048 + 1024); } } while (0)
#define PG8_LDB(dst, b, h) do { if constexpr ((ABL & 4) || (ABL & 16)) break; if constexpr (ESZ == 2) { _Pragma("unroll") for (int n = 0; n < 2; ++n) _Pragma("unroll") for (int k = 0; k < 2; ++k) dst[n][k] = *(const LAS bf16x8*)(lds + PG8_SB(b, h) + boff + n * 2048 + k * 1024); } \
        else { _Pragma("unroll") for (int n = 0; n < 2; ++n) dst##8[n] = ld32(lds + PG8_SB(b, h) + boff + n * 2048, lds + PG8_SB(b, h) + boff + n * 2048 + 1024); } } while (0)
#define PG8_MMA(ai, bj, At, Bt) do { if constexpr (ABL & 2) break; if constexpr (!(ABL & 64)) __builtin_amdgcn_s_setprio(1); _Pragma("unroll") for (int m = 0; m < 4; ++m) _Pragma("unroll") for (int n = 0; n < 2; ++n) { \
        if constexpr (ESZ == 2) { _Pragma("unroll") for (int k = 0; k < 2; ++k) acc[ai][bj][m][n] = __builtin_amdgcn_mfma_f32_16x16x32_bf16(Bt[n][k], At[m][k], acc[ai][bj][m][n], 0, 0, 0); } \
        else acc[ai][bj][m][n] = mma_fp8(Bt##8[n], At##8[m], acc[ai][bj][m][n], fp8sc); } if constexpr (!(ABL & 64)) __builtin_amdgcn_s_setprio(0); } while (0)
#define PG8_WAIT_V(n) asm volatile("s_waitcnt vmcnt(" #n ")" ::: "memory")
#define PG8_WAIT_L(n) asm volatile("s_waitcnt lgkmcnt(" #n ")" ::: "memory")
#define PG8_BAR __builtin_amdgcn_s_barrier()
#define PG8_SCHED __builtin_amdgcn_sched_barrier(0)
#define PG8_AOFF(dst, u) do { int _t = threadIdx.x; asm volatile("" : "+v"(_t)); _Pragma("unroll") for (int _h = 0; _h < 2; ++_h) _Pragma("unroll") for (int _i = 0; _i < 2; ++_i) { int _R, _C; stage_rc(_t * 16 + _i * 8192, _R, _C); \
        const int _row = g.rowidx[(u).pm * BM + _h * HALF + _R]; dst[_h][_i] = (unsigned)_row * (unsigned)RB + (unsigned)_C * 2u; } } while (0)
    Unit cur, nxt; int ui = 0;
    if (!S.next(0, cur)) return;
#define PG8_KOFF(s_, i_) ((size_t)(ROTK ? (((s_) + (i_)) & (nt - 1)) : (i_)) * kstep)
    int rs_c = ROTK ? __builtin_amdgcn_readfirstlane((cur.pm + 2 * cur.pn) & 7) : 0, rs_n = 0; (void)rs_n;
    f32x4 acc[2][2][4][2];
#pragma unroll
    for (int a = 0; a < 2; ++a)
#pragma unroll
        for (int b = 0; b < 2; ++b)
#pragma unroll
            for (int m = 0; m < 4; ++m)
#pragma unroll
                for (int n = 0; n < 2; ++n) acc[a][b][m][n] = (f32x4){0.f, 0.f, 0.f, 0.f};
    bf16x8 At[4][2], B0[2][2], B1[2][2]; v8i_t At8[4], B08[2], B18[2]; (void)At; (void)B0; (void)B1; (void)At8; (void)B08; (void)B18;
    if constexpr (ABL & (4 | 16 | 32 | 128)) { for (int m = 0; m < 4; ++m) { At8[m] = (v8i_t){0, 0, 0, 0, 0, 0, 0, 0}; for (int k = 0; k < 2; ++k) At[m][k] = (bf16x8){0, 0, 0, 0, 0, 0, 0, 0}; } for (int n = 0; n < 2; ++n) { B08[n] = B18[n] = (v8i_t){0, 0, 0, 0, 0, 0, 0, 0}; for (int k = 0; k < 2; ++k) B0[n][k] = B1[n][k] = (bf16x8){0, 0, 0, 0, 0, 0, 0, 0}; } }
    unsigned cOff[2][2], nOff[2][2];
    const char* Ab = (const char*)g.A;
    const char* cA = Ab; const char* nA = Ab;
    if constexpr (GATHER) { PG8_AOFF(cOff, cur); } else { cA = Ab + (size_t)cur.pm * tstep; }
    const char* cB = (const char*)g.Bt + (size_t)cur.e * BSTRIDE + (size_t)cur.pn * tstep;
    { const size_t K0 = PG8_KOFF(rs_c, 0); PG8_STAGE(PG8_SB(0, 0), cB + K0, voffB); PG8_STAGE(PG8_SB(0, 1), cB + hstep + K0, voffB); PG8_STAGE_AC(PG8_SA(0, 0), K0, 0); PG8_STAGE_AC(PG8_SA(0, 1), K0, 1); }
    { const size_t K1 = PG8_KOFF(rs_c, 1); PG8_STAGE(PG8_SB(1, 0), cB + K1, voffB); PG8_STAGE_AC(PG8_SA(1, 0), K1, 0); PG8_STAGE(PG8_SB(1, 1), cB + hstep + K1, voffB); }
    if (wr == 1) PG8_BAR;
    PG8_WAIT_V(8); PG8_BAR;
    PG8_WAIT_V(6); PG8_BAR;
    for (;;) {
        const bool has_next = S.next(ui + 1, nxt);
        const char* nB = has_next ? (const char*)g.Bt + (size_t)nxt.e * BSTRIDE + (size_t)nxt.pn * tstep : cB;
        if constexpr (GATHER) {
            if (has_next) { PG8_AOFF(nOff, nxt); }
            else {
#pragma unroll
                for (int h = 0; h < 2; ++h)
#pragma unroll
                    for (int i = 0; i < 2; ++i) nOff[h][i] = cOff[h][i];
            }
        } else nA = has_next ? Ab + (size_t)nxt.pm * tstep : cA;
        if constexpr (ROTK) rs_n = has_next ? __builtin_amdgcn_readfirstlane((nxt.pm + 2 * nxt.pn) & 7) : rs_c;
#pragma unroll 1
        for (int t = 0; t < nt; t += 2) {
            const bool last = (t == nt - 2);
            const size_t k1 = PG8_KOFF(rs_c, t + 1), k2 = last ? PG8_KOFF(rs_n, 0) : PG8_KOFF(rs_c, t + 2), k3 = last ? PG8_KOFF(rs_n, 1) : PG8_KOFF(rs_c, t + 3);
            const char* b2 = (last ? nB : cB) + k2; const char* b3 = (last ? nB : cB) + k3;
            PG8_LDB(B0, 0, 0); if constexpr (!(ABL & 128)) PG8_LDB(B1, 0, 1); PG8_SCHED; PG8_LDA(At, 0, 0); PG8_STAGE_AC(PG8_SA(1, 1), k1, 1);
            PG8_WAIT_V(8); PG8_WAIT_L(0); PG8_BAR; PG8_MMA(0, 0, At, B0); PG8_MMA(0, 1, At, B1); PG8_BAR; PG8_SCHED;
            PG8_LDA(At, 0, 1); PG8_STAGE(PG8_SB(0, 0), b2, voffB); PG8_STAGE(PG8_SB(0, 1), b2 + hstep, voffB); PG8_STAGE_AN(PG8_SA(0, 0), k2, 0);
            PG8_WAIT_V(8); PG8_WAIT_L(0); PG8_BAR; PG8_MMA(1, 0, At, B0); PG8_MMA(1, 1, At, B1); PG8_BAR; PG8_SCHED;
            PG8_LDB(B0, 1, 0); if constexpr (!(ABL & 128)) PG8_LDB(B1, 1, 1); PG8_SCHED; PG8_LDA(At, 1, 0); PG8_STAGE_AN(PG8_SA(0, 1), k2, 1);
            PG8_WAIT_V(8); PG8_WAIT_L(0); PG8_BAR; PG8_MMA(0, 0, At, B0); PG8_MMA(0, 1, At, B1); PG8_BAR; PG8_SCHED;
            PG8_LDA(At, 1, 1); PG8_STAGE(PG8_SB(1, 0), b3, voffB); PG8_STAGE(PG8_SB(1, 1), b3 + hstep, voffB); PG8_STAGE_AN(PG8_SA(1, 0), k3, 0);
            PG8_WAIT_V(8); PG8_WAIT_L(0); PG8_BAR; PG8_MMA(1, 0, At, B0); PG8_MMA(1, 1, At, B1); PG8_BAR; PG8_SCHED;
        }
        if constexpr (ESZ == 1 && FP8_MMA == 3) asm volatile("s_nop 15\n\ts_nop 15\n\ts_nop 15" ::: "memory");
        if constexpr (ALIGN) { if (wr == 0) PG8_BAR; }
        if constexpr (!(ABL & 8)) E(acc, cur, wr, wc, fr, fq);
        if constexpr (GATHER) { if (EPI_TWICE) { asm volatile("" ::: "memory"); E(acc, cur, wr, wc, fr, fq); } }
        if (!has_next) break;
#pragma unroll
        for (int a = 0; a < 2; ++a)
#pragma unroll
            for (int b = 0; b < 2; ++b)
#pragma unroll
                for (int m = 0; m < 4; ++m)
#pragma unroll
                    for (int n = 0; n < 2; ++n) acc[a][b][m][n] = (f32x4){0.f, 0.f, 0.f, 0.f};
        cur = nxt; cB = nB; cA = nA; ++ui; if constexpr (ROTK) rs_c = rs_n;
        if constexpr (GATHER) {
#pragma unroll
            for (int h = 0; h < 2; ++h)
#pragma unroll
                for (int i = 0; i < 2; ++i) cOff[h][i] = nOff[h][i];
        }
        if constexpr (ALIGN) { if (wr == 1) PG8_BAR; }
    }
    PG8_WAIT_V(0);
    if constexpr (!ALIGN) { if (wr == 0) PG8_BAR; }
    PG8_BAR;
#undef PG8_SA
#undef PG8_SB
#undef PG8_STAGE
#undef PG8_STAGE_AC
#undef PG8_STAGE_AN
#undef PG8_LDA
#undef PG8_LDB
#undef PG8_MMA
#undef PG8_WAIT_V
#undef PG8_WAIT_L
#undef PG8_BAR
#undef PG8_SCHED
#undef PG8_AOFF
#undef PG8_KOFF
}
}

using pg8::Unit;
DI f32x2 gelu_tanh2(f32x2 x) {
    constexpr float K0 = -2.0f * 0.7978845608028654f * LOG2E, K1 = K0 * 0.044715f;
    const f32x2 t = x * ((x * x) * K1 + K0);
    f32x2 e; e.x = __builtin_amdgcn_exp2f(t.x); e.y = __builtin_amdgcn_exp2f(t.y);
    const f32x2 d = e + 1.0f;
    f32x2 rinv; rinv.x = __builtin_amdgcn_rcpf(d.x); rinv.y = __builtin_amdgcn_rcpf(d.y);
    return x * rinv;
}
DI f32x4 gelu_tanh4(f32x4 v) { const f32x2 a = gelu_tanh2((f32x2){v[0], v[1]}), b = gelu_tanh2((f32x2){v[2], v[3]}); return (f32x4){a.x, a.y, b.x, b.y}; }
DI f32x2 silu_mul2(f32x2 a, f32x2 b) {
    const f32x2 t = a * (-LOG2E);
    f32x2 e; e.x = __builtin_amdgcn_exp2f(t.x); e.y = __builtin_amdgcn_exp2f(t.y);
    const f32x2 d = e + 1.0f;
    f32x2 rinv; rinv.x = __builtin_amdgcn_rcpf(d.x); rinv.y = __builtin_amdgcn_rcpf(d.y);
    return (a * b) * rinv;
}
struct EpiGeluUV {
    static constexpr bool PERM = true;
    bf16_t* U; bf16_t* V; const float* bias; float* stats; LAS unsigned char* xl;
    DI void operator()(const f32x4 (&acc)[2][2][4][2], const Unit& u, int wr, int wc, int fr_in, int fq_in) const {
        int fr = fr_in, fq = fq_in; asm volatile("" : "+v"(fr), "+v"(fq));
        const int row0 = u.pm * 256 + wr * 64 + fr; const bool isV = u.pn >= 8;
        bf16_t* base = isV ? V : U; const int col0 = (u.pn & 7) * 256 + wc * 32 + 8 * fq, bcol0 = u.pn * 256 + wc * 32 + 8 * fq;
        f32x4 bv[2][2];
#pragma unroll
        for (int bj = 0; bj < 2; ++bj)
#pragma unroll
            for (int n = 0; n < 2; ++n) bv[bj][n] = *(const f32x4*)(bias + bcol0 + bj * 128 + 4 * n);
#pragma unroll
        for (int ai = 0; ai < 2; ++ai)
#pragma unroll
            for (int m = 0; m < 4; ++m) { const int row = row0 + ai * 128 + m * 16; bf16_t* rowp = base + (size_t)row * 2048 + col0; float s = 0.f, q = 0.f;
#pragma unroll
                for (int bj = 0; bj < 2; ++bj) { const f32x4 v0 = gelu_tanh4(acc[ai][bj][m][0] + bv[bj][0]), v1 = gelu_tanh4(acc[ai][bj][m][1] + bv[bj][1]);
                    s += ((v0[0] + v0[1]) + (v0[2] + v0[3])) + ((v1[0] + v1[1]) + (v1[2] + v1[3]));
                    q += ((v0[0] * v0[0] + v0[1] * v0[1]) + (v0[2] * v0[2] + v0[3] * v0[3])) + ((v1[0] * v1[0] + v1[1] * v1[1]) + (v1[2] * v1[2] + v1[3] * v1[3]));
                    u32x4 w; w.x = pg8::cvt_pk_bf16(v0[0], v0[1]); w.y = pg8::cvt_pk_bf16(v0[2], v0[3]); w.z = pg8::cvt_pk_bf16(v1[0], v1[1]); w.w = pg8::cvt_pk_bf16(v1[2], v1[3]);
                    *(u32x4*)(rowp + bj * 128) = w; }
                if (isV) { s = x32_sum(x16_sum(s)); q = x32_sum(x16_sum(q));
                    if (fq == 0) *(LAS f32x2*)(xl + ((ai * 128 + wr * 64 + m * 16 + fr) * 4 + wc) * 8) = (f32x2){s, q}; }
                asm volatile("" ::: "memory"); }
        if (isV) {
            asm volatile("s_waitcnt lgkmcnt(0)" ::: "memory"); __builtin_amdgcn_s_barrier(); asm volatile("" ::: "memory");
            const int t = (wr * 4 + wc) * 64 + fq * 16 + fr;
            if (t < 256) { const f32x4 a = *(const LAS f32x4*)(xl + t * 32), b = *(const LAS f32x4*)(xl + t * 32 + 16);
                *(f32x2*)(stats + ((size_t)(u.pm * 256 + t) * 8 + (u.pn - 8)) * 2) = (f32x2){(a[0] + a[2]) + (b[0] + b[2]), (a[1] + a[3]) + (b[1] + b[3])}; }
        }
    }
};
struct EpiResAdd {
    static constexpr bool PERM = true;
    const bf16_t* X; bf16_t* Xo; const float* gate; float asc;
    DI void operator()(const f32x4 (&acc)[2][2][4][2], const Unit& u, int wr, int wc, int fr_in, int fq_in) const {
        int fr = fr_in, fq = fq_in; asm volatile("" : "+v"(fr), "+v"(fq));
        const int b = u.pm < 256 ? (u.pm >> 4) : 16;
        const int row0 = u.pm * 256 + wr * 64 + fr, col0 = u.pn * 256 + wc * 32 + 8 * fq;
        f32x4 gv[2][2];
#pragma unroll
        for (int bj = 0; bj < 2; ++bj)
#pragma unroll
            for (int n = 0; n < 2; ++n) gv[bj][n] = *(const f32x4*)(gate + (size_t)b * 6144 + col0 + bj * 128 + 4 * n) * asc;
#pragma unroll
        for (int ai = 0; ai < 2; ++ai) {
            u32x4 xv[4][2];
#pragma unroll
            for (int m = 0; m < 4; ++m)
#pragma unroll
                for (int bj = 0; bj < 2; ++bj) xv[m][bj] = *(const u32x4*)(X + (size_t)(row0 + ai * 128 + m * 16) * D + col0 + bj * 128);
#pragma unroll
            for (int m = 0; m < 4; ++m)
#pragma unroll
                for (int bj = 0; bj < 2; ++bj) { const u32x4 w = xv[m][bj]; const f32x4 a0 = acc[ai][bj][m][0] * gv[bj][0], a1 = acc[ai][bj][m][1] * gv[bj][1];
                    u32x4 o; o.x = pk2(bflo(w.x) + a0[0], bfhi(w.x) + a0[1]); o.y = pk2(bflo(w.y) + a0[2], bfhi(w.y) + a0[3]); o.z = pk2(bflo(w.z) + a1[0], bfhi(w.z) + a1[1]); o.w = pk2(bflo(w.w) + a1[2], bfhi(w.w) + a1[3]);
                    *(u32x4*)(Xo + (size_t)(row0 + ai * 128 + m * 16) * D + col0 + bj * 128) = o; }
            asm volatile("" ::: "memory"); }
    }
};
struct EpiQKV {
    static constexpr bool PERM = true;
    bf16_t *Q, *Kb, *Vb; const float* cosT; const float* sinT;
    DI void operator()(const f32x4 (&acc)[2][2][4][2], const Unit& u, int wr, int wc, int fr_in, int fq_in) const {
        int fr = fr_in, fq = fq_in; asm volatile("" : "+v"(fr), "+v"(fq));
        const int row0 = u.pm * 256 + wr * 64 + fr; const bool lat = u.pm < 256;
        const int cin = wc * 32 + 8 * fq, kk0 = 16 * (wc & 1) + 4 * fq;
        bf16_t* base; int ld; float sc; bool rope;
        constexpr float ws_ = FP8_ATT ? 1.0f / WM_SCALE : 1.0f;
        if (u.pn < 4) { base = Q + u.pn * 256 + cin; ld = 1024; sc = QSCALE * ws_; rope = lat; }
        else if (u.pn == 4) { base = Kb + cin; ld = 256; sc = ws_; rope = lat; }
        else { base = Vb + cin; ld = 256; sc = ws_; rope = false; }
#pragma unroll
        for (int ai = 0; ai < 2; ++ai) {
            f32x4 cs[4], sn[4];
#pragma unroll
            for (int m = 0; m < 4; ++m) { cs[m] = (f32x4){1.f, 1.f, 1.f, 1.f}; sn[m] = (f32x4){0.f, 0.f, 0.f, 0.f};
                if (rope) { const int t = (row0 + ai * 128 + m * 16) & 4095; cs[m] = *(const f32x4*)(cosT + t * 32 + kk0); sn[m] = *(const f32x4*)(sinT + t * 32 + kk0); } }
#pragma unroll
            for (int m = 0; m < 4; ++m) { const int row = row0 + ai * 128 + m * 16; bf16_t* rowp = base + (size_t)row * ld;
#pragma unroll
                for (int bj = 0; bj < 2; ++bj) { const f32x4 x1 = acc[ai][bj][m][0], x2 = acc[ai][bj][m][1];
                    const f32x4 o1 = (x1 * cs[m] - x2 * sn[m]) * sc, o2 = (x1 * sn[m] + x2 * cs[m]) * sc;
                    u32x4 w; w.x = pg8::cvt_pk_bf16(o1[0], o1[1]); w.y = pg8::cvt_pk_bf16(o1[2], o1[3]); w.z = pg8::cvt_pk_bf16(o2[0], o2[1]); w.w = pg8::cvt_pk_bf16(o2[2], o2[3]);
                    *(u32x4*)(rowp + bj * 128) = w; } }
            asm volatile("" ::: "memory"); }
    }
};
struct EpiSwiGLU {
    static constexpr bool PERM = true; static constexpr int NST = 0;
    unsigned char* Hm;
    DI void operator()(const f32x4 (&acc)[2][2][4][2], const Unit& u, int wr, int wc, int fr_in, int fq_in) const {
        int fr = fr_in, fq = fq_in; asm volatile("" : "+v"(fr), "+v"(fq));
        const int row0 = u.pm * 256 + wr * 64 + fr, col0 = u.pn * 128 + wc * 32 + 8 * fq;
        constexpr float is = 1.0f / W13_SCALE;
#pragma unroll
        for (int ai = 0; ai < 2; ++ai)
#pragma unroll
            for (int m = 0; m < 4; ++m) { unsigned char* rowp = Hm + (size_t)(row0 + ai * 128 + m * 16) * 2048 + col0;
                const f32x4 a0 = acc[ai][0][m][0] * is, a1 = acc[ai][0][m][1] * is, b0 = acc[ai][1][m][0] * is, b1 = acc[ai][1][m][1] * is;
                const f32x2 h0 = silu_mul2((f32x2){a0[0], a0[1]}, (f32x2){b0[0], b0[1]}), h1 = silu_mul2((f32x2){a0[2], a0[3]}, (f32x2){b0[2], b0[3]});
                const f32x2 h2 = silu_mul2((f32x2){a1[0], a1[1]}, (f32x2){b1[0], b1[1]}), h3 = silu_mul2((f32x2){a1[2], a1[3]}, (f32x2){b1[2], b1[3]});
                u32x2 w; w.x = pk4_fp8(h0.x, h0.y, h1.x, h1.y); w.y = pk4_fp8(h2.x, h2.y, h3.x, h3.y);
                *(u32x2*)rowp = w; }
    }
};
struct EpiGateY {
    static constexpr bool PERM = true;
    unsigned char* Y; const float* gate;
    DI void operator()(const f32x4 (&acc)[2][2][4][2], const Unit& u, int wr, int wc, int fr_in, int fq_in) const {
        int fr = fr_in, fq = fq_in; asm volatile("" : "+v"(fr), "+v"(fq));
        const int row0 = u.pm * 256 + wr * 64 + fr, col0 = u.pn * 256 + wc * 32 + 8 * fq;
        float gts[2][4];
#pragma unroll
        for (int ai = 0; ai < 2; ++ai)
#pragma unroll
            for (int m = 0; m < 4; ++m) gts[ai][m] = gate[row0 + ai * 128 + m * 16] * (Y_SCALE / W2_SCALE);
#pragma unroll
        for (int ai = 0; ai < 2; ++ai)
#pragma unroll
            for (int m = 0; m < 4; ++m) { const int row = row0 + ai * 128 + m * 16; const float gt = gts[ai][m]; unsigned char* rowp = Y + (size_t)row * 1024 + col0;
#pragma unroll
                for (int bj = 0; bj < 2; ++bj) { const f32x4 v0 = acc[ai][bj][m][0] * gt, v1 = acc[ai][bj][m][1] * gt;
                    u32x2 w; w.x = pk4_fp8(v0[0], v0[1], v0[2], v0[3]); w.y = pk4_fp8(v1[0], v1[1], v1[2], v1[3]);
                    *(u32x2*)(rowp + bj * 128) = w; }
                asm volatile("" ::: "memory"); }
    }
};

DI void p0_mod(LAS unsigned char* lds, const float* c, const float* c_ctx, const float* w_mod, const float* b_mod, float* mod, int bid, int G) {
    LAS float* S = (LAS float*)lds;
    LAS float* P = (LAS float*)(lds + 17 * 1024 * 4);
    const int tid = tid_opaque(), wave = tid >> 6, lane = tid & 63;
    for (int i = tid; i < 17 * 1024; i += 512) { const int r = i >> 10, k = i & 1023; const float v = r < 16 ? c[r * 1024 + k] : c_ctx[k]; S[i] = v / (1.0f + __expf(-v)); }
    __syncthreads();
    for (int item = bid; item < 4 * 96; item += G) {
        const int l = item / 96, nb = item % 96;
        const float* w = w_mod + ((size_t)l * 1024 + wave * 128) * 6144 + nb * 64 + lane;
        float acc[17];
#pragma unroll
        for (int r = 0; r < 17; ++r) acc[r] = 0.f;
        for (int k4 = 0; k4 < 128; k4 += 4) {
            const float w0 = w[(size_t)(k4 + 0) * 6144], w1 = w[(size_t)(k4 + 1) * 6144], w2 = w[(size_t)(k4 + 2) * 6144], w3 = w[(size_t)(k4 + 3) * 6144];
#pragma unroll
            for (int r = 0; r < 17; ++r) { const f32x4 s = *(const LAS f32x4*)(S + r * 1024 + wave * 128 + k4); acc[r] += (s[0] * w0 + s[1] * w1) + (s[2] * w2 + s[3] * w3); }
        }
#pragma unroll
        for (int r = 0; r < 17; ++r) P[(wave * 17 + r) * 64 + lane] = acc[r];
        __syncthreads();
        for (int o = tid; o < 17 * 64; o += 512) { const int r = o >> 6, nn = o & 63; float s = 0.f;
#pragma unroll
            for (int w8 = 0; w8 < 8; ++w8) s += P[(w8 * 17 + r) * 64 + nn];
            mod[((size_t)l * 17 + r) * 6144 + nb * 64 + nn] = s + b_mod[l * 6144 + nb * 64 + nn]; }
        __syncthreads();
    }
}
DI int qk_phys(int d) { return 8 * ((d & 31) >> 2) + (d & 3) + 4 * (d >> 5); }
DI void cvt_item(const float* src, int ldsrc, int K, bf16_t* dst, int k0, int nsrc0, int ndst0, bool perm, LAS unsigned char* Lt, int lane, bool s8 = false) {
    const int kr = lane >> 4, nq = lane & 15;
    f32x4 v[16];
#pragma unroll
    for (int q = 0; q < 16; ++q) v[q] = *(const f32x4*)(src + (size_t)(k0 + 4 * q + kr) * ldsrc + nsrc0 + 4 * nq);
    int prow[4];
#pragma unroll
    for (int i = 0; i < 4; ++i) { const int n = 4 * nq + i; prow[i] = (perm ? qk_phys(n) : n) * 132; }
#pragma unroll
    for (int q = 0; q < 16; ++q) { const int k = 4 * q + kr; if (FP8D_SIM) { for (int i = 0; i < 4; ++i) v[q][i] = sim8(v[q][i] * 32.0f, s8) * (1.0f / 32.0f); } const unsigned w01 = pk2(v[q][0], v[q][1]), w23 = pk2(v[q][2], v[q][3]);
        *(LAS unsigned short*)(Lt + prow[0] + k * 2) = (unsigned short)(w01 & 0xffffu); *(LAS unsigned short*)(Lt + prow[1] + k * 2) = (unsigned short)(w01 >> 16);
        *(LAS unsigned short*)(Lt + prow[2] + k * 2) = (unsigned short)(w23 & 0xffffu); *(LAS unsigned short*)(Lt + prow[3] + k * 2) = (unsigned short)(w23 >> 16); }
    LDS_WAIT();
    const int c = lane & 7;
#pragma unroll
    for (int j = 0; j < 8; ++j) { const int n = (lane >> 3) + 8 * j; const LAS unsigned* s = (const LAS unsigned*)(Lt + n * 132 + 16 * c);
        u32x4 o; o.x = s[0]; o.y = s[1]; o.z = s[2]; o.w = s[3];
        *(u32x4*)(dst + (size_t)(ndst0 + n) * K + k0 + 8 * c) = o; }
    LDS_WAIT();
}
struct P0Args { const float *w_in, *w_out, *w_qkv, *w_o, *w1, *w3, *w2, *w_s; bf16_t *win_t, *wout_t, *wqkv_t, *wo_t, *w13_t, *w2_t, *ws_t; float* cosT; float* sinT; };
constexpr int EXP_ITEMS = 3 * 8192, STEAL_CHUNK = 16, STEAL_NCHUNKS = EXP_ITEMS / STEAL_CHUNK;
DI void cvt_item8(const float* src, int ldsrc, int K, unsigned char* dst, int k0, int nsrc0, int ndst0, float scale, LAS unsigned char* Lt, int lane, bool perm = false) {
    const int kr = lane >> 4, nq = lane & 15;
    f32x4 v[16];
#pragma unroll
    for (int q = 0; q < 16; ++q) v[q] = *(const f32x4*)(src + (size_t)(k0 + 4 * q + kr) * ldsrc + nsrc0 + 4 * nq);
#pragma unroll
    for (int q = 0; q < 16; ++q) { const int k = 4 * q + kr; const unsigned p = pk4_fp8(v[q][0] * scale, v[q][1] * scale, v[q][2] * scale, v[q][3] * scale);
        LAS unsigned char* b = Lt + (perm ? 8 * (nq & 7) + 4 * (nq >> 3) : 4 * nq) * 68 + k;
        b[0] = (unsigned char)(p & 0xffu); b[68] = (unsigned char)((p >> 8) & 0xffu); b[136] = (unsigned char)((p >> 16) & 0xffu); b[204] = (unsigned char)(p >> 24); }
    LDS_WAIT();
    const int c = lane & 3;
#pragma unroll
    for (int j = 0; j < 4; ++j) { const int n = (lane >> 2) + 16 * j; const LAS unsigned* sp = (const LAS unsigned*)(Lt + n * 68 + 16 * c);
        u32x4 o; o.x = sp[0]; o.y = sp[1]; o.z = sp[2]; o.w = sp[3];
        *(u32x4*)(dst + (size_t)(ndst0 + n) * K + k0 + 16 * c) = o; }
    LDS_WAIT();
}
DI void cvt_expert_item(const P0Args& a, int layer, int it, LAS unsigned char* Lt, int lane) {
    const int which = it >> 13, r = it & 8191, e = r >> 9, q = r & 511; const size_t le = (size_t)layer * 16 + e;
    if (which < 2) { const int kb = q >> 5, nb = q & 31; const int ndst = ((nb * 64) >> 7) * 256 + ((nb * 64) & 127) + which * 128;
        cvt_item8((which ? a.w3 : a.w1) + le * 1024 * 2048, 2048, 1024, (unsigned char*)a.w13_t + le * 4096 * 1024, kb * 64, nb * 64, ndst, W13_SCALE, Lt, lane); }
    else { const int kb = q >> 4, nb = q & 15; cvt_item8(a.w2 + le * 2048 * 1024, 1024, 2048, (unsigned char*)a.w2_t + le * 1024 * 2048, kb * 64, nb * 64, nb * 64, W2_SCALE, Lt, lane); }
}
DI void steal_convert(LAS unsigned char* lds, unsigned* q, const P0Args& a, int layer, int max_chunks) {
    const int tid = tid_opaque(), wave = __builtin_amdgcn_readfirstlane(tid >> 6), lane = tid & 63;
    LAS unsigned* slot = (LAS unsigned*)(lds + 8 * 8448); LAS unsigned char* Lt = lds + wave * 8448;
    for (int n = 0; n < max_chunks; ++n) {
        __syncthreads();
        if (tid == 0) *slot = __hip_atomic_fetch_add(q, 1u, __ATOMIC_RELAXED, __HIP_MEMORY_SCOPE_AGENT);
        __syncthreads();
        const unsigned idx = *slot;
        if (idx >= (unsigned)STEAL_NCHUNKS) break;
#pragma unroll 1
        for (int k = 0; k < 2; ++k) cvt_expert_item(a, layer, (int)idx * STEAL_CHUNK + wave * 2 + k, Lt, lane);
    }
    __syncthreads();
}
DI void p0_convert(LAS unsigned char* lds, const P0Args& a, int gw, int NGW, int lane, int wave) {
    LAS unsigned char* Lt = lds + wave * 8448;
    constexpr int I_IN = 2 * 16 * 64, I_OUT = 2 * 32 * 16, I_QKV = 2 * 16 * 24, I_O = 2 * 16 * 16;
    constexpr int NITEMS = I_IN + I_OUT + I_QKV + I_O;
    for (int it = gw; it < NITEMS; it += NGW) {
        int r = it;
        if (r < I_IN) { const int j = r / 1024, q = r % 1024, kb = q / 64, nb = q % 64;
            cvt_item(a.w_in + (size_t)j * 1024 * 4096, 4096, 1024, a.win_t + (size_t)j * 4096 * 1024, kb * 64, nb * 64, nb * 64, false, Lt, lane, (FP8D_SIM & 1) != 0); continue; } r -= I_IN;
        if (r < I_OUT) { const int j = r / 512, q = r % 512, kb = q / 16, nb = q % 16;
            cvt_item(a.w_out + (size_t)j * 2048 * 1024, 1024, 2048, a.wout_t + (size_t)j * 1024 * 2048, kb * 64, nb * 64, nb * 64, false, Lt, lane, (FP8D_SIM & 4) != 0); continue; } r -= I_OUT;
        if (r < I_QKV) { const int j = r / 384, q = r % 384, kb = q / 24, nb = q % 24;
            if (FP8_ATT) cvt_item8(a.w_qkv + (size_t)j * 1024 * 1536, 1536, 1024, (unsigned char*)a.wqkv_t + (size_t)j * 1536 * 1024, kb * 64, nb * 64, nb * 64, WM_SCALE, Lt, lane, nb < 20);
            else cvt_item(a.w_qkv + (size_t)j * 1024 * 1536, 1536, 1024, a.wqkv_t + (size_t)j * 1536 * 1024, kb * 64, nb * 64, nb * 64, nb < 20, Lt, lane, (FP8D_SIM & 2) != 0);
            continue; } r -= I_QKV;
        if (r < I_O) { const int j = r / 256, q = r % 256, kb = q / 16, nb = q % 16;
            if (FP8_ATT) cvt_item8(a.w_o + (size_t)j * 1024 * 1024, 1024, 1024, (unsigned char*)a.wo_t + (size_t)j * 1024 * 1024, kb * 64, nb * 64, nb * 64, WM_SCALE, Lt, lane);
            else cvt_item(a.w_o + (size_t)j * 1024 * 1024, 1024, 1024, a.wo_t + (size_t)j * 1024 * 1024, kb * 64, nb * 64, nb * 64, false, Lt, lane, (FP8D_SIM & 2) != 0);
            continue; } r -= I_O;
    }
    const int gt = gw * 64 + lane, NT = NGW * 64;
    for (int i = gt; i < 2 * 16 * 128 * 128 / 8; i += NT) { const f32x4 x = *(const f32x4*)(a.w_s + (size_t)i * 8), y = *(const f32x4*)(a.w_s + (size_t)i * 8 + 4);
        u32x4 o; o.x = pk2(x[0], x[1]); o.y = pk2(x[2], x[3]); o.z = pk2(y[0], y[1]); o.w = pk2(y[2], y[3]); *(u32x4*)(a.ws_t + (size_t)i * 8) = o; }
    for (int i = gt; i < 4096 * 32; i += NT) { const int t = i >> 5, kk = i & 31; const int pos = kk < 16 ? (t >> 6) : (t & 63); const int j = kk & 15;
        const float inv = exp2f(-(float)j * (13.287712379549449f / 16.0f)); const float ang = (float)pos * inv; a.cosT[i] = cosf(ang); a.sinT[i] = sinf(ang); }
}

DI void unpack8(const u32x4 w, float (&v)[8]) { v[0] = bflo(w.x); v[1] = bfhi(w.x); v[2] = bflo(w.y); v[3] = bfhi(w.y); v[4] = bflo(w.z); v[5] = bfhi(w.z); v[6] = bflo(w.w); v[7] = bfhi(w.w); }
DI void unpack8_fp8(const u32x2 w, float (&v)[8]) { const f32x2 a = __builtin_amdgcn_cvt_pk_f32_fp8((int)w.x, false), b = __builtin_amdgcn_cvt_pk_f32_fp8((int)w.x, true), c = __builtin_amdgcn_cvt_pk_f32_fp8((int)w.y, false), d = __builtin_amdgcn_cvt_pk_f32_fp8((int)w.y, true);
    v[0] = a.x; v[1] = a.y; v[2] = b.x; v[3] = b.y; v[4] = c.x; v[5] = c.y; v[6] = d.x; v[7] = d.y; }
DI u32x4 pack8f(const float (&v)[8]) { u32x4 o; o.x = pk2(v[0], v[1]); o.y = pk2(v[2], v[3]); o.z = pk2(v[4], v[5]); o.w = pk2(v[6], v[7]); return o; }
DI void load8f(const float* p, float (&v)[8]) { const f32x4 a = *(const f32x4*)p, b = *(const f32x4*)(p + 4); v[0] = a[0]; v[1] = a[1]; v[2] = a[2]; v[3] = a[3]; v[4] = b[0]; v[5] = b[1]; v[6] = b[2]; v[7] = b[3]; }
DI void n0_phase(const float* xin, const float* cin, bf16_t* X, const float* mod_cur, const float* gmix, bf16_t* H, int gw, int NGW, int lane) {
    const int rpw = (MT + NGW - 1) / NGW; const int m0 = gw * rpw; const int m1 = (m0 + rpw) < MT ? (m0 + rpw) : MT;
    int bcur = -1; float av[2][8], shv[2][8];
#pragma unroll
    for (int j = 0; j < 2; ++j)
#pragma unroll
        for (int k = 0; k < 8; ++k) { av[j][k] = 0.f; shv[j][k] = 0.f; }
    f32x4 p0[4], p1[4];
#define N0_LOAD(dst, mm) do { const int _m = (mm); if (_m < m1) { const float* _s = (_m < ML ? xin + (size_t)_m * D : cin + (size_t)(_m - ML) * D) + 8 * lane; \
        dst[0] = *(const f32x4*)_s; dst[1] = *(const f32x4*)(_s + 4); dst[2] = *(const f32x4*)(_s + 512); dst[3] = *(const f32x4*)(_s + 516); } } while (0)
    N0_LOAD(p0, m0); N0_LOAD(p1, m0 + 1);
    for (int m = m0; m < m1; ++m) {
        const int b = m < ML ? (m >> 12) : 16;
        float v[2][8];
#pragma unroll
        for (int j = 0; j < 2; ++j)
#pragma unroll
            for (int k = 0; k < 4; ++k) { v[j][k] = p0[2 * j][k]; v[j][4 + k] = p0[2 * j + 1][k]; }
#pragma unroll
        for (int i = 0; i < 4; ++i) p0[i] = p1[i];
        N0_LOAD(p1, m + 2);
        if (b != bcur) { bcur = b;
#pragma unroll
            for (int j = 0; j < 2; ++j) { const int c = 8 * lane + 512 * j; float g8[8], s8[8]; load8f(gmix + c, g8); load8f(mod_cur + (size_t)b * 6144 + 1024 + c, s8); load8f(mod_cur + (size_t)b * 6144 + c, shv[j]);
#pragma unroll
                for (int k = 0; k < 8; ++k) av[j][k] = g8[k] * (s8[k] + 1.0f); } }
        float ss = 0.f;
#pragma unroll
        for (int j = 0; j < 2; ++j)
#pragma unroll
            for (int k = 0; k < 8; ++k) ss += v[j][k] * v[j][k];
        const float rstd = __builtin_amdgcn_rsqf(wave_sum(ss) * (1.0f / D) + EPS);
#pragma unroll
        for (int j = 0; j < 2; ++j) { const int c = 8 * lane + 512 * j; *(u32x4*)(X + (size_t)m * D + c) = pack8f(v[j]); float h[8];
#pragma unroll
            for (int k = 0; k < 8; ++k) h[k] = sim8(v[j][k] * rstd * av[j][k] + shv[j][k], (FP8D_SIM & 1) != 0);
            *(u32x4*)(H + (size_t)m * D + c) = pack8f(h); }
    }
#undef N0_LOAD
}
DI void n1_phase(int mode, int nrows, const bf16_t* X, bf16_t* Xo, float* out, const unsigned char* Y  , const int* tokslot, const float* mod_prev, const float* mod_cur, const float* gmix, bf16_t* H, int gw, int NGW, int lane, bool s8 = false, bool h8 = false) {
    const int rpw = (nrows + NGW - 1) / NGW; const int m0 = gw * rpw; const int m1 = (m0 + rpw) < nrows ? (m0 + rpw) : nrows;
    if (m0 >= m1) return;
    u32x4 xq[3][2]; int sq[3] = {-1, -1, -1};
#define N1_LOAD(qi, mm) do { const int _m = (mm); if (_m < m1) { xq[qi][0] = *(const u32x4*)(X + (size_t)_m * D + 8 * lane); xq[qi][1] = *(const u32x4*)(X + (size_t)_m * D + 8 * lane + 512); \
        sq[qi] = lane < 16 ? tokslot[(size_t)lane * MT + _m] : -1; } } while (0)
    N1_LOAD(0, m0); N1_LOAD(1, m0 + 1); N1_LOAD(2, m0 + 2);
    int bcur = -1; float g2v[2][8], av[2][8], shv[2][8];
#pragma unroll
    for (int j = 0; j < 2; ++j)
#pragma unroll
        for (int k = 0; k < 8; ++k) { g2v[j][k] = 0.f; av[j][k] = 0.f; shv[j][k] = 0.f; }
    int slotn = sq[0]; unsigned maskn = (unsigned)__builtin_amdgcn_ballot_w64(slotn >= 0) & 0xffffu; int sbn[4]; u32x2 yrn[4][2];
#define N1_GATHER() do { _Pragma("unroll") for (int i = 0; i < 4; ++i) { sbn[i] = -1; if (maskn) { const int e = __builtin_ctz(maskn); sbn[i] = __builtin_amdgcn_readlane(slotn, e); maskn &= maskn - 1u; } \
            const unsigned char* yp = Y + (size_t)(sbn[i] >= 0 ? sbn[i] : 0) * D + 8 * lane; yrn[i][0] = *(const u32x2*)yp; yrn[i][1] = *(const u32x2*)(yp + 512); } } while (0)
    N1_GATHER();
    for (int m = m0; m < m1; ++m) {
        float v[2][8];
        unpack8(xq[0][0], v[0]); unpack8(xq[0][1], v[1]);
        xq[0][0] = xq[1][0]; xq[0][1] = xq[1][1]; xq[1][0] = xq[2][0]; xq[1][1] = xq[2][1];
        const int slot = slotn; sq[0] = sq[1]; sq[1] = sq[2];
        const int b = m < ML ? (m >> 12) : 16;
        unsigned mask = maskn;
        int sb[4]; u32x2 yr[4][2];
#pragma unroll
        for (int i = 0; i < 4; ++i) { sb[i] = sbn[i]; yr[i][0] = yrn[i][0]; yr[i][1] = yrn[i][1]; }
        slotn = (m + 1 < m1) ? sq[0] : -1; maskn = (unsigned)__builtin_amdgcn_ballot_w64(slotn >= 0) & 0xffffu;
        N1_GATHER();
        N1_LOAD(2, m + 3);
        if (b != bcur) { bcur = b;
#pragma unroll
            for (int j = 0; j < 2; ++j) { const int c = 8 * lane + 512 * j; load8f(mod_prev + (size_t)b * 6144 + 5120 + c, g2v[j]);
#pragma unroll
                for (int k = 0; k < 8; ++k) g2v[j][k] *= (1.0f / Y_SCALE);
                if (mode == 1) { float g8[8], s8[8]; load8f(gmix + c, g8); load8f(mod_cur + (size_t)b * 6144 + 1024 + c, s8); load8f(mod_cur + (size_t)b * 6144 + c, shv[j]);
#pragma unroll
                    for (int k = 0; k < 8; ++k) av[j][k] = g8[k] * (s8[k] + 1.0f); }
                else load8f(gmix + c, av[j]); } }
        float a[2][8];
#pragma unroll
        for (int j = 0; j < 2; ++j)
#pragma unroll
            for (int k = 0; k < 8; ++k) a[j][k] = 0.f;
#pragma unroll
        for (int i = 0; i < 4; ++i) if (sb[i] >= 0) {
#pragma unroll
            for (int j = 0; j < 2; ++j) { float y[8]; unpack8_fp8(yr[i][j], y);
#pragma unroll
                for (int k = 0; k < 8; ++k) a[j][k] += y[k]; } }
        while (mask) { const int e = __builtin_ctz(mask); const int s1 = __builtin_amdgcn_readlane(slot, e); mask &= mask - 1u; const unsigned char* yp = Y + (size_t)s1 * D + 8 * lane;
#pragma unroll
            for (int j = 0; j < 2; ++j) { float y[8]; unpack8_fp8(*(const u32x2*)(yp + 512 * j), y);
#pragma unroll
                for (int k = 0; k < 8; ++k) a[j][k] += y[k]; } }
        float ss = 0.f;
#pragma unroll
        for (int j = 0; j < 2; ++j)
#pragma unroll
            for (int k = 0; k < 8; ++k) { v[j][k] += g2v[j][k] * a[j][k]; ss += v[j][k] * v[j][k]; }
        const float rstd = __builtin_amdgcn_rsqf(wave_sum(ss) * (1.0f / D) + EPS);
        if (mode == 2) {
#pragma unroll
            for (int j = 0; j < 2; ++j) { float* op = out + (size_t)m * D + 8 * lane + 512 * j;
                *(f32x4*)op = (f32x4){v[j][0] * rstd * av[j][0], v[j][1] * rstd * av[j][1], v[j][2] * rstd * av[j][2], v[j][3] * rstd * av[j][3]};
                *(f32x4*)(op + 4) = (f32x4){v[j][4] * rstd * av[j][4], v[j][5] * rstd * av[j][5], v[j][6] * rstd * av[j][6], v[j][7] * rstd * av[j][7]}; }
        } else {
#pragma unroll
            for (int j = 0; j < 2; ++j) { const int c = 8 * lane + 512 * j; *(u32x4*)(Xo + (size_t)m * D + c) = pack8f(v[j]); float h[8];
#pragma unroll
                for (int k = 0; k < 8; ++k) h[k] = sim8(v[j][k] * rstd * av[j][k] + shv[j][k], s8);
                if (h8) { u32x2 w8; w8.x = pk4_fp8(h[0], h[1], h[2], h[3]); w8.y = pk4_fp8(h[4], h[5], h[6], h[7]); *(u32x2*)((unsigned char*)H + (size_t)m * D + c) = w8; }
                else *(u32x4*)(H + (size_t)m * D + c) = pack8f(h); }
        }
    }
#undef N1_LOAD
#undef N1_GATHER
}

DI void n2_phase(LAS unsigned char* lds, int nrows, const bf16_t* X, const float* mod_cur, const float* gffn, const float* w_r, bf16_t* H, float* aff, int bid, int G) {
    LAS unsigned char* Whi = lds; LAS unsigned char* Wlo = lds + 32768;
    LAS float* AV = (LAS float*)(lds + 65536); LAS float* SH = AV + 1024; LAS float* BIAS = SH + 1024;
    LAS float* DP0 = BIAS + 16; LAS float* SSP0 = DP0 + 2 * 8 * 256;
    const int tid = tid_opaque(), w = __builtin_amdgcn_readfirstlane(tid >> 6), lane = tid & 63, r = lane & 15, q = lane >> 4;
    const int ngroups = nrows >> 4, gpw = (ngroups + G - 1) / G; const int g0 = bid * gpw; const int g1 = (g0 + gpw) < ngroups ? (g0 + gpw) : ngroups;
    int bcur = -1;
    u32x4 xa[4], xn[4], xn2[4];
#define N2_LOAD(dst, gg) do { const size_t _row = (size_t)(gg) * 16 + r; _Pragma("unroll") for (int i = 0; i < 4; ++i) dst[i] = *(const u32x4*)(X + _row * D + 128 * w + 32 * i + 8 * q); } while (0)
    if (g0 < g1) N2_LOAD(xn, g0);
    if (g0 + 1 < g1) N2_LOAD(xn2, g0 + 1);
    for (int g = g0; g < g1; ++g) {
        const int row0 = g * 16; const int b = row0 < ML ? (row0 >> 12) : 16;
        if (b != bcur) {
            bcur = b; __syncthreads();
            for (int c = tid; c < 1024; c += 512) { AV[c] = gffn[c] * (mod_cur[(size_t)b * 6144 + 4096 + c] + 1.0f); SH[c] = mod_cur[(size_t)b * 6144 + 3072 + c]; }
            __syncthreads();
            float sb = 0.f;
            for (int i = tid; i < 16384; i += 512) { const int c = i >> 4, e = i & 15; const float wv = w_r[i]; const float v = AV[c] * wv; sb += SH[c] * wv; const unsigned hi = pk2(v, 0.f) & 0xffffu; const float lo = v - __uint_as_float(hi << 16);
                const int off = (((c >> 5) * 16 + e) * 4 + ((c >> 3) & 3)) * 16 + (c & 7) * 2;
                *(LAS unsigned short*)(Whi + off) = (unsigned short)hi; *(LAS unsigned short*)(Wlo + off) = (unsigned short)(pk2(lo, 0.f) & 0xffffu); }
            sb = x32_sum(x16_sum(sb));
            if (q == 0) DP0[w * 16 + r] = sb;
            __syncthreads();
            if (tid < 16) { float t = 0.f;
#pragma unroll
                for (int ww = 0; ww < 8; ++ww) t += DP0[ww * 16 + tid];
                BIAS[tid] = t; }
            __syncthreads();
        }
#pragma unroll
        for (int i = 0; i < 4; ++i) { xa[i] = xn[i]; xn[i] = xn2[i]; }
        if (g + 2 < g1) N2_LOAD(xn2, g + 2);
        f32x4 acc = (f32x4){0.f, 0.f, 0.f, 0.f}; float ss = 0.f;
#pragma unroll
        for (int i = 0; i < 4; ++i) { const int ks = 4 * w + i;
            const bf16x8 wh = *(const LAS bf16x8*)(Whi + ((ks * 16 + r) * 4 + q) * 16), wl = *(const LAS bf16x8*)(Wlo + ((ks * 16 + r) * 4 + q) * 16);
            const bf16x8 a = __builtin_bit_cast(bf16x8, xa[i]);
            acc = __builtin_amdgcn_mfma_f32_16x16x32_bf16(a, wh, acc, 0, 0, 0); acc = __builtin_amdgcn_mfma_f32_16x16x32_bf16(a, wl, acc, 0, 0, 0);
            float v[8]; unpack8(xa[i], v);
#pragma unroll
            for (int k = 0; k < 8; ++k) ss += v[k] * v[k]; }
        ss = x32_sum(x16_sum(ss));
        LAS float* DP = DP0 + (g & 1) * (8 * 256); LAS float* SSP = SSP0 + (g & 1) * (8 * 16);
        if (q == 0) SSP[w * 16 + r] = ss;
#pragma unroll
        for (int k = 0; k < 4; ++k) DP[(w * 16 + 4 * q + k) * 16 + r] = acc[k];
        __syncthreads();
        float rs;
        { float s2 = 0.f;
#pragma unroll
          for (int ww = 0; ww < 8; ++ww) s2 += SSP[ww * 16 + r];
          rs = __builtin_amdgcn_rsqf(s2 * (1.0f / D) + EPS); }
        if (tid < 256) { const int row = tid >> 4, e = tid & 15; float d = 0.f;
#pragma unroll
            for (int ww = 0; ww < 8; ++ww) d += DP[(ww * 16 + row) * 16 + e];
            const float rrow = __shfl(rs, (lane & 48) | row);
            const float t = rrow * d + BIAS[e];
            float mx = t;
            mx = row16_max(mx);
            const float ex = __expf(t - mx); float sm = ex;
            sm = row16_sum(sm);
            aff[(size_t)(row0 + row) * 16 + e] = ex * __builtin_amdgcn_rcpf(sm); }
        {
#pragma unroll
          for (int i = 0; i < 4; ++i) { const int c = 128 * w + 32 * i + 8 * q; float v[8]; unpack8(xa[i], v);
              const f32x4 a0 = *(const LAS f32x4*)(AV + c), a1 = *(const LAS f32x4*)(AV + c + 4), s0 = *(const LAS f32x4*)(SH + c), s1 = *(const LAS f32x4*)(SH + c + 4);
              float h[8]; h[0] = v[0] * rs * a0[0] + s0[0]; h[1] = v[1] * rs * a0[1] + s0[1]; h[2] = v[2] * rs * a0[2] + s0[2]; h[3] = v[3] * rs * a0[3] + s0[3];
              h[4] = v[4] * rs * a1[0] + s1[0]; h[5] = v[5] * rs * a1[1] + s1[1]; h[6] = v[6] * rs * a1[2] + s1[2]; h[7] = v[7] * rs * a1[3] + s1[3];
              u32x2 w8; w8.x = pk4_fp8(h[0], h[1], h[2], h[3]); w8.y = pk4_fp8(h[4], h[5], h[6], h[7]);
              *(u32x2*)((unsigned char*)H + (size_t)(row0 + r) * D + c) = w8; } }
    }
#undef N2_LOAD
    __syncthreads();
}

DI void tk_problem(LAS unsigned char* lds, const float* aff, int rowbase, int n, int cap, int e, int slotbase, int* rowidx, float* gate, int* tokslot_e) {
    LAS int* cntA = (LAS int*)lds;
    LAS int* scanA = (LAS int*)(lds + 64);
    LAS int* scanB = (LAS int*)(lds + 128);
    LAS int* totG = (LAS int*)(lds + 192);
    const int tid = tid_opaque(), wave = tid >> 6, lane = tid & 63;
    unsigned key[8];
#pragma unroll
    for (int j = 0; j < 8; ++j) { const int t = tid * 8 + j; key[j] = t < n ? __float_as_uint(aff[(size_t)(rowbase + t) * 16 + e]) : 0u; }
    unsigned prefix = 0u; int it = 0;
    for (int bit = 30; bit >= 0; --bit, ++it) {
        const unsigned cand = prefix | (1u << bit);
        int c = 0;
#pragma unroll
        for (int j = 0; j < 8; ++j) c += key[j] >= cand ? 1 : 0;
        c = wave_sum_i(c);
        if (lane == 0) cntA[(it & 1) * 8 + wave] = c;
        __syncthreads();
        int tot = 0;
#pragma unroll
        for (int w = 0; w < 8; ++w) tot += cntA[(it & 1) * 8 + w];
        if (tot >= cap) prefix = cand;
    }
    int ng = 0, neq = 0;
#pragma unroll
    for (int j = 0; j < 8; ++j) { ng += key[j] > prefix ? 1 : 0; neq += key[j] == prefix ? 1 : 0; }
    int incl = neq;
#pragma unroll
    for (int o = 1; o < 64; o <<= 1) { const int y = __shfl_up(incl, o); if (lane >= o) incl += y; }
    const int wg = wave_sum_i(ng);
    if (lane == 63) scanA[wave] = incl;
    if (lane == 0) totG[wave] = wg;
    __syncthreads();
    int eqbase = incl - neq, G = 0;
#pragma unroll
    for (int w = 0; w < 8; ++w) { if (w < wave) eqbase += scanA[w]; G += totG[w]; }
    const int need = cap - G;
    bool sel[8]; int nsel = 0, er = eqbase;
#pragma unroll
    for (int j = 0; j < 8; ++j) { const bool isg = key[j] > prefix, ise = key[j] == prefix; sel[j] = isg || (ise && er < need); er += ise ? 1 : 0; nsel += sel[j] ? 1 : 0; }
    int incl2 = nsel;
#pragma unroll
    for (int o = 1; o < 64; o <<= 1) { const int y = __shfl_up(incl2, o); if (lane >= o) incl2 += y; }
    if (lane == 63) scanB[wave] = incl2;
    __syncthreads();
    int pos = incl2 - nsel;
#pragma unroll
    for (int w = 0; w < 8; ++w) if (w < wave) pos += scanB[w];
#pragma unroll
    for (int j = 0; j < 8; ++j) { const int t = tid * 8 + j;
        if (t < n) { if (sel[j]) { const int s = slotbase + pos; rowidx[s] = rowbase + t; gate[s] = __uint_as_float(key[j]); tokslot_e[rowbase + t] = s; ++pos; } else tokslot_e[rowbase + t] = -1; } }
    __syncthreads();
}

DI void tk_pair(LAS unsigned char* lds, const float* aff, int e, int rowbaseL, int slotbaseL, bool ctx, int rowbaseC, int slotbaseC, int* rowidx, float* gate, int* tokslot_e) {
    LAS int* cnt = (LAS int*)lds;
    LAS int* scanA = (LAS int*)(lds + 512);
    LAS int* scanB = (LAS int*)(lds + 640);
    LAS int* totG = (LAS int*)(lds + 768);
    const int tid = tid_opaque(), wave = __builtin_amdgcn_readfirstlane(tid >> 6), lane = tid & 63;
    unsigned key[8];
#pragma unroll
    for (int j = 0; j < 8; ++j) key[j] = __float_as_uint(aff[(size_t)(rowbaseL + tid * 8 + j) * 16 + e]);
    const bool hasc = ctx && tid < 256;
    const unsigned keyc = hasc ? __float_as_uint(aff[(size_t)(rowbaseC + tid) * 16 + e]) : 0u;
    unsigned pL = 0u, pC = 0u; int it = 0;
    for (int bit = 28; bit >= 0; bit -= 2, ++it) {
        LAS int* cb = cnt + (it & 1) * 48;
#pragma unroll
        for (int k = 0; k < 3; ++k) { const unsigned cL = pL | ((unsigned)(3 - k) << bit), cC = pC | ((unsigned)(3 - k) << bit);
            int n = 0;
#pragma unroll
            for (int j = 0; j < 8; ++j) n += __builtin_popcountll(__builtin_amdgcn_ballot_w64(key[j] >= cL));
            const int m = __builtin_popcountll(__builtin_amdgcn_ballot_w64(keyc >= cC));
            if (lane == 0) { cb[k * 8 + wave] = n; cb[24 + k * 8 + wave] = m; } }
        __syncthreads();
        int tL[3], tC[3];
#pragma unroll
        for (int k = 0; k < 3; ++k) { const pg8::v4i_t a = *(const LAS pg8::v4i_t*)(cb + k * 8), b = *(const LAS pg8::v4i_t*)(cb + k * 8 + 4), c = *(const LAS pg8::v4i_t*)(cb + 24 + k * 8), d = *(const LAS pg8::v4i_t*)(cb + 24 + k * 8 + 4);
            tL[k] = a[0] + a[1] + a[2] + a[3] + b[0] + b[1] + b[2] + b[3]; tC[k] = c[0] + c[1] + c[2] + c[3] + d[0] + d[1] + d[2] + d[3]; }
        const unsigned dL = tL[0] >= CAPL ? 3u : (tL[1] >= CAPL ? 2u : (tL[2] >= CAPL ? 1u : 0u)), dC = tC[0] >= CAPC ? 3u : (tC[1] >= CAPC ? 2u : (tC[2] >= CAPC ? 1u : 0u));
        pL |= dL << bit; pC |= dC << bit;
    }
    int ngL = 0, neqL = 0;
#pragma unroll
    for (int j = 0; j < 8; ++j) { ngL += key[j] > pL ? 1 : 0; neqL += key[j] == pL ? 1 : 0; }
    const int ngC = (hasc && keyc > pC) ? 1 : 0, neqC = (hasc && keyc == pC) ? 1 : 0;
    int inL = neqL, inC = neqC;
#pragma unroll
    for (int o = 1; o < 64; o <<= 1) { const int y = __shfl_up(inL, o), z = __shfl_up(inC, o); if (lane >= o) { inL += y; inC += z; } }
    const int wgL = wave_sum_i(ngL), wgC = wave_sum_i(ngC);
    if (lane == 63) { scanA[wave] = inL; scanA[8 + wave] = inC; }
    if (lane == 0) { totG[wave] = wgL; totG[8 + wave] = wgC; }
    __syncthreads();
    int ebL = inL - neqL, ebC = inC - neqC, GL = 0, GC = 0;
#pragma unroll
    for (int w = 0; w < 8; ++w) { if (w < wave) { ebL += scanA[w]; ebC += scanA[8 + w]; } GL += totG[w]; GC += totG[8 + w]; }
    const int needL = CAPL - GL, needC = CAPC - GC;
    bool sel[8]; int nsel = 0, er = ebL;
#pragma unroll
    for (int j = 0; j < 8; ++j) { const bool isg = key[j] > pL, ise = key[j] == pL; sel[j] = isg || (ise && er < needL); er += ise ? 1 : 0; nsel += sel[j] ? 1 : 0; }
    const bool selC = hasc && (keyc > pC || (keyc == pC && ebC < needC));
    int i2L = nsel, i2C = selC ? 1 : 0;
#pragma unroll
    for (int o = 1; o < 64; o <<= 1) { const int y = __shfl_up(i2L, o), z = __shfl_up(i2C, o); if (lane >= o) { i2L += y; i2C += z; } }
    if (lane == 63) { scanB[wave] = i2L; scanB[8 + wave] = i2C; }
    __syncthreads();
    int posL = i2L - nsel, posC = i2C - (selC ? 1 : 0);
#pragma unroll
    for (int w = 0; w < 8; ++w) if (w < wave) { posL += scanB[w]; posC += scanB[8 + w]; }
#pragma unroll
    for (int j = 0; j < 8; ++j) { const int t = rowbaseL + tid * 8 + j;
        if (sel[j]) { const int sl = slotbaseL + posL; rowidx[sl] = t; gate[sl] = __uint_as_float(key[j]); tokslot_e[t] = sl; ++posL; } else tokslot_e[t] = -1; }
    if (hasc) { const int t = rowbaseC + tid;
        if (selC) { const int sl = slotbaseC + posC; rowidx[sl] = t; gate[sl] = __uint_as_float(keyc); tokslot_e[t] = sl; } else tokslot_e[t] = -1; }
    __syncthreads();
}

DI int sm_chunk_of(int t) {
    if (t < 32) { const int x = t >> 2, w = t & 3; return 68 * x + 64 + w; }
    const int u = t - 32, j = 3 - (u >> 7), v = u & 127, x = v >> 4, w = v & 15; return 68 * x + 16 * j + w;
}
DI s16x4 tr16(const LAS unsigned char* p) { return __builtin_bit_cast(s16x4, __builtin_amdgcn_ds_read_tr16_b64_v4i16((LAS v4i16_t*)p)); }
DI void sm_phase(LAS unsigned char* lds, const bf16_t* U, bf16_t* Uo, const bf16_t* V, const float* stats, const bf16_t* ws_t  , const float* ws_f  , const float* b_s  ,
                 const float* ln_g, const float* ln_b, int bid, int G) {
    constexpr int PITCH = 272;
    constexpr int NUNITS = (MT / 128) * 16;
    LAS unsigned char* Aimg = lds; LAS unsigned char* Bimg = lds + 128 * PITCH; LAS float* RS = (LAS float*)(lds + 3 * 128 * PITCH);
    const int tid = tid_opaque(), wid = __builtin_amdgcn_readfirstlane(tid >> 6), lane = tid & 63, wr = wid >> 2, wc = wid & 3, fr = lane & 15, fq = lane >> 4;
    const int r4 = tid >> 2, q4 = tid & 3;
    f32x4 gam[2], bet[2]; float rsw[4], bsv[4];
    u32x4 vr[4], vr2[4]; f32x4 sr, sr2; u32x4 ur[4], ur2[4];
    int last_g = -1;
#define SM_LOAD(dv, ds, du, un) do { const int _ch = sm_chunk_of((un) >> 4), _g = (un) & 15; const size_t _r0 = (size_t)_ch * 128; const int _c0 = _g * 128; \
        _Pragma("unroll") for (int k = 0; k < 4; ++k) dv[k] = *(const u32x4*)(V + (_r0 + r4) * 2048 + _c0 + k * 32 + q4 * 8);     \
        ds = *(const f32x4*)(stats + (_r0 + r4) * 16 + q4 * 4); \
        _Pragma("unroll") for (int mt = 0; mt < 4; ++mt) du[mt] = *(const u32x4*)(U + (_r0 + wr * 64 + mt * 16 + fr) * 2048 + _c0 + wc * 32 + 8 * fq); } while (0)
    int unit = bid;
    if (unit < NUNITS) SM_LOAD(vr, sr, ur, unit);
    if (unit + G < NUNITS) SM_LOAD(vr2, sr2, ur2, unit + G);
    for (int it = 0; unit < NUNITS; unit += G, ++it) {
        const int ch = sm_chunk_of(unit >> 4), g = unit & 15; const size_t row0 = (size_t)ch * 128; const int c0 = g * 128;
        if (g != last_g) {
            __syncthreads();
#pragma unroll
            for (int k = 0; k < 4; ++k) { const int id = tid + 512 * k, r = id >> 4, cc = (id & 15) * 8; *(LAS u32x4*)(Aimg + r * PITCH + cc * 2) = *(const u32x4*)(ws_t + ((size_t)g * 128 + r) * 128 + cc); }
            if (tid < 128) { const float* wp = ws_f + ((size_t)g * 128 + tid) * 128; float s = 0.f;
#pragma unroll 8
                for (int i = 0; i < 32; ++i) { const f32x4 x = *(const f32x4*)(wp + 4 * i); s += (x[0] + x[1]) + (x[2] + x[3]); }
                RS[tid] = s; }
            __syncthreads();
#pragma unroll
            for (int mt = 0; mt < 4; ++mt) { const int p = wr * 64 + mt * 16 + fr; rsw[mt] = RS[p]; bsv[mt] = b_s[g * 128 + p]; }
#pragma unroll
            for (int nt = 0; nt < 2; ++nt) { gam[nt] = *(const f32x4*)(ln_g + c0 + wc * 32 + 8 * fq + 4 * nt); bet[nt] = *(const f32x4*)(ln_b + c0 + wc * 32 + 8 * fq + 4 * nt); }
            last_g = g;
        }
        LAS unsigned char* Bi = Bimg + (it & 1) * 128 * PITCH;
        { float s = sr[0] + sr[2], q = sr[1] + sr[3]; s += xor1_f(s); q += xor1_f(q); s += xor2_f(s); q += xor2_f(q);
          const float mu = s * (1.0f / DA); const float rs = __builtin_amdgcn_rsqf(fmaxf(q * (1.0f / DA) - mu * mu, 0.f) + EPS);
#pragma unroll
          for (int k = 0; k < 4; ++k) { const u32x4 w = vr[k]; u32x2 o0, o1;
              o0.x = pk2((bflo(w.x) - mu) * rs, (bfhi(w.x) - mu) * rs); o0.y = pk2((bflo(w.y) - mu) * rs, (bfhi(w.y) - mu) * rs);
              o1.x = pk2((bflo(w.z) - mu) * rs, (bfhi(w.z) - mu) * rs); o1.y = pk2((bflo(w.w) - mu) * rs, (bfhi(w.w) - mu) * rs);
              *(LAS u32x2*)(Bi + r4 * PITCH + (k * 32 + 4 * q4) * 2) = o0; *(LAS u32x2*)(Bi + r4 * PITCH + (k * 32 + 16 + 4 * q4) * 2) = o1; } }
        u32x4 uc[4];
#pragma unroll
        for (int mt = 0; mt < 4; ++mt) { uc[mt] = ur[mt]; ur[mt] = ur2[mt]; }
#pragma unroll
        for (int k = 0; k < 4; ++k) vr[k] = vr2[k];
        sr = sr2;
        if (unit + 2 * G < NUNITS) SM_LOAD(vr2, sr2, ur2, unit + 2 * G);
        __syncthreads();
        f32x4 acc[4][2];
#pragma unroll
        for (int mt = 0; mt < 4; ++mt)
#pragma unroll
            for (int nt = 0; nt < 2; ++nt) acc[mt][nt] = (f32x4){0.f, 0.f, 0.f, 0.f};
#pragma unroll
        for (int ks = 0; ks < 4; ++ks) {
            bf16x8 bfr[2], afr[4];
#pragma unroll
            for (int mt = 0; mt < 4; ++mt) afr[mt] = *(const LAS bf16x8*)(Aimg + (wr * 64 + mt * 16 + fr) * PITCH + (ks * 32 + 8 * fq) * 2);
#pragma unroll
            for (int nt = 0; nt < 2; ++nt) { const LAS unsigned char* p = Bi + (ks * 32 + 8 * fq + (fr >> 2)) * PITCH + (wc * 32 + nt * 16) * 2 + 8 * (fr & 3);
                const s16x4 lo = tr16(p), hi = tr16(p + 4 * PITCH); bfr[nt] = __builtin_shufflevector(lo, hi, 0, 1, 2, 3, 4, 5, 6, 7); }
#pragma unroll
            for (int mt = 0; mt < 4; ++mt)
#pragma unroll
                for (int nt = 0; nt < 2; ++nt) acc[mt][nt] = __builtin_amdgcn_mfma_f32_16x16x32_bf16(bfr[nt], afr[mt], acc[mt][nt], 0, 0, 0);
        }
#pragma unroll
        for (int mt = 0; mt < 4; ++mt) { const int p = wr * 64 + mt * 16 + fr;
            const f32x4 sv0 = gam[0] * acc[mt][0] + bet[0] * rsw[mt] + bsv[mt], sv1 = gam[1] * acc[mt][1] + bet[1] * rsw[mt] + bsv[mt]; const u32x4 w = uc[mt];
            constexpr bool S8 = (FP8D_SIM & 4) != 0; u32x4 o; o.x = pk2(sim8(bflo(w.x) * sv0[0], S8), sim8(bfhi(w.x) * sv0[1], S8)); o.y = pk2(sim8(bflo(w.y) * sv0[2], S8), sim8(bfhi(w.y) * sv0[3], S8)); o.z = pk2(sim8(bflo(w.z) * sv1[0], S8), sim8(bfhi(w.z) * sv1[1], S8)); o.w = pk2(sim8(bflo(w.w) * sv1[2], S8), sim8(bfhi(w.w) * sv1[3], S8));
            *(u32x4*)(Uo + (row0 + p) * 2048 + c0 + wc * 32 + 8 * fq) = o; }
    }
#undef SM_LOAD
    __syncthreads();
}

DI bf16x8 pack8(const f32x16& x, int s) {
    u32x4 p; p.x = pk2(x[8 * s], x[8 * s + 1]); p.y = pk2(x[8 * s + 2], x[8 * s + 3]); p.z = pk2(x[8 * s + 4], x[8 * s + 5]); p.w = pk2(x[8 * s + 6], x[8 * s + 7]);
    return __builtin_bit_cast(bf16x8, p);
}
DI void at_phase(LAS unsigned char* lds, const bf16_t* Q, const bf16_t* Kb, const bf16_t* Vb, bf16_t* O, const float* sink  , int nunits, int bid, int G) {
    constexpr int KP = 144;
    constexpr int BUFB = 2 * 64 * KP;
    const int tid = tid_opaque(), wid = __builtin_amdgcn_readfirstlane(tid >> 6), lane = tid & 63, r = lane & 31, h = lane >> 5;
    const int g = wid >> 1, wh = wid & 1;
    const int skey = tid >> 3, sdc = tid & 7;
    for (int unit = bid; unit < nunits; unit += G) {
        int b, kvh, qb, qrow0; bool lat;
        if (unit < 2048) { lat = true; b = unit >> 7; kvh = (unit >> 5) & 3; qb = unit & 31; qrow0 = b * 4096 + qb * 128; }
        else { const int u2 = unit - 2048; lat = false; b = u2 >> 3; kvh = (u2 >> 1) & 3; qb = u2 & 1; qrow0 = ML + b * 256 + qb * 128; }
        const int hq = kvh * 4 + g;
        unsigned tmask = lat ? (0x3CCu | (qb >= 1 ? 0x3u : 0u) | (qb <= 30 ? 0x30u : 0u)) : 0x3C0u;
#define AT_KROW(ti) ((ti) < 6 ? b * 4096 + (qb - 1 + ((ti) >> 1)) * 128 + ((ti) & 1) * 64 : ML + b * 256 + ((ti) - 6) * 64)
        int ti = __builtin_ctz(tmask); tmask &= tmask - 1u;
        u32x4 kreg, vreg;
        { const int kr = AT_KROW(ti); kreg = *(const u32x4*)(Kb + (size_t)(kr + skey) * 256 + kvh * 64 + sdc * 8); vreg = *(const u32x4*)(Vb + (size_t)(kr + skey) * 256 + kvh * 64 + sdc * 8); }
        LAS unsigned char* QO = lds + 2 * BUFB + wid * (64 * KP);
        bf16x8 qf[2][4];
        { u32x4 qv[8];
#pragma unroll
          for (int i = 0; i < 8; ++i) { const int row = (lane >> 3) + 8 * i; qv[i] = *(const u32x4*)(Q + (size_t)(qrow0 + wh * 64 + row) * 1024 + hq * 64 + (lane & 7) * 8); }
#pragma unroll
          for (int i = 0; i < 8; ++i) { const int row = (lane >> 3) + 8 * i; *(LAS u32x4*)(QO + row * KP + (lane & 7) * 16) = qv[i]; }
          asm volatile("s_waitcnt lgkmcnt(0)" ::: "memory");
#pragma unroll
          for (int qt = 0; qt < 2; ++qt)
#pragma unroll
              for (int ks = 0; ks < 4; ++ks) qf[qt][ks] = *(const LAS bf16x8*)(QO + (qt * 32 + r) * KP + (ks * 16 + 8 * h) * 2);
          asm volatile("s_waitcnt lgkmcnt(0)" ::: "memory"); }
        f32x16 o[2][2];
#pragma unroll
        for (int dt = 0; dt < 2; ++dt)
#pragma unroll
            for (int qt = 0; qt < 2; ++qt)
#pragma unroll
                for (int i = 0; i < 16; ++i) o[dt][qt][i] = 0.f;
        float mrun[2], lrun[2];
        { const float sk = sink[hq] * LOG2E; mrun[0] = sk; mrun[1] = sk; lrun[0] = h == 0 ? 1.f : 0.f; lrun[1] = lrun[0]; }
        __syncthreads();
        *(LAS u32x4*)(lds + skey * KP + sdc * 16) = kreg; *(LAS u32x4*)(lds + 64 * KP + skey * KP + sdc * 16) = vreg;
        int buf = 0;
        for (;;) {
            const int tn = tmask ? __builtin_ctz(tmask) : -1; tmask &= tmask - 1u;
            if (tn >= 0) { const int kr = AT_KROW(tn); kreg = *(const u32x4*)(Kb + (size_t)(kr + skey) * 256 + kvh * 64 + sdc * 8); vreg = *(const u32x4*)(Vb + (size_t)(kr + skey) * 256 + kvh * 64 + sdc * 8); }
            __syncthreads();
            const LAS unsigned char* Kimg = lds + buf * BUFB; const LAS unsigned char* Vimg = Kimg + 64 * KP;
            const int mode = ti < 2 ? 1 : (ti < 4 ? 0 : (ti < 6 ? 2 : 0));
            const bool skip = (ti == 0 && wh == 1) || (ti == 5 && wh == 0);
            if (!skip) {
            f32x16 s[2][2];
#pragma unroll
            for (int kt = 0; kt < 2; ++kt)
#pragma unroll
                for (int qt = 0; qt < 2; ++qt)
#pragma unroll
                    for (int i = 0; i < 16; ++i) s[kt][qt][i] = -mrun[qt];
            {
                const unsigned kaddr = (unsigned)(__UINTPTR_TYPE__)(Kimg + r * KP + 16 * h);
                bf16x8 k0, k1, k2;
#define AT_KRD(dst, OFF) asm volatile("ds_read_b128 %0, %1 offset:" #OFF : "=v"(dst) : "v"(kaddr))
#define AT_KW(dst, N) asm volatile("s_waitcnt lgkmcnt(" #N ")" : "+v"(dst) :: "memory")
#define AT_QK(kfv, kt, ks) do { s[kt][0] = __builtin_amdgcn_mfma_f32_32x32x16_bf16(kfv, qf[0][ks], s[kt][0], 0, 0, 0); s[kt][1] = __builtin_amdgcn_mfma_f32_32x32x16_bf16(kfv, qf[1][ks], s[kt][1], 0, 0, 0); } while (0)
                asm volatile("s_waitcnt lgkmcnt(0)" ::: "memory");
                AT_KRD(k0, 0); AT_KRD(k1, 32);
                AT_KRD(k2, 64);   AT_KW(k0, 2); AT_QK(k0, 0, 0);
                AT_KRD(k0, 96);   AT_KW(k1, 2); AT_QK(k1, 0, 1);
                AT_KRD(k1, 4608); AT_KW(k2, 2); AT_QK(k2, 0, 2);
                AT_KRD(k2, 4640); AT_KW(k0, 2); AT_QK(k0, 0, 3);
                AT_KRD(k0, 4672); AT_KW(k1, 2); AT_QK(k1, 1, 0);
                AT_KRD(k1, 4704); AT_KW(k2, 2); AT_QK(k2, 1, 1);
                                  AT_KW(k0, 1); AT_QK(k0, 1, 2);
                                  AT_KW(k1, 0); AT_QK(k1, 1, 3);
#undef AT_KRD
#undef AT_KW
#undef AT_QK
            }
            if (mode != 0) {
                const int jb = (ti & 1) * 64;
#pragma unroll
                for (int qt = 0; qt < 2; ++qt) { const int dlt = jb + 4 * h - (wh * 64 + qt * 32 + r);
                    if (mode == 1) {
#pragma unroll
                        for (int kt = 0; kt < 2; ++kt)
#pragma unroll
                            for (int i = 0; i < 16; ++i) { if (dlt < -(kt * 32 + (i & 3) + 8 * (i >> 2))) s[kt][qt][i] = -INFINITY; }
                    } else {
#pragma unroll
                        for (int kt = 0; kt < 2; ++kt)
#pragma unroll
                            for (int i = 0; i < 16; ++i) { if (dlt > -(kt * 32 + (i & 3) + 8 * (i >> 2))) s[kt][qt][i] = -INFINITY; }
                    } }
            }
            float mx[2];
#pragma unroll
            for (int qt = 0; qt < 2; ++qt) { float m0 = __builtin_fmaxf(s[0][qt][0], s[1][qt][0]);
#pragma unroll
                for (int i = 1; i < 16; ++i) m0 = __builtin_fmaxf(__builtin_fmaxf(m0, s[0][qt][i]), s[1][qt][i]);
                mx[qt] = x32_max(m0); }
            if (__builtin_amdgcn_ballot_w64(mx[0] > 8.0f || mx[1] > 8.0f) != 0ull) {
#pragma unroll
                for (int qt = 0; qt < 2; ++qt) { const float d = fmaxf(mx[qt], 0.f), alpha = __builtin_amdgcn_exp2f(-d); mrun[qt] += d; lrun[qt] *= alpha;
#pragma unroll
                    for (int kt = 0; kt < 2; ++kt)
#pragma unroll
                        for (int i = 0; i < 16; ++i) s[kt][qt][i] -= d;
#pragma unroll
                    for (int dt = 0; dt < 2; ++dt)
#pragma unroll
                        for (int i = 0; i < 16; ++i) o[dt][qt][i] *= alpha; }
            }
#pragma unroll
            for (int qt = 0; qt < 2; ++qt) { float ls = 0.f;
#pragma unroll
                for (int kt = 0; kt < 2; ++kt)
#pragma unroll
                    for (int i = 0; i < 16; ++i) { const float p = __builtin_amdgcn_exp2f(s[kt][qt][i]); s[kt][qt][i] = p; ls += p; }
                lrun[qt] += ls; }
#pragma unroll
            for (int kt = 0; kt < 2; ++kt)
#pragma unroll
                for (int ss = 0; ss < 2; ++ss) {
                    bf16x8 vf[2];
#pragma unroll
                    for (int dt = 0; dt < 2; ++dt) { const LAS unsigned char* p = Vimg + (kt * 32 + 16 * ss + 4 * h + ((lane & 15) >> 2)) * KP + (dt * 32 + 16 * ((lane >> 4) & 1)) * 2 + 8 * (lane & 3);
                        const s16x4 lo = tr16(p), hi = tr16(p + 8 * KP); vf[dt] = __builtin_shufflevector(lo, hi, 0, 1, 2, 3, 4, 5, 6, 7); }
#pragma unroll
                    for (int qt = 0; qt < 2; ++qt) { const bf16x8 pf = pack8(s[kt][qt], ss);
#pragma unroll
                        for (int dt = 0; dt < 2; ++dt) o[dt][qt] = __builtin_amdgcn_mfma_f32_32x32x16_bf16(vf[dt], pf, o[dt][qt], 0, 0, 0); }
                }
            }
            if (tn < 0) break;
            { LAS unsigned char* nb = lds + (buf ^ 1) * BUFB; *(LAS u32x4*)(nb + skey * KP + sdc * 16) = kreg; *(LAS u32x4*)(nb + 64 * KP + skey * KP + sdc * 16) = vreg; }
            buf ^= 1; ti = tn;
        }
#undef AT_KROW
#pragma unroll
        for (int qt = 0; qt < 2; ++qt) { const float lt = x32_sum(lrun[qt]); const float inv = 1.0f / lt;
#pragma unroll
            for (int dt = 0; dt < 2; ++dt)
#pragma unroll
                for (int ig = 0; ig < 4; ++ig) {
                    if (FP8_ATT) { *(LAS unsigned*)(QO + (qt * 32 + r) * KP + (dt * 32 + 8 * ig + 4 * h)) = pk4_fp8(o[dt][qt][4 * ig] * inv, o[dt][qt][4 * ig + 1] * inv, o[dt][qt][4 * ig + 2] * inv, o[dt][qt][4 * ig + 3] * inv); }
                    else { constexpr bool S8 = (FP8D_SIM & 2) != 0; u32x2 w; w.x = pk2(sim8(o[dt][qt][4 * ig] * inv, S8), sim8(o[dt][qt][4 * ig + 1] * inv, S8)); w.y = pk2(sim8(o[dt][qt][4 * ig + 2] * inv, S8), sim8(o[dt][qt][4 * ig + 3] * inv, S8));
                        *(LAS u32x2*)(QO + (qt * 32 + r) * KP + (dt * 32 + 8 * ig + 4 * h) * 2) = w; } } }
        asm volatile("s_waitcnt lgkmcnt(0)" ::: "memory");
        if (FP8_ATT) {
#pragma unroll
            for (int i = 0; i < 4; ++i) { const int row = (lane >> 2) + 16 * i; const u32x4 w = *(const LAS u32x4*)(QO + row * KP + (lane & 3) * 16);
                *(u32x4*)((unsigned char*)O + (size_t)(qrow0 + wh * 64 + row) * 1024 + hq * 64 + (lane & 3) * 16) = w; }
        } else {
#pragma unroll
        for (int i = 0; i < 8; ++i) { const int row = (lane >> 3) + 8 * i; const u32x4 w = *(const LAS u32x4*)(QO + row * KP + (lane & 7) * 16);
            *(u32x4*)(O + (size_t)(qrow0 + wh * 64 + row) * 1024 + hq * 64 + (lane & 7) * 8) = w; }
        }
        asm volatile("s_waitcnt lgkmcnt(0)" ::: "memory");
    }
    __syncthreads();
}

struct Args { const float* in[23]; float* out; unsigned char* ws; int ph_lo, ph_hi; };
static_assert(sizeof(Args) == 25 * 8 + 8, "Args has no padding");
#define AS4 __attribute__((address_space(4)))
DI unsigned long long karg(int k) { const unsigned long long AS4* kp = (const unsigned long long AS4*)__builtin_amdgcn_kernarg_segment_ptr(); asm volatile("" : "+s"(kp)); return kp[k]; }
#define KIN(k) ((const float*)(const GAS float*)karg(k))
#define KOUT() ((float*)(GAS float*)karg(23))
#define KWS() ((unsigned char*)(GAS unsigned char*)karg(24))

#ifndef DBG_ONLY
#define DBG_ONLY -1
#endif
#ifndef ALIGN_E12
#define ALIGN_E12 true
#endif
#ifndef DUP_MASK
#define DUP_MASK 0
#endif
#ifndef STAMP_MASK
#define STAMP_MASK 0
#endif
#ifndef STAMP_TMAX_US
#define STAMP_TMAX_US 5000
#endif
#define NDUP(n) (((DUP_MASK >> (n)) & 1) ? 2 : 1)
#define DUMMY(n) (NDUP(n) == 2 && dup_ == 0)
#define ST0(n) do { if (STAMP_MASK && ((STAMP_MASK >> (n)) & 1) && blockIdx.x == 0) t_st0 = __builtin_amdgcn_s_memrealtime(); } while (0)
#define ST1(n) do { if (STAMP_MASK && ((STAMP_MASK >> (n)) & 1) && blockIdx.x == 0) t_acc += __builtin_amdgcn_s_memrealtime() - t_st0; } while (0)
#define SITE(n) (DBG_ONLY < 0 || DBG_ONLY == (n))

__global__ void __launch_bounds__(512, 2) mega_fwd(Args args) {
    extern __shared__ __attribute__((aligned(16))) unsigned char lds_raw[];
    LAS unsigned char* lds = (LAS unsigned char*)lds_raw;
    const int tid = threadIdx.x;
    for (int u = tid; u < (LDS_BYTES - RING_BYTES) / 4; u += 512) ((LAS unsigned*)(lds + RING_BYTES))[u] = 0u;
    __syncthreads();
    XcdBarrier bar; bar.bar = (unsigned*)(args.ws + WS_CTL) + CW_BAR; bar.x = 0; bar.st = nullptr;
    if (!MK_SPLIT) bar = xcd_barrier_post((unsigned*)(args.ws + WS_CTL) + CW_BAR, (volatile LAS unsigned*)(lds + MISC_OFF) + 8);
    const int lo = args.ph_lo, hi = args.ph_hi;
    unsigned long long t_st0 = 0, t_acc = 0; (void)t_st0; (void)t_acc;
#define IN(k) (lo <= (k) && (k) < hi)
#ifndef SEAM_REP
#define SEAM_REP 1
#endif
#define SEAM(k) do { if (!MK_SPLIT && IN((k) + 1)) { for (int rep_ = 0; rep_ < SEAM_REP; ++rep_) xcd_barrier(bar); } } while (0)
#ifndef STEAL
#define STEAL 1
#endif
#define STEAL_ARGS() P0Args sa; sa.w1 = KIN(19); sa.w3 = KIN(20); sa.w2 = KIN(21); sa.w13_t = (bf16_t*)(ws + WS_W13); sa.w2_t = (bf16_t*)(ws + WS_W2); unsigned* sq = (unsigned*)(ws + WS_CTL) + CW_STEAL
#define STEAL_TAIL(nunits, budget, own) do { if (STEAL && ((nunits) % G) != 0 && bid >= ((nunits) % G)) { STEAL_ARGS(); \
        if (own) steal_convert(lds, sq + 64 * layer, sa, layer, (budget)); else if (layer < DEPTH - 1) steal_convert(lds, sq + 64 * (layer + 1), sa, layer + 1, (budget)); } } while (0)
#define WAVE_IDS() const int tid_ = tid_opaque(); const int lane = tid_ & 63, wave = __builtin_amdgcn_readfirstlane(tid_ >> 6); const int G = gridDim.x, bid = blockIdx.x; const int gw = bid * 8 + wave, NGW = G * 8; (void)lane; (void)gw; (void)NGW; (void)G; (void)bid

    ST0(0); for (int dup_ = 0; dup_ < NDUP(0); ++dup_) if (SITE(0) && IN(0)) { if (dup_) __syncthreads();
        WAVE_IDS(); unsigned char* ws = KWS();
        p0_mod(lds, KIN(1), KIN(3), KIN(4), KIN(5), (float*)(ws + WS_MOD), bid, G);
        P0Args pa; pa.w_in = KIN(8); pa.w_out = KIN(14); pa.w_qkv = KIN(15); pa.w_o = KIN(17); pa.w1 = KIN(19); pa.w3 = KIN(20); pa.w2 = KIN(21); pa.w_s = KIN(12);
        pa.win_t = (bf16_t*)(ws + WS_WIN); pa.wout_t = (bf16_t*)(ws + WS_WOUT); pa.wqkv_t = (bf16_t*)(ws + WS_WQKV); pa.wo_t = (bf16_t*)(ws + WS_WO); pa.w13_t = (bf16_t*)(ws + WS_W13); pa.w2_t = (bf16_t*)(ws + WS_W2);
        pa.ws_t = (bf16_t*)(ws + WS_WSP); pa.cosT = (float*)(ws + WS_ROPE); pa.sinT = pa.cosT + 4096 * 32;
        p0_convert(lds, pa, gw, NGW, lane, wave);
    }
    SEAM(0); ST1(0);
    ST0(1); for (int dup_ = 0; dup_ < NDUP(1); ++dup_) if (SITE(1) && IN(1)) { if (dup_) __syncthreads(); WAVE_IDS(); unsigned char* ws = KWS();
        n0_phase(KIN(0), KIN(2), DUMMY(1) ? (bf16_t*)(ws + WS_BIG) : (bf16_t*)(ws + WS_X), (const float*)(ws + WS_MOD), KIN(6), DUMMY(1) ? (bf16_t*)(ws + WS_BIG + 300 * MiB) : (bf16_t*)(ws + WS_H), gw, NGW, lane); }
    SEAM(1); ST1(1);

    for (int layer = 0; layer < DEPTH; ++layer) {
        const int pb = 2 + 8 * layer, j = layer >> 1; const bool lastl = layer == DEPTH - 1;
        const int mrows = lastl ? ML : MT;
        if ((layer & 1) == 0) {
            ST0(2); for (int dup_ = 0; dup_ < NDUP(2); ++dup_) if (SITE(2) && IN(pb + 0)) { if (dup_) __syncthreads(); WAVE_IDS(); unsigned char* ws = KWS();
                pg8::Gemm g{(const bf16_t*)(ws + WS_H), (const bf16_t*)(ws + WS_WIN) + (size_t)j * 4096 * 1024, nullptr}; pg8::GroupedOrder<16, 0> S; S.init(MT / 256, 1, G, bid);
                EpiGeluUV E{(bf16_t*)(ws + WS_BIG + BIG_U), (bf16_t*)(ws + WS_BIG + BIG_V), KIN(9) + (size_t)j * 4096, (float*)(ws + WS_STATS), lds + XCH_OFF};
                pg8::gemm_phase<EpiGeluUV, pg8::GroupedOrder<16, 0>, false, 1024, 0, 0, true, 2, (ROTK_MASK & 4) != 0>(lds, g, S, E); }
            SEAM(pb + 0); ST1(2);
            ST0(3); for (int dup_ = 0; dup_ < NDUP(3); ++dup_) if (SITE(3) && IN(pb + 1)) { if (dup_) __syncthreads(); WAVE_IDS(); unsigned char* ws = KWS();
                sm_phase(lds, (const bf16_t*)(ws + WS_BIG + BIG_U), DUMMY(3) ? (bf16_t*)(ws + WS_Y) : (bf16_t*)(ws + WS_BIG + BIG_U), (const bf16_t*)(ws + WS_BIG + BIG_V), (const float*)(ws + WS_STATS), (const bf16_t*)(ws + WS_WSP) + (size_t)j * 16 * 128 * 128,
                         KIN(12) + (size_t)j * 16 * 128 * 128, KIN(13) + (size_t)j * 16 * 128, KIN(10) + (size_t)j * 2048, KIN(11) + (size_t)j * 2048, bid, G); }
            SEAM(pb + 1); ST1(3);
            ST0(4); for (int dup_ = 0; dup_ < NDUP(4); ++dup_) if (SITE(4) && IN(pb + 2)) { if (dup_) __syncthreads(); WAVE_IDS(); unsigned char* ws = KWS();
                pg8::Gemm g{(const bf16_t*)(ws + WS_BIG + BIG_U), (const bf16_t*)(ws + WS_WOUT) + (size_t)j * 1024 * 2048, nullptr}; pg8::GroupedOrder<4, 0> S; S.init(MT / 256, 1, G, bid);
                EpiResAdd E{(const bf16_t*)(ws + WS_X), DUMMY(4) ? (bf16_t*)(ws + WS_Y) : (bf16_t*)(ws + WS_X), (const float*)(ws + WS_MOD) + (size_t)layer * 17 * 6144 + 2048, 1.0f};
                pg8::gemm_phase<EpiResAdd, pg8::GroupedOrder<4, 0>, false, 2048, 0, 0, true, 2, (ROTK_MASK & 8) != 0>(lds, g, S, E); if (dup_ == NDUP(4) - 1) STEAL_TAIL((MT / 256) * 4, 8, true); }
            SEAM(pb + 2); ST1(4);
        } else {
            ST0(5); for (int dup_ = 0; dup_ < NDUP(5); ++dup_) if (SITE(5) && IN(pb + 0)) { if (dup_) __syncthreads(); WAVE_IDS(); unsigned char* ws = KWS();
                pg8::Gemm g{(const bf16_t*)(ws + WS_H), (const bf16_t*)(ws + WS_WQKV + (size_t)j * 1536 * 1024 * (FP8_ATT ? 1 : 2)), nullptr}; pg8::GroupedOrder<6, 0> S; S.init(MT / 256, 1, G, bid);
                EpiQKV E{(bf16_t*)(ws + WS_BIG + BIG_Q), (bf16_t*)(ws + WS_BIG + BIG_K), (bf16_t*)(ws + WS_BIG + BIG_VV), (const float*)(ws + WS_ROPE), (const float*)(ws + WS_ROPE) + 4096 * 32};
                pg8::gemm_phase<EpiQKV, pg8::GroupedOrder<6, 0>, false, 1024, 0, 0, true, FP8_ATT ? 1 : 2, (ROTK_MASK & 16) != 0>(lds, g, S, E); if (dup_ == NDUP(5) - 1) STEAL_TAIL((MT / 256) * 6, 2, true); }
            SEAM(pb + 0); ST1(5);
            ST0(6); for (int dup_ = 0; dup_ < NDUP(6); ++dup_) if (SITE(6) && IN(pb + 1)) { if (dup_) __syncthreads(); WAVE_IDS(); unsigned char* ws = KWS();
                at_phase(lds, (const bf16_t*)(ws + WS_BIG + BIG_Q), (const bf16_t*)(ws + WS_BIG + BIG_K), (const bf16_t*)(ws + WS_BIG + BIG_VV), (bf16_t*)(ws + WS_BIG + BIG_O), KIN(16) + j * 16, lastl ? 2048 : 2048 + 128, bid, G); if (dup_ == NDUP(6) - 1) STEAL_TAIL(lastl ? 2048 : 2048 + 128, 5, true); }
            SEAM(pb + 1); ST1(6);
            ST0(7); for (int dup_ = 0; dup_ < NDUP(7); ++dup_) if (SITE(7) && IN(pb + 2)) { if (dup_) __syncthreads(); WAVE_IDS(); unsigned char* ws = KWS();
                pg8::Gemm g{(const bf16_t*)(ws + WS_BIG + BIG_O), (const bf16_t*)(ws + WS_WO + (size_t)j * 1024 * 1024 * (FP8_ATT ? 1 : 2)), nullptr}; pg8::GroupedOrder<4, 0> S; S.init(mrows / 256, 1, G, bid);
                EpiResAdd E{(const bf16_t*)(ws + WS_X), DUMMY(7) ? (bf16_t*)(ws + WS_Y) : (bf16_t*)(ws + WS_X), (const float*)(ws + WS_MOD) + (size_t)layer * 17 * 6144 + 2048, FP8_ATT ? 1.0f / WM_SCALE : 1.0f};
                pg8::gemm_phase<EpiResAdd, pg8::GroupedOrder<4, 0>, false, 1024, 0, 0, true, FP8_ATT ? 1 : 2, (ROTK_MASK & 32) != 0>(lds, g, S, E); if (dup_ == NDUP(7) - 1) STEAL_TAIL((mrows / 256) * 4, 1, true); }
            SEAM(pb + 2); ST1(7);
        }
        ST0(8); for (int dup_ = 0; dup_ < NDUP(8); ++dup_) if (SITE(8) && IN(pb + 3)) { if (dup_) __syncthreads(); WAVE_IDS(); unsigned char* ws = KWS();
            n2_phase(lds, mrows, (const bf16_t*)(ws + WS_X), (const float*)(ws + WS_MOD) + (size_t)layer * 17 * 6144, KIN(7) + layer * 1024, KIN(18) + (size_t)layer * 1024 * 16,
                     (bf16_t*)(ws + WS_H), (float*)(ws + WS_AFF), bid, G); }
        SEAM(pb + 3); ST1(8);
        ST0(9); for (int dup_ = 0; dup_ < NDUP(9); ++dup_) if (SITE(9) && IN(pb + 4)) { if (dup_) __syncthreads(); WAVE_IDS(); unsigned char* ws = KWS();
            const float* aff = (const float*)(ws + WS_AFF); int* rowidx = (int*)(ws + WS_ROWIDX); float* gate = (float*)(ws + WS_GATE); int* tokslot = (int*)(ws + WS_TOKSLOT);
            for (int p = bid; p < 256; p += G) { const int b = p >> 4, e = p & 15; tk_pair(lds, aff, e, b * 4096, e * SLOTS_E + b * CAPL, !lastl, ML + b * 256, e * SLOTS_E + NB * CAPL + b * CAPC, rowidx, gate, tokslot + (size_t)e * MT); }
            if (STEAL && dup_ == NDUP(9) - 1) { STEAL_ARGS(); steal_convert(lds, sq + 64 * layer, sa, layer, STEAL_NCHUNKS); }
        }
        SEAM(pb + 4); ST1(9);
        const int nMe = lastl ? 32 : 34;
        ST0(10); for (int dup_ = 0; dup_ < NDUP(10); ++dup_) if (SITE(10) && IN(pb + 5)) { if (dup_) __syncthreads(); WAVE_IDS(); unsigned char* ws = KWS();
            pg8::Gemm g{(const bf16_t*)(ws + WS_H), (const bf16_t*)(ws + WS_W13 + (size_t)layer * 16 * 4096 * 1024), (const int*)(ws + WS_ROWIDX)}; pg8::GroupedOrder<16, 34> S; S.init(nMe, 16, G, bid);
            EpiSwiGLU E{(unsigned char*)(ws + WS_BIG)};
#if ABL_E1
            { EpiSwiGLU Ed{(unsigned char*)(ws + WS_Y)}; pg8::gemm_phase<EpiSwiGLU, pg8::GroupedOrder<16, 34>, true, 1024, (size_t)4096 * 1024, 0, ALIGN_E12, 1, (ROTK_MASK & 1) != 0, (ABL_E1) & 255>(lds, g, S, Ed); __syncthreads(); }
#endif
            pg8::gemm_phase<EpiSwiGLU, pg8::GroupedOrder<16, 34>, true, 1024, (size_t)4096 * 1024, 0, ALIGN_E12, 1, (ROTK_MASK & 1) != 0>(lds, g, S, E); }
        SEAM(pb + 5); ST1(10);
        ST0(11); for (int dup_ = 0; dup_ < NDUP(11); ++dup_) if (SITE(11) && IN(pb + 6)) { if (dup_) __syncthreads(); WAVE_IDS(); unsigned char* ws = KWS();
            pg8::Gemm g{(const bf16_t*)(ws + WS_BIG), (const bf16_t*)(ws + WS_W2 + (size_t)layer * 16 * 1024 * 2048), nullptr}; pg8::GroupedOrder<4, 34, true> S; S.init(nMe, 16, G, bid);
            EpiGateY E{(unsigned char*)(ws + WS_Y), (const float*)(ws + WS_GATE)};
            pg8::gemm_phase<EpiGateY, pg8::GroupedOrder<4, 34, true>, false, 2048, (size_t)1024 * 2048, 0, ALIGN_E12, 1, (ROTK_MASK & 2) != 0>(lds, g, S, E); if (dup_ == NDUP(11) - 1) STEAL_TAIL(nMe * 4 * 16, 4, false); }
        SEAM(pb + 6); ST1(11);
        ST0(12); for (int dup_ = 0; dup_ < NDUP(12); ++dup_) if (SITE(12) && IN(pb + 7)) { if (dup_) __syncthreads(); WAVE_IDS(); unsigned char* ws = KWS();
            const float* modl = (const float*)(ws + WS_MOD) + (size_t)layer * 17 * 6144;
            if (!lastl) n1_phase(1, MT, (const bf16_t*)(ws + WS_X), DUMMY(12) ? (bf16_t*)(ws + WS_BIG) : (bf16_t*)(ws + WS_X), nullptr, (const unsigned char*)(ws + WS_Y), (const int*)(ws + WS_TOKSLOT), modl, modl + 17 * 6144, KIN(6) + (layer + 1) * 1024,
                                 DUMMY(12) ? (bf16_t*)(ws + WS_BIG + 300 * MiB) : (bf16_t*)(ws + WS_H), gw, NGW, lane, ((layer + 1) & 1) ? (FP8D_SIM & 2) != 0 : (FP8D_SIM & 1) != 0, FP8_ATT && ((layer + 1) & 1));
            else n1_phase(2, ML, (const bf16_t*)(ws + WS_X), nullptr, DUMMY(12) ? (float*)(ws + WS_BIG) : KOUT(), (const unsigned char*)(ws + WS_Y), (const int*)(ws + WS_TOKSLOT), modl, nullptr, KIN(22), nullptr, gw, NGW, lane);
        }
        SEAM(pb + 7); ST1(12);
    }
#undef IN
#undef SEAM
}

extern "C" void kernel_launch(void* const* d_in, const int* in_sizes, int n_in, void* d_out, int out_size, void* d_ws, size_t ws_size, hipStream_t stream) {
    static int grid = 0;
    if (grid == 0) {
        if (n_in != 23 || out_size != ML * D || ws_size < WS_END) { fprintf(stderr, "kernel_launch: unexpected shapes (n_in %d, out %d, ws %zu); nothing launched\n", n_in, out_size, ws_size); grid = -1; return; }
        int dev = 0, cus = 0, per_cu = 0;
        if (hipGetDevice(&dev) != hipSuccess || hipDeviceGetAttribute(&cus, hipDeviceAttributeMultiprocessorCount, dev) != hipSuccess) { grid = -1; return; }
        if (hipFuncSetAttribute((const void*)mega_fwd, hipFuncAttributeMaxDynamicSharedMemorySize, LDS_BYTES) != hipSuccess) { fprintf(stderr, "kernel_launch: hipFuncSetAttribute failed\n"); grid = -1; return; }
        if (hipOccupancyMaxActiveBlocksPerMultiprocessor(&per_cu, (const void*)mega_fwd, 512, LDS_BYTES) != hipSuccess || per_cu < 1)
            fprintf(stderr, "kernel_launch: note: occupancy query reports %d workgroups per CU\n", per_cu);
        (void)hipGetLastError();
        grid = cus;
    }
    if (grid < 0) return;
    if (hipMemsetAsync((char*)d_ws + WS_CTL, 0, CTL_ZERO_BYTES, stream) != hipSuccess) return;
    Args a{};
    for (int i = 0; i < 23; ++i) a.in[i] = (const float*)d_in[i];
    a.out = (float*)d_out; a.ws = (unsigned char*)d_ws;
    constexpr int NPH = 2 + 8 * DEPTH;
#if MK_SPLIT
    for (int p = 0; p < NPH; ++p) { a.ph_lo = p; a.ph_hi = p + 1; hipLaunchKernelGGL(mega_fwd, dim3(grid), dim3(512), LDS_BYTES, stream, a); }
#else
    a.ph_lo = 0; a.ph_hi = NPH;
    hipLaunchKernelGGL(mega_fwd, dim3(grid), dim3(512), LDS_BYTES, stream, a);
#endif
    const hipError_t le = hipPeekAtLastError();
    if (le != hipSuccess) fprintf(stderr, "kernel_launch: launch failed: %s\n", hipGetErrorName(le));
}
```

```cpp
#include <hip/hip_runtime.h>
#include <cstdio>
#include <cstdint>

#define LAS __attribute__((address_space(3)))
#define GAS __attribute__((address_space(1)))
typedef unsigned short bf16_t;
typedef short bf16x8 __attribute__((ext_vector_type(8)));
typedef short s16x4 __attribute__((ext_vector_type(4)));
typedef float f32x4 __attribute__((ext_vector_type(4)));
typedef float f32x2 __attribute__((ext_vector_type(2)));
typedef float f32x16 __attribute__((ext_vector_type(16)));
typedef unsigned u32x4 __attribute__((ext_vector_type(4)));
typedef unsigned u32x2 __attribute__((ext_vector_type(2)));
typedef short v4i16_t __attribute__((ext_vector_type(4)));
#define DI __device__ __forceinline__

#ifndef MK_SPLIT
#define MK_SPLIT 0
#endif

constexpr int D = 1024, NB = 16, SEQ = 4096, CTX = 256, DEPTH = 4;
constexpr int ML = NB * SEQ, MC = NB * CTX, MT = ML + MC;
constexpr int DA = 2048, NE = 16, CAPL = 512, CAPC = 32;
constexpr int SLOTS_E = NB * CAPL + NB * CAPC;
constexpr int NSLOT = NE * SLOTS_E;
constexpr int DFF = 2048, NQKV = 1536;
constexpr float EPS = 1e-6f;
constexpr float LOG2E = 1.4426950408889634f;
constexpr float W13_SCALE = 32.0f, W2_SCALE = 64.0f, Y_SCALE = 32.0f, WM_SCALE = 32.0f;
constexpr float QSCALE = 0.125f * LOG2E;

constexpr size_t MiB = 1u << 20;
constexpr size_t WS_CTL = 0, CTL_ZERO_BYTES = 64 * 1024;
constexpr size_t WS_MOD = 1 * MiB;
constexpr size_t WS_ROPE = 3 * MiB;
constexpr size_t WS_AFF = 4 * MiB;
constexpr size_t WS_TOKSLOT = 9 * MiB;
constexpr size_t WS_ROWIDX = 14 * MiB;
constexpr size_t WS_GATE = 15 * MiB;
constexpr size_t WS_STATS = 16 * MiB;
constexpr size_t WS_XC = 34 * MiB;
constexpr size_t WS_WIN = 50 * MiB;
constexpr size_t WS_WOUT = 66 * MiB;
constexpr size_t WS_WQKV = 74 * MiB;
constexpr size_t WS_WO = 80 * MiB;
constexpr size_t WS_WSP = 84 * MiB;
constexpr size_t WS_W13 = 86 * MiB;
constexpr size_t WS_W2 = 598 * MiB;
constexpr size_t WS_H = 854 * MiB;
constexpr size_t WS_BIG = 990 * MiB;
constexpr size_t WS_Y = 1534 * MiB;
constexpr size_t WS_X = 1806 * MiB;
constexpr size_t WS_END = 1942 * MiB;
constexpr size_t BIG_U = 0, BIG_V = (size_t)MT * 2048 * 2;
constexpr size_t BIG_Q = 0, BIG_K = (size_t)MT * 1024 * 2, BIG_VV = BIG_K + (size_t)MT * 256 * 2, BIG_O = BIG_VV + (size_t)MT * 256 * 2;
static_assert(BIG_O + (size_t)MT * 1024 * 2 <= 544 * MiB && (size_t)NSLOT * 2048 * 2 <= 544 * MiB && BIG_V + (size_t)MT * 2048 * 2 <= 544 * MiB, "big region");
static_assert(WS_STATS + (size_t)MT * 64 * 4 <= WS_XC && WS_AFF + (size_t)MT * 64 <= WS_TOKSLOT && WS_TOKSLOT + (size_t)MT * 64 <= WS_ROWIDX, "ws map");
constexpr int CW_BAR = 4096;
constexpr int CW_STEAL = 1024;

constexpr int RING_BYTES = 131072;
constexpr int MISC_OFF = RING_BYTES + 320;
constexpr int XCH_OFF = RING_BYTES + 1024;
constexpr int LDS_BYTES = 147456;
static_assert(MISC_OFF + 128 <= XCH_OFF && XCH_OFF + 8192 <= LDS_BYTES, "LDS map");

DI unsigned pk2(float lo, float hi) { unsigned r; asm("v_cvt_pk_bf16_f32 %0, %1, %2" : "=v"(r) : "v"(lo), "v"(hi)); return r; }
DI unsigned pk4_fp8(float a, float b, float c, float d) { int p = __builtin_amdgcn_cvt_pk_fp8_f32(a, b, 0, false); p = __builtin_amdgcn_cvt_pk_fp8_f32(c, d, p, true); return (unsigned)p; }
#ifndef FP8_ATT
#define FP8_ATT 1
#endif
#ifndef ABL_E1
#define ABL_E1 0
#endif
#ifndef ROTK_MASK
#define ROTK_MASK 0
#endif
#ifndef FP8D_SIM
#define FP8D_SIM 0
#endif
DI float sim8(float v, bool on) { if (!FP8D_SIM || !on) return v; const int p = __builtin_amdgcn_cvt_pk_fp8_f32(v, v, 0, false); return __builtin_amdgcn_cvt_f32_fp8(p, 0); }
DI float bflo(unsigned w) { return __uint_as_float(w << 16); }
DI float bfhi(unsigned w) { return __uint_as_float(w & 0xffff0000u); }
typedef unsigned u32v2_t __attribute__((ext_vector_type(2)));
#define DPP_F(v, ctrl) __uint_as_float((unsigned)__builtin_amdgcn_mov_dpp((int)__float_as_uint(v), ctrl, 0xF, 0xF, true))
#define DPP_I(v, ctrl) __builtin_amdgcn_mov_dpp((v), ctrl, 0xF, 0xF, true)
DI float xor1_f(float v) { return DPP_F(v, 0xB1); }
DI float xor2_f(float v) { return DPP_F(v, 0x4E); }
DI float row16_sum(float v) { v += DPP_F(v, 0xB1); v += DPP_F(v, 0x4E); v += DPP_F(v, 0x141); v += DPP_F(v, 0x140); return v; }
DI float row16_max(float v) { v = fmaxf(v, DPP_F(v, 0xB1)); v = fmaxf(v, DPP_F(v, 0x4E)); v = fmaxf(v, DPP_F(v, 0x141)); v = fmaxf(v, DPP_F(v, 0x140)); return v; }
DI int row16_sum_i(int v) { v += DPP_I(v, 0xB1); v += DPP_I(v, 0x4E); v += DPP_I(v, 0x141); v += DPP_I(v, 0x140); return v; }
DI float x16_sum(float v) { const unsigned x = __float_as_uint(v); const u32v2_t r = __builtin_amdgcn_permlane16_swap(x, x, false, false); return __uint_as_float(r[0]) + __uint_as_float(r[1]); }
DI float x32_sum(float v) { const unsigned x = __float_as_uint(v); const u32v2_t r = __builtin_amdgcn_permlane32_swap(x, x, false, false); return __uint_as_float(r[0]) + __uint_as_float(r[1]); }
DI float x32_max(float v) { const unsigned x = __float_as_uint(v); const u32v2_t r = __builtin_amdgcn_permlane32_swap(x, x, false, false); return fmaxf(__uint_as_float(r[0]), __uint_as_float(r[1])); }
DI int x16_sum_i(int v) { const u32v2_t r = __builtin_amdgcn_permlane16_swap((unsigned)v, (unsigned)v, false, false); return (int)(r[0] + r[1]); }
DI int x32_sum_i(int v) { const u32v2_t r = __builtin_amdgcn_permlane32_swap((unsigned)v, (unsigned)v, false, false); return (int)(r[0] + r[1]); }
DI float wave_sum(float v) { return x32_sum(x16_sum(row16_sum(v))); }
DI int wave_sum_i(int v) { return x32_sum_i(x16_sum_i(row16_sum_i(v))); }
DI int tid_opaque() { int t = threadIdx.x; asm volatile("" : "+v"(t)); return t; }
#define LDS_WAIT() asm volatile("s_waitcnt lgkmcnt(0)" ::: "memory")
#define VM_WAIT() asm volatile("s_waitcnt vmcnt(0)" ::: "memory")
#define RLX_AGENT __ATOMIC_RELAXED, __HIP_MEMORY_SCOPE_AGENT

#define XB_TMO      128
#define XB_XCNT(j)  (256  + 64 * (j))
#define XB_XSUB(j)  (1280 + 64 * (j))
#define XB_XGEN(j)  (2304 + 64 * (j))
#define XB_TOP      3328
#define XB_TOPGEN   3392
#define XCD_BAR_WORDS 3456
#define XB_SPIN_CAP (1u << 18)
DI unsigned xb_ld(unsigned* p)              { return __hip_atomic_load(p, __ATOMIC_RELAXED, __HIP_MEMORY_SCOPE_AGENT); }
DI unsigned xb_add(unsigned* p, unsigned v) { return __hip_atomic_fetch_add(p, v, __ATOMIC_RELAXED, __HIP_MEMORY_SCOPE_AGENT); }
DI unsigned xb_xcc_id() { return (unsigned)__builtin_amdgcn_s_getreg((3 << 11) | 20) & 0xFu; }
#define XB_SPIN(cond, bar) do { unsigned _sp = 0; while (cond) { __builtin_amdgcn_s_sleep(1); \
    if ((++_sp & 255u) == 0u) { if (xb_ld(&(bar)[XB_TMO])) break; if (_sp > XB_SPIN_CAP) { atomicAdd(&(bar)[XB_TMO], 1u); break; } } } } while (0)
struct XcdBarrier { unsigned* bar; unsigned x; volatile LAS unsigned* st; };
DI XcdBarrier xcd_barrier_post(unsigned* bar, volatile LAS unsigned* st) {
    XcdBarrier b; b.bar = bar; b.x = (unsigned)__builtin_amdgcn_readfirstlane((int)xb_xcc_id()); b.st = st;
    if (threadIdx.x == 0) (void)xb_add(&bar[XB_XCNT(b.x)], 1u);
    return b;
}
DI void xcd_barrier_complete(unsigned* bar, unsigned x, unsigned& nloc, unsigned& nx) {
    const unsigned G = gridDim.x * gridDim.y * gridDim.z;
    unsigned sum, cnt, mine, sp = 0u;
    for (;;) {
        sum = 0u; cnt = 0u; mine = 0u;
#pragma unroll
        for (unsigned j = 0; j < 16; ++j) { const unsigned c = xb_ld(&bar[XB_XCNT(j)]); sum += c; cnt += (c > 0u) ? 1u : 0u; mine = (j == x) ? c : mine; }
        if (sum == G) break;
        __builtin_amdgcn_s_sleep(1);
        if ((++sp & 255u) == 0u) { if (xb_ld(&bar[XB_TMO])) break; if (sp > XB_SPIN_CAP) { atomicAdd(&bar[XB_TMO], 1u); break; } }
    }
    nloc = mine > 0u ? mine : 1u; nx = cnt > 0u ? cnt : 1u;
}
DI void xcd_barrier(const XcdBarrier& b) {
    asm volatile("s_waitcnt vmcnt(0)" ::: "memory");
    __syncthreads();
    if (threadIdx.x == 0) {
        unsigned* bar = b.bar;
        __builtin_amdgcn_s_waitcnt(0);
        unsigned bx = b.x; asm volatile("" : "+s"(bx));
        unsigned nloc = b.st[0], nx = b.st[1];
        if (nloc == 0u) { xcd_barrier_complete(bar, bx, nloc, nx); b.st[0] = nloc; b.st[1] = nx; }
        const unsigned old = xb_add(&bar[XB_XSUB(bx)], 1u);
        const unsigned gen = old / nloc;
        if (old + 1u == (gen + 1u) * nloc) {
            __builtin_amdgcn_fence(__ATOMIC_RELEASE, "agent");
            asm volatile("s_waitcnt vmcnt(0)" ::: "memory");
            const unsigned og = xb_add(&bar[XB_TOP], 1u);
            const unsigned tg = og / nx;
            if (og + 1u == (tg + 1u) * nx) xb_add(&bar[XB_TOPGEN], 1u);
            else XB_SPIN(xb_ld(&bar[XB_TOPGEN]) == tg, bar);
            __builtin_amdgcn_fence(__ATOMIC_ACQUIRE, "agent");
            xb_add(&bar[XB_XGEN(bx)], 1u);
            asm volatile("s_waitcnt vmcnt(0)" ::: "memory");
        } else {
            XB_SPIN(xb_ld(&bar[XB_XGEN(bx)]) == gen, bar);
            __builtin_amdgcn_fence(__ATOMIC_ACQUIRE, "agent");
            asm volatile("s_waitcnt vmcnt(0)" ::: "memory");
        }
    }
    __syncthreads();
}

#ifndef FP8_MMA
#define FP8_MMA 3
#endif
#ifndef EPI_TWICE
#define EPI_TWICE 0
#endif
namespace pg8 {
constexpr int BM = 256, BK = 64, HALF = 128, HTB = HALF * BK * 2, STAGE_BYTES = 8 * HTB, NXCD = 8, WGM = 8;
__host__ __device__ __forceinline__ int lds_byte(int r, int c) { const int st = (r >> 4) * 2 + (c >> 5), rr = r & 15, cc = c & 31, ob = rr * 64 + cc * 2; return st * 1024 + (ob ^ (((ob >> 9) & 1) << 5)); }
__host__ __device__ __forceinline__ void stage_rc(int b, int& R, int& C) { const int st = b / 1024, sb = b % 1024, swz = sb ^ (((sb >> 9) & 1) << 5); R = (st >> 1) * 16 + swz / 64; C = (st & 1) * 32 + (swz % 64) / 2; }
__host__ __device__ __forceinline__ int perm32(int rho) { const int n = rho >> 4, i = rho & 15; return 8 * (i >> 2) + 4 * n + (i & 3); }

struct Unit { int pm, pn, e; };
struct Gemm { const bf16_t* A; const bf16_t* Bt; const int* rowidx; };

template <int NN, int MSTRIDE, bool REV = false>
struct GroupedOrder {
    int nM, nwg, G, c;
    __device__ void init(int nM_, int ngroups, int G_, int c_) { nM = nM_; nwg = nM_ * NN * ngroups; G = G_; c = c_; }
    __device__ bool next(int i, Unit& u) const {
        const int L = i * G + c; if (L >= nwg) return false;
        int wgid = L; { const int q = nwg / NXCD, r = nwg % NXCD, xcd = wgid % NXCD; int off = wgid / NXCD; if (REV) off = (xcd < r ? q : q - 1) - off;
            wgid = (xcd < r ? xcd * (q + 1) : r * (q + 1) + (xcd - r) * q) + off; }
        const int per = nM * NN, e = wgid / per, rr = wgid % per;
        constexpr int nig = WGM * NN; const int gid = rr / nig, fm = gid * WGM, gsz = (nM - fm) < WGM ? (nM - fm) : WGM;
        u.pm = e * MSTRIDE + fm + ((rr % nig) % gsz); u.pn = (rr % nig) / gsz; u.e = e; return true;
    }
};

typedef int v8i_t __attribute__((ext_vector_type(8)));
typedef int v4i_t __attribute__((ext_vector_type(4)));
typedef long v2l_t __attribute__((ext_vector_type(2)));
DI const char* sptr(const char* p) {
    const unsigned long long v = (unsigned long long)p; const unsigned lo = (unsigned)__builtin_amdgcn_readfirstlane((int)(unsigned)v), hi = (unsigned)__builtin_amdgcn_readfirstlane((int)(unsigned)(v >> 32));
    return (const char*)(((unsigned long long)hi << 32) | lo); }
DI v8i_t ld32(const LAS unsigned char* p0, const LAS unsigned char* p1) {
    const v4i_t a = *(const LAS v4i_t*)p0, b = *(const LAS v4i_t*)p1; return __builtin_shufflevector(a, b, 0, 1, 2, 3, 4, 5, 6, 7); }
DI f32x4 mma_fp8(const v8i_t X, const v8i_t Y, f32x4 c, const int sc) {
#if FP8_MMA == 3
    asm volatile("v_mfma_scale_f32_16x16x128_f8f6f4 %0, %1, %2, %0, %3, %3 op_sel_hi:[0,0,0]" : "+v"(c) : "v"(X), "v"(Y), "v"(sc));
    return c;
#elif FP8_MMA == 2
    return __builtin_amdgcn_mfma_scale_f32_16x16x128_f8f6f4(X, Y, c, 0, 0, 0, 0x7F7F7F7F, 0, 0x7F7F7F7F);
#else
    const v4i_t xl = __builtin_shufflevector(X, X, 0, 1, 2, 3), xh = __builtin_shufflevector(X, X, 4, 5, 6, 7), yl = __builtin_shufflevector(Y, Y, 0, 1, 2, 3), yh = __builtin_shufflevector(Y, Y, 4, 5, 6, 7);
    const v2l_t x0 = __builtin_bit_cast(v2l_t, xl), x1 = __builtin_bit_cast(v2l_t, xh), y0 = __builtin_bit_cast(v2l_t, yl), y1 = __builtin_bit_cast(v2l_t, yh);
    c = __builtin_amdgcn_mfma_f32_16x16x32_fp8_fp8(x0[0], y0[0], c, 0, 0, 0); c = __builtin_amdgcn_mfma_f32_16x16x32_fp8_fp8(x0[1], y0[1], c, 0, 0, 0);
    c = __builtin_amdgcn_mfma_f32_16x16x32_fp8_fp8(x1[0], y1[0], c, 0, 0, 0); c = __builtin_amdgcn_mfma_f32_16x16x32_fp8_fp8(x1[1], y1[1], c, 0, 0, 0);
    return c;
#endif
}
DI unsigned cvt_pk_bf16(float lo, float hi) { unsigned r; asm volatile("v_cvt_pk_bf16_f32 %0, %1, %2" : "=v"(r) : "v"(lo), "v"(hi)); return r; }

template <class Epi, class Sched, bool GATHER, int K, size_t BSTRIDE, int STAG = 0, bool ALIGN = true, int ESZ = 2, bool ROTK = false, int ABL = 0>
DI void gemm_phase(LAS unsigned char* lds, const Gemm g, const Sched& S, const Epi& E) {
    if constexpr (STAG > 0) { const int ng = (int)((blockIdx.x * 5u) & 7u); for (int i = 0; i < ng; ++i) __builtin_amdgcn_s_sleep(STAG); }
    const int tid = tid_opaque(), wid = __builtin_amdgcn_readfirstlane(tid >> 6), lane = tid & 63, wr = wid >> 2, wc = wid & 3, fr = lane & 15, fq = lane >> 4;
    constexpr int RB = K * ESZ, nt = RB / 128;
    int fp8sc = 0x7F7F7F7F; asm volatile("" : "+v"(fp8sc));
    unsigned voffA[2], voffB[2];
#pragma unroll
    for (int i = 0; i < 2; ++i) { int R, C; stage_rc(tid * 16 + i * 8192, R, C); const int Rb = Epi::PERM ? ((R & ~31) + perm32(R & 31)) : R;
        voffA[i] = (unsigned)(R * RB + C * 2); voffB[i] = (unsigned)(Rb * RB + C * 2); }
    constexpr size_t kstep = (size_t)(BK * 2);
    constexpr size_t hstep = (size_t)HALF * RB;
    constexpr size_t tstep = 2 * hstep;
    const unsigned ldsw = (unsigned)wid * 1024u;
    const int aoff = lds_byte(wr * 64 + fr, fq * 8), boff = lds_byte(wc * 32 + fr, fq * 8);
#define PG8_SA(b, h) (((b) * 2 + (h)) * HTB)
#define PG8_SB(b, h) ((4 + (b) * 2 + (h)) * HTB)
#define PG8_STAGE(bufoff, gbase, voff) do { if constexpr (ABL & 1) break; const char* _gb = sptr((const char*)(gbase)); _Pragma("unroll") for (int _i = 0; _i < 2; ++_i) \
        __builtin_amdgcn_global_load_lds((const unsigned*)(_gb + (voff)[_i]), (LAS unsigned*)(lds + (bufoff) + ldsw + _i * 8192), 16, 0, 0); } while (0)
#define PG8_STAGE_AC(bufoff, kb, h) do { if constexpr (GATHER) PG8_STAGE(bufoff, Ab + (kb), cOff[h]); else PG8_STAGE(bufoff, cA + (h) * hstep + (kb), voffA); } while (0)
#define PG8_STAGE_AN(bufoff, kb, h) do { if constexpr (GATHER) { if (last) PG8_STAGE(bufoff, Ab + (kb), nOff[h]); else PG8_STAGE(bufoff, Ab + (kb), cOff[h]); } \
        else PG8_STAGE(bufoff, (last ? nA : cA) + (h) * hstep + (kb), voffA); } while (0)
#define PG8_LDA(dst, b, h) do { if constexpr ((ABL & 4) || (ABL & 32)) break; if constexpr (ESZ == 2) { _Pragma("unroll") for (int m = 0; m < 4; ++m) _Pragma("unroll") for (int k = 0; k < 2; ++k) dst[m][k] = *(const LAS bf16x8*)(lds + PG8_SA(b, h) + aoff + m * 2048 + k * 1024); } \
        else { _Pragma("unroll") for (int m = 0; m < 4; ++m) dst##8[m] = ld32(lds + PG8_SA(b, h) + aoff + m * 2048, lds + PG8_SA(b, h) + aoff + m * 2048 + 1024); } } while (0)
#define PG8_LDB(dst, b, h) do { if constexpr ((ABL & 4) || (ABL & 16)) break; if constexpr (ESZ == 2) { _Pragma("unroll") for (int n = 0; n < 2; ++n) _Pragma("unroll") for (int k = 0; k < 2; ++k) dst[n][k] = *(const LAS bf16x8*)(lds + PG8_SB(b, h) + boff + n * 2048 + k * 1024); } \
        else { _Pragma("unroll") for (int n = 0; n < 2; ++n) dst##8[n] = ld32(lds + PG8_SB(b, h) + boff + n * 2048, lds + PG8_SB(b, h) + boff + n * 2048 + 1024); } } while (0)
#define PG8_MMA(ai, bj, At, Bt) do { if constexpr (ABL & 2) break; if constexpr (!(ABL & 64)) __builtin_amdgcn_s_setprio(1); _Pragma("unroll") for (int m = 0; m < 4; ++m) _Pragma("unroll") for (int n = 0; n < 2; ++n) { \
        if constexpr (ESZ == 2) { _Pragma("unroll") for (int k = 0; k < 2; ++k) acc[ai][bj][m][n] = __builtin_amdgcn_mfma_f32_16x16x32_bf16(Bt[n][k], At[m][k], acc[ai][bj][m][n], 0, 0, 0); } \
        else acc[ai][bj][m][n] = mma_fp8(Bt##8[n], At##8[m], acc[ai][bj][m][n], fp8sc); } if constexpr (!(ABL & 64)) __builtin_amdgcn_s_setprio(0); } while (0)
#define PG8_WAIT_V(n) asm volatile("s_waitcnt vmcnt(" #n ")" ::: "memory")
#define PG8_WAIT_L(n) asm volatile("s_waitcnt lgkmcnt(" #n ")" ::: "memory")
#define PG8_BAR __builtin_amdgcn_s_barrier()
#define PG8_SCHED __builtin_amdgcn_sched_barrier(0)
#define PG8_AOFF(dst, u) do { int _t = threadIdx.x; asm volatile("" : "+v"(_t)); _Pragma("unroll") for (int _h = 0; _h < 2; ++_h) _Pragma("unroll") for (int _i = 0; _i < 2; ++_i) { int _R, _C; stage_rc(_t * 16 + _i * 8192, _R, _C); \
        const int _row = g.rowidx[(u).pm * BM + _h * HALF + _R]; dst[_h][_i] = (unsigned)_row * (unsigned)RB + (unsigned)_C * 2u; } } while (0)
    Unit cur, nxt; int ui = 0;
    if (!S.next(0, cur)) return;
#define PG8_KOFF(s_, i_) ((size_t)(ROTK ? (((s_) + (i_)) & (nt - 1)) : (i_)) * kstep)
    int rs_c = ROTK ? __builtin_amdgcn_readfirstlane((cur.pm + 2 * cur.pn) & 7) : 0, rs_n = 0; (void)rs_n;
    f32x4 acc[2][2][4][2];
#pragma unroll
    for (int a = 0; a < 2; ++a)
#pragma unroll
        for (int b = 0; b < 2; ++b)
#pragma unroll
            for (int m = 0; m < 4; ++m)
#pragma unroll
                for (int n = 0; n < 2; ++n) acc[a][b][m][n] = (f32x4){0.f, 0.f, 0.f, 0.f};
    bf16x8 At[4][2], B0[2][2], B1[2][2]; v8i_t At8[4], B08[2], B18[2]; (void)At; (void)B0; (void)B1; (void)At8; (void)B08; (void)B18;
    if constexpr (ABL & (4 | 16 | 32 | 128)) { for (int m = 0; m < 4; ++m) { At8[m] = (v8i_t){0, 0, 0, 0, 0, 0, 0, 0}; for (int k = 0; k < 2; ++k) At[m][k] = (bf16x8){0, 0, 0, 0, 0, 0, 0, 0}; } for (int n = 0; n < 2; ++n) { B08[n] = B18[n] = (v8i_t){0, 0, 0, 0, 0, 0, 0, 0}; for (int k = 0; k < 2; ++k) B0[n][k] = B1[n][k] = (bf16x8){0, 0, 0, 0, 0, 0, 0, 0}; } }
    unsigned cOff[2][2], nOff[2][2];
    const char* Ab = (const char*)g.A;
    const char* cA = Ab; const char* nA = Ab;
    if constexpr (GATHER) { PG8_AOFF(cOff, cur); } else { cA = Ab + (size_t)cur.pm * tstep; }
    const char* cB = (const char*)g.Bt + (size_t)cur.e * BSTRIDE + (size_t)cur.pn * tstep;
    { const size_t K0 = PG8_KOFF(rs_c, 0); PG8_STAGE(PG8_SB(0, 0), cB + K0, voffB); PG8_STAGE(PG8_SB(0, 1), cB + hstep + K0, voffB); PG8_STAGE_AC(PG8_SA(0, 0), K0, 0); PG8_STAGE_AC(PG8_SA(0, 1), K0, 1); }
    { const size_t K1 = PG8_KOFF(rs_c, 1); PG8_STAGE(PG8_SB(1, 0), cB + K1, voffB); PG8_STAGE_AC(PG8_SA(1, 0), K1, 0); PG8_STAGE(PG8_SB(1, 1), cB + hstep + K1, voffB); }
    if (wr == 1) PG8_BAR;
    PG8_WAIT_V(8); PG8_BAR;
    PG8_WAIT_V(6); PG8_BAR;
    for (;;) {
        const bool has_next = S.next(ui + 1, nxt);
        const char* nB = has_next ? (const char*)g.Bt + (size_t)nxt.e * BSTRIDE + (size_t)nxt.pn * tstep : cB;
        if constexpr (GATHER) {
            if (has_next) { PG8_AOFF(nOff, nxt); }
            else {
#pragma unroll
                for (int h = 0; h < 2; ++h)
#pragma unroll
                    for (int i = 0; i < 2; ++i) nOff[h][i] = cOff[h][i];
            }
        } else nA = has_next ? Ab + (size_t)nxt.pm * tstep : cA;
        if constexpr (ROTK) rs_n = has_next ? __builtin_amdgcn_readfirstlane((nxt.pm + 2 * nxt.pn) & 7) : rs_c;
#pragma unroll 1
        for (int t = 0; t < nt; t += 2) {
            const bool last = (t == nt - 2);
            const size_t k1 = PG8_KOFF(rs_c, t + 1), k2 = last ? PG8_KOFF(rs_n, 0) : PG8_KOFF(rs_c, t + 2), k3 = last ? PG8_KOFF(rs_n, 1) : PG8_KOFF(rs_c, t + 3);
            const char* b2 = (last ? nB : cB) + k2; const char* b3 = (last ? nB : cB) + k3;
            PG8_LDB(B0, 0, 0); if constexpr (!(ABL & 128)) PG8_LDB(B1, 0, 1); PG8_SCHED; PG8_LDA(At, 0, 0); PG8_STAGE_AC(PG8_SA(1, 1), k1, 1);
            PG8_WAIT_V(8); PG8_WAIT_L(0); PG8_BAR; PG8_MMA(0, 0, At, B0); PG8_MMA(0, 1, At, B1); PG8_BAR; PG8_SCHED;
            PG8_LDA(At, 0, 1); PG8_STAGE(PG8_SB(0, 0), b2, voffB); PG8_STAGE(PG8_SB(0, 1), b2 + hstep, voffB); PG8_STAGE_AN(PG8_SA(0, 0), k2, 0);
            PG8_WAIT_V(8); PG8_WAIT_L(0); PG8_BAR; PG8_MMA(1, 0, At, B0); PG8_MMA(1, 1, At, B1); PG8_BAR; PG8_SCHED;
            PG8_LDB(B0, 1, 0); if constexpr (!(ABL & 128)) PG8_LDB(B1, 1, 1); PG8_SCHED; PG8_LDA(At, 1, 0); PG8_STAGE_AN(PG8_SA(0, 1), k2, 1);
            PG8_WAIT_V(8); PG8_WAIT_L(0); PG8_BAR; PG8_MMA(0, 0, At, B0); PG8_MMA(0, 1, At, B1); PG8_BAR; PG8_SCHED;
            PG8_LDA(At, 1, 1); PG8_STAGE(PG8_SB(1, 0), b3, voffB); PG8_STAGE(PG8_SB(1, 1), b3 + hstep, voffB); PG8_STAGE_AN(PG8_SA(1, 0), k3, 0);
            PG8_WAIT_V(8); PG8_WAIT_L(0); PG8_BAR; PG8_MMA(1, 0, At, B0); PG8_MMA(1, 1, At, B1); PG8_BAR; PG8_SCHED;
        }
        if constexpr (ESZ == 1 && FP8_MMA == 3) asm volatile("s_nop 15\n\ts_nop 15\n\ts_nop 15" ::: "memory");
        if constexpr (ALIGN) { if (wr == 0) PG8_BAR; }
        if constexpr (!(ABL & 8)) E(acc, cur, wr, wc, fr, fq);
        if constexpr (GATHER) { if (EPI_TWICE) { asm volatile("" ::: "memory"); E(acc, cur, wr, wc, fr, fq); } }
        if (!has_next) break;
#pragma unroll
        for (int a = 0; a < 2; ++a)
#pragma unroll
            for (int b = 0; b < 2; ++b)
#pragma unroll
                for (int m = 0; m < 4; ++m)
#pragma unroll
                    for (int n = 0; n < 2; ++n) acc[a][b][m][n] = (f32x4){0.f, 0.f, 0.f, 0.f};
        cur = nxt; cB = nB; cA = nA; ++ui; if constexpr (ROTK) rs_c = rs_n;
        if constexpr (GATHER) {
#pragma unroll
            for (int h = 0; h < 2; ++h)
#pragma unroll
                for (int i = 0; i < 2; ++i) cOff[h][i] = nOff[h][i];
        }
        if constexpr (ALIGN) { if (wr == 1) PG8_BAR; }
    }
    PG8_WAIT_V(0);
    if constexpr (!ALIGN) { if (wr == 0) PG8_BAR; }
    PG8_BAR;
#undef PG8_SA
#undef PG8_SB
#undef PG8_STAGE
#undef PG8_STAGE_AC
#undef PG8_STAGE_AN
#undef PG8_LDA
#undef PG8_LDB
#undef PG8_MMA
#undef PG8_WAIT_V
#undef PG8_WAIT_L
#undef PG8_BAR
#undef PG8_SCHED
#undef PG8_AOFF
#undef PG8_KOFF
}
}

using pg8::Unit;
DI f32x2 gelu_tanh2(f32x2 x) {
    constexpr float K0 = -2.0f * 0.7978845608028654f * LOG2E, K1 = K0 * 0.044715f;
    const f32x2 t = x * ((x * x) * K1 + K0);
    f32x2 e; e.x = __builtin_amdgcn_exp2f(t.x); e.y = __builtin_amdgcn_exp2f(t.y);
    const f32x2 d = e + 1.0f;
    f32x2 rinv; rinv.x = __builtin_amdgcn_rcpf(d.x); rinv.y = __builtin_amdgcn_rcpf(d.y);
    return x * rinv;
}
DI f32x4 gelu_tanh4(f32x4 v) { const f32x2 a = gelu_tanh2((f32x2){v[0], v[1]}), b = gelu_tanh2((f32x2){v[2], v[3]}); return (f32x4){a.x, a.y, b.x, b.y}; }
DI f32x2 silu_mul2(f32x2 a, f32x2 b) {
    const f32x2 t = a * (-LOG2E);
    f32x2 e; e.x = __builtin_amdgcn_exp2f(t.x); e.y = __builtin_amdgcn_exp2f(t.y);
    const f32x2 d = e + 1.0f;
    f32x2 rinv; rinv.x = __builtin_amdgcn_rcpf(d.x); rinv.y = __builtin_amdgcn_rcpf(d.y);
    return (a * b) * rinv;
}
struct EpiGeluUV {
    static constexpr bool PERM = true;
    bf16_t* U; bf16_t* V; const float* bias; float* stats; LAS unsigned char* xl;
    DI void operator()(const f32x4 (&acc)[2][2][4][2], const Unit& u, int wr, int wc, int fr_in, int fq_in) const {
        int fr = fr_in, fq = fq_in; asm volatile("" : "+v"(fr), "+v"(fq));
        const int row0 = u.pm * 256 + wr * 64 + fr; const bool isV = u.pn >= 8;
        bf16_t* base = isV ? V : U; const int col0 = (u.pn & 7) * 256 + wc * 32 + 8 * fq, bcol0 = u.pn * 256 + wc * 32 + 8 * fq;
        f32x4 bv[2][2];
#pragma unroll
        for (int bj = 0; bj < 2; ++bj)
#pragma unroll
            for (int n = 0; n < 2; ++n) bv[bj][n] = *(const f32x4*)(bias + bcol0 + bj * 128 + 4 * n);
#pragma unroll
        for (int ai = 0; ai < 2; ++ai)
#pragma unroll
            for (int m = 0; m < 4; ++m) { const int row = row0 + ai * 128 + m * 16; bf16_t* rowp = base + (size_t)row * 2048 + col0; float s = 0.f, q = 0.f;
#pragma unroll
                for (int bj = 0; bj < 2; ++bj) { const f32x4 v0 = gelu_tanh4(acc[ai][bj][m][0] + bv[bj][0]), v1 = gelu_tanh4(acc[ai][bj][m][1] + bv[bj][1]);
                    s += ((v0[0] + v0[1]) + (v0[2] + v0[3])) + ((v1[0] + v1[1]) + (v1[2] + v1[3]));
                    q += ((v0[0] * v0[0] + v0[1] * v0[1]) + (v0[2] * v0[2] + v0[3] * v0[3])) + ((v1[0] * v1[0] + v1[1] * v1[1]) + (v1[2] * v1[2] + v1[3] * v1[3]));
                    u32x4 w; w.x = pg8::cvt_pk_bf16(v0[0], v0[1]); w.y = pg8::cvt_pk_bf16(v0[2], v0[3]); w.z = pg8::cvt_pk_bf16(v1[0], v1[1]); w.w = pg8::cvt_pk_bf16(v1[2], v1[3]);
                    *(u32x4*)(rowp + bj * 128) = w; }
                if (isV) { s = x32_sum(x16_sum(s)); q = x32_sum(x16_sum(q));
                    if (fq == 0) *(LAS f32x2*)(xl + ((ai * 128 + wr * 64 + m * 16 + fr) * 4 + wc) * 8) = (f32x2){s, q}; }
                asm volatile("" ::: "memory"); }
        if (isV) {
            asm volatile("s_waitcnt lgkmcnt(0)" ::: "memory"); __builtin_amdgcn_s_barrier(); asm volatile("" ::: "memory");
            const int t = (wr * 4 + wc) * 64 + fq * 16 + fr;
            if (t < 256) { const f32x4 a = *(const LAS f32x4*)(xl + t * 32), b = *(const LAS f32x4*)(xl + t * 32 + 16);
                *(f32x2*)(stats + ((size_t)(u.pm * 256 + t) * 8 + (u.pn - 8)) * 2) = (f32x2){(a[0] + a[2]) + (b[0] + b[2]), (a[1] + a[3]) + (b[1] + b[3])}; }
        }
    }
};
struct EpiResAdd {
    static constexpr bool PERM = true;
    const bf16_t* X; bf16_t* Xo; const float* gate; float asc;
    DI void operator()(const f32x4 (&acc)[2][2][4][2], const Unit& u, int wr, int wc, int fr_in, int fq_in) const {
        int fr = fr_in, fq = fq_in; asm volatile("" : "+v"(fr), "+v"(fq));
        const int b = u.pm < 256 ? (u.pm >> 4) : 16;
        const int row0 = u.pm * 256 + wr * 64 + fr, col0 = u.pn * 256 + wc * 32 + 8 * fq;
        f32x4 gv[2][2];
#pragma unroll
        for (int bj = 0; bj < 2; ++bj)
#pragma unroll
            for (int n = 0; n < 2; ++n) gv[bj][n] = *(const f32x4*)(gate + (size_t)b * 6144 + col0 + bj * 128 + 4 * n) * asc;
#pragma unroll
        for (int ai = 0; ai < 2; ++ai) {
            u32x4 xv[4][2];
#pragma unroll
            for (int m = 0; m < 4; ++m)
#pragma unroll
                for (int bj = 0; bj < 2; ++bj) xv[m][bj] = *(const u32x4*)(X + (size_t)(row0 + ai * 128 + m * 16) * D + col0 + bj * 128);
#pragma unroll
            for (int m = 0; m < 4; ++m)
#pragma unroll
                for (int bj = 0; bj < 2; ++bj) { const u32x4 w = xv[m][bj]; const f32x4 a0 = acc[ai][bj][m][0] * gv[bj][0], a1 = acc[ai][bj][m][1] * gv[bj][1];
                    u32x4 o; o.x = pk2(bflo(w.x) + a0[0], bfhi(w.x) + a0[1]); o.y = pk2(bflo(w.y) + a0[2], bfhi(w.y) + a0[3]); o.z = pk2(bflo(w.z) + a1[0], bfhi(w.z) + a1[1]); o.w = pk2(bflo(w.w) + a1[2], bfhi(w.w) + a1[3]);
                    *(u32x4*)(Xo + (size_t)(row0 + ai * 128 + m * 16) * D + col0 + bj * 128) = o; }
            asm volatile("" ::: "memory"); }
    }
};
struct EpiQKV {
    static constexpr bool PERM = true;
    bf16_t *Q, *Kb, *Vb; const float* cosT; const float* sinT;
    DI void operator()(const f32x4 (&acc)[2][2][4][2], const Unit& u, int wr, int wc, int fr_in, int fq_in) const {
        int fr = fr_in, fq = fq_in; asm volatile("" : "+v"(fr), "+v"(fq));
        const int row0 = u.pm * 256 + wr * 64 + fr; const bool lat = u.pm < 256;
        const int cin = wc * 32 + 8 * fq, kk0 = 16 * (wc & 1) + 4 * fq;
        bf16_t* base; int ld; float sc; bool rope;
        constexpr float ws_ = FP8_ATT ? 1.0f / WM_SCALE : 1.0f;
        if (u.pn < 4) { base = Q + u.pn * 256 + cin; ld = 1024; sc = QSCALE * ws_; rope = lat; }
        else if (u.pn == 4) { base = Kb + cin; ld = 256; sc = ws_; rope = lat; }
        else { base = Vb + cin; ld = 256; sc = ws_; rope = false; }
#pragma unroll
        for (int ai = 0; ai < 2; ++ai) {
            f32x4 cs[4], sn[4];
#pragma unroll
            for (int m = 0; m < 4; ++m) { cs[m] = (f32x4){1.f, 1.f, 1.f, 1.f}; sn[m] = (f32x4){0.f, 0.f, 0.f, 0.f};
                if (rope) { const int t = (row0 + ai * 128 + m * 16) & 4095; cs[m] = *(const f32x4*)(cosT + t * 32 + kk0); sn[m] = *(const f32x4*)(sinT + t * 32 + kk0); } }
#pragma unroll
            for (int m = 0; m < 4; ++m) { const int row = row0 + ai * 128 + m * 16; bf16_t* rowp = base + (size_t)row * ld;
#pragma unroll
                for (int bj = 0; bj < 2; ++bj) { const f32x4 x1 = acc[ai][bj][m][0], x2 = acc[ai][bj][m][1];
                    const f32x4 o1 = (x1 * cs[m] - x2 * sn[m]) * sc, o2 = (x1 * sn[m] + x2 * cs[m]) * sc;
                    u32x4 w; w.x = pg8::cvt_pk_bf16(o1[0], o1[1]); w.y = pg8::cvt_pk_bf16(o1[2], o1[3]); w.z = pg8::cvt_pk_bf16(o2[0], o2[1]); w.w = pg8::cvt_pk_bf16(o2[2], o2[3]);
                    *(u32x4*)(rowp + bj * 128) = w; } }
            asm volatile("" ::: "memory"); }
    }
};
struct EpiSwiGLU {
    static constexpr bool PERM = true; static constexpr int NST = 0;
    unsigned char* Hm;
    DI void operator()(const f32x4 (&acc)[2][2][4][2], const Unit& u, int wr, int wc, int fr_in, int fq_in) const {
        int fr = fr_in, fq = fq_in; asm volatile("" : "+v"(fr), "+v"(fq));
        const int row0 = u.pm * 256 + wr * 64 + fr, col0 = u.pn * 128 + wc * 32 + 8 * fq;
        constexpr float is = 1.0f / W13_SCALE;
#pragma unroll
        for (int ai = 0; ai < 2; ++ai)
#pragma unroll
            for (int m = 0; m < 4; ++m) { unsigned char* rowp = Hm + (size_t)(row0 + ai * 128 + m * 16) * 2048 + col0;
                const f32x4 a0 = acc[ai][0][m][0] * is, a1 = acc[ai][0][m][1] * is, b0 = acc[ai][1][m][0] * is, b1 = acc[ai][1][m][1] * is;
                const f32x2 h0 = silu_mul2((f32x2){a0[0], a0[1]}, (f32x2){b0[0], b0[1]}), h1 = silu_mul2((f32x2){a0[2], a0[3]}, (f32x2){b0[2], b0[3]});
                const f32x2 h2 = silu_mul2((f32x2){a1[0], a1[1]}, (f32x2){b1[0], b1[1]}), h3 = silu_mul2((f32x2){a1[2], a1[3]}, (f32x2){b1[2], b1[3]});
                u32x2 w; w.x = pk4_fp8(h0.x, h0.y, h1.x, h1.y); w.y = pk4_fp8(h2.x, h2.y, h3.x, h3.y);
                *(u32x2*)rowp = w; }
    }
};
struct EpiGateY {
    static constexpr bool PERM = true;
    unsigned char* Y; const float* gate;
    DI void operator()(const f32x4 (&acc)[2][2][4][2], const Unit& u, int wr, int wc, int fr_in, int fq_in) const {
        int fr = fr_in, fq = fq_in; asm volatile("" : "+v"(fr), "+v"(fq));
        const int row0 = u.pm * 256 + wr * 64 + fr, col0 = u.pn * 256 + wc * 32 + 8 * fq;
        float gts[2][4];
#pragma unroll
        for (int ai = 0; ai < 2; ++ai)
#pragma unroll
            for (int m = 0; m < 4; ++m) gts[ai][m] = gate[row0 + ai * 128 + m * 16] * (Y_SCALE / W2_SCALE);
#pragma unroll
        for (int ai = 0; ai < 2; ++ai)
#pragma unroll
            for (int m = 0; m < 4; ++m) { const int row = row0 + ai * 128 + m * 16; const float gt = gts[ai][m]; unsigned char* rowp = Y + (size_t)row * 1024 + col0;
#pragma unroll
                for (int bj = 0; bj < 2; ++bj) { const f32x4 v0 = acc[ai][bj][m][0] * gt, v1 = acc[ai][bj][m][1] * gt;
                    u32x2 w; w.x = pk4_fp8(v0[0], v0[1], v0[2], v0[3]); w.y = pk4_fp8(v1[0], v1[1], v1[2], v1[3]);
                    *(u32x2*)(rowp + bj * 128) = w; }
                asm volatile("" ::: "memory"); }
    }
};

DI void p0_mod(LAS unsigned char* lds, const float* c, const float* c_ctx, const float* w_mod, const float* b_mod, float* mod, int bid, int G) {
    LAS float* S = (LAS float*)lds;
    LAS float* P = (LAS float*)(lds + 17 * 1024 * 4);
    const int tid = tid_opaque(), wave = tid >> 6, lane = tid & 63;
    for (int i = tid; i < 17 * 1024; i += 512) { const int r = i >> 10, k = i & 1023; const float v = r < 16 ? c[r * 1024 + k] : c_ctx[k]; S[i] = v / (1.0f + __expf(-v)); }
    __syncthreads();
    for (int item = bid; item < 4 * 96; item += G) {
        const int l = item / 96, nb = item % 96;
        const float* w = w_mod + ((size_t)l * 1024 + wave * 128) * 6144 + nb * 64 + lane;
        float acc[17];
#pragma unroll
        for (int r = 0; r < 17; ++r) acc[r] = 0.f;
        for (int k4 = 0; k4 < 128; k4 += 4) {
            const float w0 = w[(size_t)(k4 + 0) * 6144], w1 = w[(size_t)(k4 + 1) * 6144], w2 = w[(size_t)(k4 + 2) * 6144], w3 = w[(size_t)(k4 + 3) * 6144];
#pragma unroll
            for (int r = 0; r < 17; ++r) { const f32x4 s = *(const LAS f32x4*)(S + r * 1024 + wave * 128 + k4); acc[r] += (s[0] * w0 + s[1] * w1) + (s[2] * w2 + s[3] * w3); }
        }
#pragma unroll
        for (int r = 0; r < 17; ++r) P[(wave * 17 + r) * 64 + lane] = acc[r];
        __syncthreads();
        for (int o = tid; o < 17 * 64; o += 512) { const int r = o >> 6, nn = o & 63; float s = 0.f;
#pragma unroll
            for (int w8 = 0; w8 < 8; ++w8) s += P[(w8 * 17 + r) * 64 + nn];
            mod[((size_t)l * 17 + r) * 6144 + nb * 64 + nn] = s + b_mod[l * 6144 + nb * 64 + nn]; }
        __syncthreads();
    }
}
DI int qk_phys(int d) { return 8 * ((d & 31) >> 2) + (d & 3) + 4 * (d >> 5); }
DI void cvt_item(const float* src, int ldsrc, int K, bf16_t* dst, int k0, int nsrc0, int ndst0, bool perm, LAS unsigned char* Lt, int lane, bool s8 = false) {
    const int kr = lane >> 4, nq = lane & 15;
    f32x4 v[16];
#pragma unroll
    for (int q = 0; q < 16; ++q) v[q] = *(const f32x4*)(src + (size_t)(k0 + 4 * q + kr) * ldsrc + nsrc0 + 4 * nq);
    int prow[4];
#pragma unroll
    for (int i = 0; i < 4; ++i) { const int n = 4 * nq + i; prow[i] = (perm ? qk_phys(n) : n) * 132; }
#pragma unroll
    for (int q = 0; q < 16; ++q) { const int k = 4 * q + kr; if (FP8D_SIM) { for (int i = 0; i < 4; ++i) v[q][i] = sim8(v[q][i] * 32.0f, s8) * (1.0f / 32.0f); } const unsigned w01 = pk2(v[q][0], v[q][1]), w23 = pk2(v[q][2], v[q][3]);
        *(LAS unsigned short*)(Lt + prow[0] + k * 2) = (unsigned short)(w01 & 0xffffu); *(LAS unsigned short*)(Lt + prow[1] + k * 2) = (unsigned short)(w01 >> 16);
        *(LAS unsigned short*)(Lt + prow[2] + k * 2) = (unsigned short)(w23 & 0xffffu); *(LAS unsigned short*)(Lt + prow[3] + k * 2) = (unsigned short)(w23 >> 16); }
    LDS_WAIT();
    const int c = lane & 7;
#pragma unroll
    for (int j = 0; j < 8; ++j) { const int n = (lane >> 3) + 8 * j; const LAS unsigned* s = (const LAS unsigned*)(Lt + n * 132 + 16 * c);
        u32x4 o; o.x = s[0]; o.y = s[1]; o.z = s[2]; o.w = s[3];
        *(u32x4*)(dst + (size_t)(ndst0 + n) * K + k0 + 8 * c) = o; }
    LDS_WAIT();
}
struct P0Args { const float *w_in, *w_out, *w_qkv, *w_o, *w1, *w3, *w2, *w_s; bf16_t *win_t, *wout_t, *wqkv_t, *wo_t, *w13_t, *w2_t, *ws_t; float* cosT; float* sinT; };
constexpr int EXP_ITEMS = 3 * 8192, STEAL_CHUNK = 16, STEAL_NCHUNKS = EXP_ITEMS / STEAL_CHUNK;
DI void cvt_item8(const float* src, int ldsrc, int K, unsigned char* dst, int k0, int nsrc0, int ndst0, float scale, LAS unsigned char* Lt, int lane, bool perm = false) {
    const int kr = lane >> 4, nq = lane & 15;
    f32x4 v[16];
#pragma unroll
    for (int q = 0; q < 16; ++q) v[q] = *(const f32x4*)(src + (size_t)(k0 + 4 * q + kr) * ldsrc + nsrc0 + 4 * nq);
#pragma unroll
    for (int q = 0; q < 16; ++q) { const int k = 4 * q + kr; const unsigned p = pk4_fp8(v[q][0] * scale, v[q][1] * scale, v[q][2] * scale, v[q][3] * scale);
        LAS unsigned char* b = Lt + (perm ? 8 * (nq & 7) + 4 * (nq >> 3) : 4 * nq) * 68 + k;
        b[0] = (unsigned char)(p & 0xffu); b[68] = (unsigned char)((p >> 8) & 0xffu); b[136] = (unsigned char)((p >> 16) & 0xffu); b[204] = (unsigned char)(p >> 24); }
    LDS_WAIT();
    const int c = lane & 3;
#pragma unroll
    for (int j = 0; j < 4; ++j) { const int n = (lane >> 2) + 16 * j; const LAS unsigned* sp = (const LAS unsigned*)(Lt + n * 68 + 16 * c);
        u32x4 o; o.x = sp[0]; o.y = sp[1]; o.z = sp[2]; o.w = sp[3];
        *(u32x4*)(dst + (size_t)(ndst0 + n) * K + k0 + 16 * c) = o; }
    LDS_WAIT();
}
DI void cvt_expert_item(const P0Args& a, int layer, int it, LAS unsigned char* Lt, int lane) {
    const int which = it >> 13, r = it & 8191, e = r >> 9, q = r & 511; const size_t le = (size_t)layer * 16 + e;
    if (which < 2) { const int kb = q >> 5, nb = q & 31; const int ndst = ((nb * 64) >> 7) * 256 + ((nb * 64) & 127) + which * 128;
        cvt_item8((which ? a.w3 : a.w1) + le * 1024 * 2048, 2048, 1024, (unsigned char*)a.w13_t + le * 4096 * 1024, kb * 64, nb * 64, ndst, W13_SCALE, Lt, lane); }
    else { const int kb = q >> 4, nb = q & 15; cvt_item8(a.w2 + le * 2048 * 1024, 1024, 2048, (unsigned char*)a.w2_t + le * 1024 * 2048, kb * 64, nb * 64, nb * 64, W2_SCALE, Lt, lane); }
}
DI void steal_convert(LAS unsigned char* lds, unsigned* q, const P0Args& a, int layer, int max_chunks) {
    const int tid = tid_opaque(), wave = __builtin_amdgcn_readfirstlane(tid >> 6), lane = tid & 63;
    LAS unsigned* slot = (LAS unsigned*)(lds + 8 * 8448); LAS unsigned char* Lt = lds + wave * 8448;
    for (int n = 0; n < max_chunks; ++n) {
        __syncthreads();
        if (tid == 0) *slot = __hip_atomic_fetch_add(q, 1u, __ATOMIC_RELAXED, __HIP_MEMORY_SCOPE_AGENT);
        __syncthreads();
        const unsigned idx = *slot;
        if (idx >= (unsigned)STEAL_NCHUNKS) break;
#pragma unroll 1
        for (int k = 0; k < 2; ++k) cvt_expert_item(a, layer, (int)idx * STEAL_CHUNK + wave * 2 + k, Lt, lane);
    }
    __syncthreads();
}
DI void p0_convert(LAS unsigned char* lds, const P0Args& a, int gw, int NGW, int lane, int wave) {
    LAS unsigned char* Lt = lds + wave * 8448;
    constexpr int I_IN = 2 * 16 * 64, I_OUT = 2 * 32 * 16, I_QKV = 2 * 16 * 24, I_O = 2 * 16 * 16;
    constexpr int NITEMS = I_IN + I_OUT + I_QKV + I_O;
    for (int it = gw; it < NITEMS; it += NGW) {
        int r = it;
        if (r < I_IN) { const int j = r / 1024, q = r % 1024, kb = q / 64, nb = q % 64;
            cvt_item(a.w_in + (size_t)j * 1024 * 4096, 4096, 1024, a.win_t + (size_t)j * 4096 * 1024, kb * 64, nb * 64, nb * 64, false, Lt, lane, (FP8D_SIM & 1) != 0); continue; } r -= I_IN;
        if (r < I_OUT) { const int j = r / 512, q = r % 512, kb = q / 16, nb = q % 16;
            cvt_item(a.w_out + (size_t)j * 2048 * 1024, 1024, 2048, a.wout_t + (size_t)j * 1024 * 2048, kb * 64, nb * 64, nb * 64, false, Lt, lane, (FP8D_SIM & 4) != 0); continue; } r -= I_OUT;
        if (r < I_QKV) { const int j = r / 384, q = r % 384, kb = q / 24, nb = q % 24;
            if (FP8_ATT) cvt_item8(a.w_qkv + (size_t)j * 1024 * 1536, 1536, 1024, (unsigned char*)a.wqkv_t + (size_t)j * 1536 * 1024, kb * 64, nb * 64, nb * 64, WM_SCALE, Lt, lane, nb < 20);
            else cvt_item(a.w_qkv + (size_t)j * 1024 * 1536, 1536, 1024, a.wqkv_t + (size_t)j * 1536 * 1024, kb * 64, nb * 64, nb * 64, nb < 20, Lt, lane, (FP8D_SIM & 2) != 0);
            continue; } r -= I_QKV;
        if (r < I_O) { const int j = r / 256, q = r % 256, kb = q / 16, nb = q % 16;
            if (FP8_ATT) cvt_item8(a.w_o + (size_t)j * 1024 * 1024, 1024, 1024, (unsigned char*)a.wo_t + (size_t)j * 1024 * 1024, kb * 64, nb * 64, nb * 64, WM_SCALE, Lt, lane);
            else cvt_item(a.w_o + (size_t)j * 1024 * 1024, 1024, 1024, a.wo_t + (size_t)j * 1024 * 1024, kb * 64, nb * 64, nb * 64, false, Lt, lane, (FP8D_SIM & 2) != 0);
            continue; } r -= I_O;
    }
    const int gt = gw * 64 + lane, NT = NGW * 64;
    for (int i = gt; i < 2 * 16 * 128 * 128 / 8; i += NT) { const f32x4 x = *(const f32x4*)(a.w_s + (size_t)i * 8), y = *(const f32x4*)(a.w_s + (size_t)i * 8 + 4);
        u32x4 o; o.x = pk2(x[0], x[1]); o.y = pk2(x[2], x[3]); o.z = pk2(y[0], y[1]); o.w = pk2(y[2], y[3]); *(u32x4*)(a.ws_t + (size_t)i * 8) = o; }
    for (int i = gt; i < 4096 * 32; i += NT) { const int t = i >> 5, kk = i & 31; const int pos = kk < 16 ? (t >> 6) : (t & 63); const int j = kk & 15;
        const float inv = exp2f(-(float)j * (13.287712379549449f / 16.0f)); const float ang = (float)pos * inv; a.cosT[i] = cosf(ang); a.sinT[i] = sinf(ang); }
}

DI void unpack8(const u32x4 w, float (&v)[8]) { v[0] = bflo(w.x); v[1] = bfhi(w.x); v[2] = bflo(w.y); v[3] = bfhi(w.y); v[4] = bflo(w.z); v[5] = bfhi(w.z); v[6] = bflo(w.w); v[7] = bfhi(w.w); }
DI void unpack8_fp8(const u32x2 w, float (&v)[8]) { const f32x2 a = __builtin_amdgcn_cvt_pk_f32_fp8((int)w.x, false), b = __builtin_amdgcn_cvt_pk_f32_fp8((int)w.x, true), c = __builtin_amdgcn_cvt_pk_f32_fp8((int)w.y, false), d = __builtin_amdgcn_cvt_pk_f32_fp8((int)w.y, true);
    v[0] = a.x; v[1] = a.y; v[2] = b.x; v[3] = b.y; v[4] = c.x; v[5] = c.y; v[6] = d.x; v[7] = d.y; }
DI u32x4 pack8f(const float (&v)[8]) { u32x4 o; o.x = pk2(v[0], v[1]); o.y = pk2(v[2], v[3]); o.z = pk2(v[4], v[5]); o.w = pk2(v[6], v[7]); return o; }
DI void load8f(const float* p, float (&v)[8]) { const f32x4 a = *(const f32x4*)p, b = *(const f32x4*)(p + 4); v[0] = a[0]; v[1] = a[1]; v[2] = a[2]; v[3] = a[3]; v[4] = b[0]; v[5] = b[1]; v[6] = b[2]; v[7] = b[3]; }
DI void n0_phase(const float* xin, const float* cin, bf16_t* X, const float* mod_cur, const float* gmix, bf16_t* H, int gw, int NGW, int lane) {
    const int rpw = (MT + NGW - 1) / NGW; const int m0 = gw * rpw; const int m1 = (m0 + rpw) < MT ? (m0 + rpw) : MT;
    int bcur = -1; float av[2][8], shv[2][8];
#pragma unroll
    for (int j = 0; j < 2; ++j)
#pragma unroll
        for (int k = 0; k < 8; ++k) { av[j][k] = 0.f; shv[j][k] = 0.f; }
    f32x4 p0[4], p1[4];
#define N0_LOAD(dst, mm) do { const int _m = (mm); if (_m < m1) { const float* _s = (_m < ML ? xin + (size_t)_m * D : cin + (size_t)(_m - ML) * D) + 8 * lane; \
        dst[0] = *(const f32x4*)_s; dst[1] = *(const f32x4*)(_s + 4); dst[2] = *(const f32x4*)(_s + 512); dst[3] = *(const f32x4*)(_s + 516); } } while (0)
    N0_LOAD(p0, m0); N0_LOAD(p1, m0 + 1);
    for (int m = m0; m < m1; ++m) {
        const int b = m < ML ? (m >> 12) : 16;
        float v[2][8];
#pragma unroll
        for (int j = 0; j < 2; ++j)
#pragma unroll
            for (int k = 0; k < 4; ++k) { v[j][k] = p0[2 * j][k]; v[j][4 + k] = p0[2 * j + 1][k]; }
#pragma unroll
        for (int i = 0; i < 4; ++i) p0[i] = p1[i];
        N0_LOAD(p1, m + 2);
        if (b != bcur) { bcur = b;
#pragma unroll
            for (int j = 0; j < 2; ++j) { const int c = 8 * lane + 512 * j; float g8[8], s8[8]; load8f(gmix + c, g8); load8f(mod_cur + (size_t)b * 6144 + 1024 + c, s8); load8f(mod_cur + (size_t)b * 6144 + c, shv[j]);
#pragma unroll
                for (int k = 0; k < 8; ++k) av[j][k] = g8[k] * (s8[k] + 1.0f); } }
        float ss = 0.f;
#pragma unroll
        for (int j = 0; j < 2; ++j)
#pragma unroll
            for (int k = 0; k < 8; ++k) ss += v[j][k] * v[j][k];
        const float rstd = __builtin_amdgcn_rsqf(wave_sum(ss) * (1.0f / D) + EPS);
#pragma unroll
        for (int j = 0; j < 2; ++j) { const int c = 8 * lane + 512 * j; *(u32x4*)(X + (size_t)m * D + c) = pack8f(v[j]); float h[8];
#pragma unroll
            for (int k = 0; k < 8; ++k) h[k] = sim8(v[j][k] * rstd * av[j][k] + shv[j][k], (FP8D_SIM & 1) != 0);
            *(u32x4*)(H + (size_t)m * D + c) = pack8f(h); }
    }
#undef N0_LOAD
}
DI void n1_phase(int mode, int nrows, const bf16_t* X, bf16_t* Xo, float* out, const unsigned char* Y  , const int* tokslot, const float* mod_prev, const float* mod_cur, const float* gmix, bf16_t* H, int gw, int NGW, int lane, bool s8 = false, bool h8 = false) {
    const int rpw = (nrows + NGW - 1) / NGW; const int m0 = gw * rpw; const int m1 = (m0 + rpw) < nrows ? (m0 + rpw) : nrows;
    if (m0 >= m1) return;
    u32x4 xq[3][2]; int sq[3] = {-1, -1, -1};
#define N1_LOAD(qi, mm) do { const int _m = (mm); if (_m < m1) { xq[qi][0] = *(const u32x4*)(X + (size_t)_m * D + 8 * lane); xq[qi][1] = *(const u32x4*)(X + (size_t)_m * D + 8 * lane + 512); \
        sq[qi] = lane < 16 ? tokslot[(size_t)lane * MT + _m] : -1; } } while (0)
    N1_LOAD(0, m0); N1_LOAD(1, m0 + 1); N1_LOAD(2, m0 + 2);
    int bcur = -1; float g2v[2][8], av[2][8], shv[2][8];
#pragma unroll
    for (int j = 0; j < 2; ++j)
#pragma unroll
        for (int k = 0; k < 8; ++k) { g2v[j][k] = 0.f; av[j][k] = 0.f; shv[j][k] = 0.f; }
    int slotn = sq[0]; unsigned maskn = (unsigned)__builtin_amdgcn_ballot_w64(slotn >= 0) & 0xffffu; int sbn[4]; u32x2 yrn[4][2];
#define N1_GATHER() do { _Pragma("unroll") for (int i = 0; i < 4; ++i) { sbn[i] = -1; if (maskn) { const int e = __builtin_ctz(maskn); sbn[i] = __builtin_amdgcn_readlane(slotn, e); maskn &= maskn - 1u; } \
            const unsigned char* yp = Y + (size_t)(sbn[i] >= 0 ? sbn[i] : 0) * D + 8 * lane; yrn[i][0] = *(const u32x2*)yp; yrn[i][1] = *(const u32x2*)(yp + 512); } } while (0)
    N1_GATHER();
    for (int m = m0; m < m1; ++m) {
        float v[2][8];
        unpack8(xq[0][0], v[0]); unpack8(xq[0][1], v[1]);
        xq[0][0] = xq[1][0]; xq[0][1] = xq[1][1]; xq[1][0] = xq[2][0]; xq[1][1] = xq[2][1];
        const int slot = slotn; sq[0] = sq[1]; sq[1] = sq[2];
        const int b = m < ML ? (m >> 12) : 16;
        unsigned mask = maskn;
        int sb[4]; u32x2 yr[4][2];
#pragma unroll
        for (int i = 0; i < 4; ++i) { sb[i] = sbn[i]; yr[i][0] = yrn[i][0]; yr[i][1] = yrn[i][1]; }
        slotn = (m + 1 < m1) ? sq[0] : -1; maskn = (unsigned)__builtin_amdgcn_ballot_w64(slotn >= 0) & 0xffffu;
        N1_GATHER();
        N1_LOAD(2, m + 3);
        if (b != bcur) { bcur = b;
#pragma unroll
            for (int j = 0; j < 2; ++j) { const int c = 8 * lane + 512 * j; load8f(mod_prev + (size_t)b * 6144 + 5120 + c, g2v[j]);
#pragma unroll
                for (int k = 0; k < 8; ++k) g2v[j][k] *= (1.0f / Y_SCALE);
                if (mode == 1) { float g8[8], s8[8]; load8f(gmix + c, g8); load8f(mod_cur + (size_t)b * 6144 + 1024 + c, s8); load8f(mod_cur + (size_t)b * 6144 + c, shv[j]);
#pragma unroll
                    for (int k = 0; k < 8; ++k) av[j][k] = g8[k] * (s8[k] + 1.0f); }
                else load8f(gmix + c, av[j]); } }
        float a[2][8];
#pragma unroll
        for (int j = 0; j < 2; ++j)
#pragma unroll
            for (int k = 0; k < 8; ++k) a[j][k] = 0.f;
#pragma unroll
        for (int i = 0; i < 4; ++i) if (sb[i] >= 0) {
#pragma unroll
            for (int j = 0; j < 2; ++j) { float y[8]; unpack8_fp8(yr[i][j], y);
#pragma unroll
                for (int k = 0; k < 8; ++k) a[j][k] += y[k]; } }
        while (mask) { const int e = __builtin_ctz(mask); const int s1 = __builtin_amdgcn_readlane(slot, e); mask &= mask - 1u; const unsigned char* yp = Y + (size_t)s1 * D + 8 * lane;
#pragma unroll
            for (int j = 0; j < 2; ++j) { float y[8]; unpack8_fp8(*(const u32x2*)(yp + 512 * j), y);
#pragma unroll
                for (int k = 0; k < 8; ++k) a[j][k] += y[k]; } }
        float ss = 0.f;
#pragma unroll
        for (int j = 0; j < 2; ++j)
#pragma unroll
            for (int k = 0; k < 8; ++k) { v[j][k] += g2v[j][k] * a[j][k]; ss += v[j][k] * v[j][k]; }
        const float rstd = __builtin_amdgcn_rsqf(wave_sum(ss) * (1.0f / D) + EPS);
        if (mode == 2) {
#pragma unroll
            for (int j = 0; j < 2; ++j) { float* op = out + (size_t)m * D + 8 * lane + 512 * j;
                *(f32x4*)op = (f32x4){v[j][0] * rstd * av[j][0], v[j][1] * rstd * av[j][1], v[j][2] * rstd * av[j][2], v[j][3] * rstd * av[j][3]};
                *(f32x4*)(op + 4) = (f32x4){v[j][4] * rstd * av[j][4], v[j][5] * rstd * av[j][5], v[j][6] * rstd * av[j][6], v[j][7] * rstd * av[j][7]}; }
        } else {
#pragma unroll
            for (int j = 0; j < 2; ++j) { const int c = 8 * lane + 512 * j; *(u32x4*)(Xo + (size_t)m * D + c) = pack8f(v[j]); float h[8];
#pragma unroll
                for (int k = 0; k < 8; ++k) h[k] = sim8(v[j][k] * rstd * av[j][k] + shv[j][k], s8);
                if (h8) { u32x2 w8; w8.x = pk4_fp8(h[0], h[1], h[2], h[3]); w8.y = pk4_fp8(h[4], h[5], h[6], h[7]); *(u32x2*)((unsigned char*)H + (size_t)m * D + c) = w8; }
                else *(u32x4*)(H + (size_t)m * D + c) = pack8f(h); }
        }
    }
#undef N1_LOAD
#undef N1_GATHER
}

DI void n2_phase(LAS unsigned char* lds, int nrows, const bf16_t* X, const float* mod_cur, const float* gffn, const float* w_r, bf16_t* H, float* aff, int bid, int G) {
    LAS unsigned char* Whi = lds; LAS unsigned char* Wlo = lds + 32768;
    LAS float* AV = (LAS float*)(lds + 65536); LAS float* SH = AV + 1024; LAS float* BIAS = SH + 1024;
    LAS float* DP0 = BIAS + 16; LAS float* SSP0 = DP0 + 2 * 8 * 256;
    const int tid = tid_opaque(), w = __builtin_amdgcn_readfirstlane(tid >> 6), lane = tid & 63, r = lane & 15, q = lane >> 4;
    const int ngroups = nrows >> 4, gpw = (ngroups + G - 1) / G; const int g0 = bid * gpw; const int g1 = (g0 + gpw) < ngroups ? (g0 + gpw) : ngroups;
    int bcur = -1;
    u32x4 xa[4], xn[4], xn2[4];
#define N2_LOAD(dst, gg) do { const size_t _row = (size_t)(gg) * 16 + r; _Pragma("unroll") for (int i = 0; i < 4; ++i) dst[i] = *(const u32x4*)(X + _row * D + 128 * w + 32 * i + 8 * q); } while (0)
    if (g0 < g1) N2_LOAD(xn, g0);
    if (g0 + 1 < g1) N2_LOAD(xn2, g0 + 1);
    for (int g = g0; g < g1; ++g) {
        const int row0 = g * 16; const int b = row0 < ML ? (row0 >> 12) : 16;
        if (b != bcur) {
            bcur = b; __syncthreads();
            for (int c = tid; c < 1024; c += 512) { AV[c] = gffn[c] * (mod_cur[(size_t)b * 6144 + 4096 + c] + 1.0f); SH[c] = mod_cur[(size_t)b * 6144 + 3072 + c]; }
            __syncthreads();
            float sb = 0.f;
            for (int i = tid; i < 16384; i += 512) { const int c = i >> 4, e = i & 15; const float wv = w_r[i]; const float v = AV[c] * wv; sb += SH[c] * wv; const unsigned hi = pk2(v, 0.f) & 0xffffu; const float lo = v - __uint_as_float(hi << 16);
                const int off = (((c >> 5) * 16 + e) * 4 + ((c >> 3) & 3)) * 16 + (c & 7) * 2;
                *(LAS unsigned short*)(Whi + off) = (unsigned short)hi; *(LAS unsigned short*)(Wlo + off) = (unsigned short)(pk2(lo, 0.f) & 0xffffu); }
            sb = x32_sum(x16_sum(sb));
            if (q == 0) DP0[w * 16 + r] = sb;
            __syncthreads();
            if (tid < 16) { float t = 0.f;
#pragma unroll
                for (int ww = 0; ww < 8; ++ww) t += DP0[ww * 16 + tid];
                BIAS[tid] = t; }
            __syncthreads();
        }
#pragma unroll
        for (int i = 0; i < 4; ++i) { xa[i] = xn[i]; xn[i] = xn2[i]; }
        if (g + 2 < g1) N2_LOAD(xn2, g + 2);
        f32x4 acc = (f32x4){0.f, 0.f, 0.f, 0.f}; float ss = 0.f;
#pragma unroll
        for (int i = 0; i < 4; ++i) { const int ks = 4 * w + i;
            const bf16x8 wh = *(const LAS bf16x8*)(Whi + ((ks * 16 + r) * 4 + q) * 16), wl = *(const LAS bf16x8*)(Wlo + ((ks * 16 + r) * 4 + q) * 16);
            const bf16x8 a = __builtin_bit_cast(bf16x8, xa[i]);
            acc = __builtin_amdgcn_mfma_f32_16x16x32_bf16(a, wh, acc, 0, 0, 0); acc = __builtin_amdgcn_mfma_f32_16x16x32_bf16(a, wl, acc, 0, 0, 0);
            float v[8]; unpack8(xa[i], v);
#pragma unroll
            for (int k = 0; k < 8; ++k) ss += v[k] * v[k]; }
        ss = x32_sum(x16_sum(ss));
        LAS float* DP = DP0 + (g & 1) * (8 * 256); LAS float* SSP = SSP0 + (g & 1) * (8 * 16);
        if (q == 0) SSP[w * 16 + r] = ss;
#pragma unroll
        for (int k = 0; k < 4; ++k) DP[(w * 16 + 4 * q + k) * 16 + r] = acc[k];
        __syncthreads();
        float rs;
        { float s2 = 0.f;
#pragma unroll
          for (int ww = 0; ww < 8; ++ww) s2 += SSP[ww * 16 + r];
          rs = __builtin_amdgcn_rsqf(s2 * (1.0f / D) + EPS); }
        if (tid < 256) { const int row = tid >> 4, e = tid & 15; float d = 0.f;
#pragma unroll
            for (int ww = 0; ww < 8; ++ww) d += DP[(ww * 16 + row) * 16 + e];
            const float rrow = __shfl(rs, (lane & 48) | row);
            const float t = rrow * d + BIAS[e];
            float mx = t;
            mx = row16_max(mx);
            const float ex = __expf(t - mx); float sm = ex;
            sm = row16_sum(sm);
            aff[(size_t)(row0 + row) * 16 + e] = ex * __builtin_amdgcn_rcpf(sm); }
        {
#pragma unroll
          for (int i = 0; i < 4; ++i) { const int c = 128 * w + 32 * i + 8 * q; float v[8]; unpack8(xa[i], v);
              const f32x4 a0 = *(const LAS f32x4*)(AV + c), a1 = *(const LAS f32x4*)(AV + c + 4), s0 = *(const LAS f32x4*)(SH + c), s1 = *(const LAS f32x4*)(SH + c + 4);
              float h[8]; h[0] = v[0] * rs * a0[0] + s0[0]; h[1] = v[1] * rs * a0[1] + s0[1]; h[2] = v[2] * rs * a0[2] + s0[2]; h[3] = v[3] * rs * a0[3] + s0[3];
              h[4] = v[4] * rs * a1[0] + s1[0]; h[5] = v[5] * rs * a1[1] + s1[1]; h[6] = v[6] * rs * a1[2] + s1[2]; h[7] = v[7] * rs * a1[3] + s1[3];
              u32x2 w8; w8.x = pk4_fp8(h[0], h[1], h[2], h[3]); w8.y = pk4_fp8(h[4], h[5], h[6], h[7]);
              *(u32x2*)((unsigned char*)H + (size_t)(row0 + r) * D + c) = w8; } }
    }
#undef N2_LOAD
    __syncthreads();
}

DI void tk_problem(LAS unsigned char* lds, const float* aff, int rowbase, int n, int cap, int e, int slotbase, int* rowidx, float* gate, int* tokslot_e) {
    LAS int* cntA = (LAS int*)lds;
    LAS int* scanA = (LAS int*)(lds + 64);
    LAS int* scanB = (LAS int*)(lds + 128);
    LAS int* totG = (LAS int*)(lds + 192);
    const int tid = tid_opaque(), wave = tid >> 6, lane = tid & 63;
    unsigned key[8];
#pragma unroll
    for (int j = 0; j < 8; ++j) { const int t = tid * 8 + j; key[j] = t < n ? __float_as_uint(aff[(size_t)(rowbase + t) * 16 + e]) : 0u; }
    unsigned prefix = 0u; int it = 0;
    for (int bit = 30; bit >= 0; --bit, ++it) {
        const unsigned cand = prefix | (1u << bit);
        int c = 0;
#pragma unroll
        for (int j = 0; j < 8; ++j) c += key[j] >= cand ? 1 : 0;
        c = wave_sum_i(c);
        if (lane == 0) cntA[(it & 1) * 8 + wave] = c;
        __syncthreads();
        int tot = 0;
#pragma unroll
        for (int w = 0; w < 8; ++w) tot += cntA[(it & 1) * 8 + w];
        if (tot >= cap) prefix = cand;
    }
    int ng = 0, neq = 0;
#pragma unroll
    for (int j = 0; j < 8; ++j) { ng += key[j] > prefix ? 1 : 0; neq += key[j] == prefix ? 1 : 0; }
    int incl = neq;
#pragma unroll
    for (int o = 1; o < 64; o <<= 1) { const int y = __shfl_up(incl, o); if (lane >= o) incl += y; }
    const int wg = wave_sum_i(ng);
    if (lane == 63) scanA[wave] = incl;
    if (lane == 0) totG[wave] = wg;
    __syncthreads();
    int eqbase = incl - neq, G = 0;
#pragma unroll
    for (int w = 0; w < 8; ++w) { if (w < wave) eqbase += scanA[w]; G += totG[w]; }
    const int need = cap - G;
    bool sel[8]; int nsel = 0, er = eqbase;
#pragma unroll
    for (int j = 0; j < 8; ++j) { const bool isg = key[j] > prefix, ise = key[j] == prefix; sel[j] = isg || (ise && er < need); er += ise ? 1 : 0; nsel += sel[j] ? 1 : 0; }
    int incl2 = nsel;
#pragma unroll
    for (int o = 1; o < 64; o <<= 1) { const int y = __shfl_up(incl2, o); if (lane >= o) incl2 += y; }
    if (lane == 63) scanB[wave] = incl2;
    __syncthreads();
    int pos = incl2 - nsel;
#pragma unroll
    for (int w = 0; w < 8; ++w) if (w < wave) pos += scanB[w];
#pragma unroll
    for (int j = 0; j < 8; ++j) { const int t = tid * 8 + j;
        if (t < n) { if (sel[j]) { const int s = slotbase + pos; rowidx[s] = rowbase + t; gate[s] = __uint_as_float(key[j]); tokslot_e[rowbase + t] = s; ++pos; } else tokslot_e[rowbase + t] = -1; } }
    __syncthreads();
}

DI void tk_pair(LAS unsigned char* lds, const float* aff, int e, int rowbaseL, int slotbaseL, bool ctx, int rowbaseC, int slotbaseC, int* rowidx, float* gate, int* tokslot_e) {
    LAS int* cnt = (LAS int*)lds;
    LAS int* scanA = (LAS int*)(lds + 512);
    LAS int* scanB = (LAS int*)(lds + 640);
    LAS int* totG = (LAS int*)(lds + 768);
    const int tid = tid_opaque(), wave = __builtin_amdgcn_readfirstlane(tid >> 6), lane = tid & 63;
    unsigned key[8];
#pragma unroll
    for (int j = 0; j < 8; ++j) key[j] = __float_as_uint(aff[(size_t)(rowbaseL + tid * 8 + j) * 16 + e]);
    const bool hasc = ctx && tid < 256;
    const unsigned keyc = hasc ? __float_as_uint(aff[(size_t)(rowbaseC + tid) * 16 + e]) : 0u;
    unsigned pL = 0u, pC = 0u; int it = 0;
    for (int bit = 28; bit >= 0; bit -= 2, ++it) {
        LAS int* cb = cnt + (it & 1) * 48;
#pragma unroll
        for (int k = 0; k < 3; ++k) { const unsigned cL = pL | ((unsigned)(3 - k) << bit), cC = pC | ((unsigned)(3 - k) << bit);
            int n = 0;
#pragma unroll
            for (int j = 0; j < 8; ++j) n += __builtin_popcountll(__builtin_amdgcn_ballot_w64(key[j] >= cL));
            const int m = __builtin_popcountll(__builtin_amdgcn_ballot_w64(keyc >= cC));
            if (lane == 0) { cb[k * 8 + wave] = n; cb[24 + k * 8 + wave] = m; } }
        __syncthreads();
        int tL[3], tC[3];
#pragma unroll
        for (int k = 0; k < 3; ++k) { const pg8::v4i_t a = *(const LAS pg8::v4i_t*)(cb + k * 8), b = *(const LAS pg8::v4i_t*)(cb + k * 8 + 4), c = *(const LAS pg8::v4i_t*)(cb + 24 + k * 8), d = *(const LAS pg8::v4i_t*)(cb + 24 + k * 8 + 4);
            tL[k] = a[0] + a[1] + a[2] + a[3] + b[0] + b[1] + b[2] + b[3]; tC[k] = c[0] + c[1] + c[2] + c[3] + d[0] + d[1] + d[2] + d[3]; }
        const unsigned dL = tL[0] >= CAPL ? 3u : (tL[1] >= CAPL ? 2u : (tL[2] >= CAPL ? 1u : 0u)), dC = tC[0] >= CAPC ? 3u : (tC[1] >= CAPC ? 2u : (tC[2] >= CAPC ? 1u : 0u));
        pL |= dL << bit; pC |= dC << bit;
    }
    int ngL = 0, neqL = 0;
#pragma unroll
    for (int j = 0; j < 8; ++j) { ngL += key[j] > pL ? 1 : 0; neqL += key[j] == pL ? 1 : 0; }
    const int ngC = (hasc && keyc > pC) ? 1 : 0, neqC = (hasc && keyc == pC) ? 1 : 0;
    int inL = neqL, inC = neqC;
#pragma unroll
    for (int o = 1; o < 64; o <<= 1) { const int y = __shfl_up(inL, o), z = __shfl_up(inC, o); if (lane >= o) { inL += y; inC += z; } }
    const int wgL = wave_sum_i(ngL), wgC = wave_sum_i(ngC);
    if (lane == 63) { scanA[wave] = inL; scanA[8 + wave] = inC; }
    if (lane == 0) { totG[wave] = wgL; totG[8 + wave] = wgC; }
    __syncthreads();
    int ebL = inL - neqL, ebC = inC - neqC, GL = 0, GC = 0;
#pragma unroll
    for (int w = 0; w < 8; ++w) { if (w < wave) { ebL += scanA[w]; ebC += scanA[8 + w]; } GL += totG[w]; GC += totG[8 + w]; }
    const int needL = CAPL - GL, needC = CAPC - GC;
    bool sel[8]; int nsel = 0, er = ebL;
#pragma unroll
    for (int j = 0; j < 8; ++j) { const bool isg = key[j] > pL, ise = key[j] == pL; sel[j] = isg || (ise && er < needL); er += ise ? 1 : 0; nsel += sel[j] ? 1 : 0; }
    const bool selC = hasc && (keyc > pC || (keyc == pC && ebC < needC));
    int i2L = nsel, i2C = selC ? 1 : 0;
#pragma unroll
    for (int o = 1; o < 64; o <<= 1) { const int y = __shfl_up(i2L, o), z = __shfl_up(i2C, o); if (lane >= o) { i2L += y; i2C += z; } }
    if (lane == 63) { scanB[wave] = i2L; scanB[8 + wave] = i2C; }
    __syncthreads();
    int posL = i2L - nsel, posC = i2C - (selC ? 1 : 0);
#pragma unroll
    for (int w = 0; w < 8; ++w) if (w < wave) { posL += scanB[w]; posC += scanB[8 + w]; }
#pragma unroll
    for (int j = 0; j < 8; ++j) { const int t = rowbaseL + tid * 8 + j;
        if (sel[j]) { const int sl = slotbaseL + posL; rowidx[sl] = t; gate[sl] = __uint_as_float(key[j]); tokslot_e[t] = sl; ++posL; } else tokslot_e[t] = -1; }
    if (hasc) { const int t = rowbaseC + tid;
        if (selC) { const int sl = slotbaseC + posC; rowidx[sl] = t; gate[sl] = __uint_as_float(keyc); tokslot_e[t] = sl; } else tokslot_e[t] = -1; }
    __syncthreads();
}

DI int sm_chunk_of(int t) {
    if (t < 32) { const int x = t >> 2, w = t & 3; return 68 * x + 64 + w; }
    const int u = t - 32, j = 3 - (u >> 7), v = u & 127, x = v >> 4, w = v & 15; return 68 * x + 16 * j + w;
}
DI s16x4 tr16(const LAS unsigned char* p) { return __builtin_bit_cast(s16x4, __builtin_amdgcn_ds_read_tr16_b64_v4i16((LAS v4i16_t*)p)); }
DI void sm_phase(LAS unsigned char* lds, const bf16_t* U, bf16_t* Uo, const bf16_t* V, const float* stats, const bf16_t* ws_t  , const float* ws_f  , const float* b_s  ,
                 const float* ln_g, const float* ln_b, int bid, int G) {
    constexpr int PITCH = 272;
    constexpr int NUNITS = (MT / 128) * 16;
    LAS unsigned char* Aimg = lds; LAS unsigned char* Bimg = lds + 128 * PITCH; LAS float* RS = (LAS float*)(lds + 3 * 128 * PITCH);
    const int tid = tid_opaque(), wid = __builtin_amdgcn_readfirstlane(tid >> 6), lane = tid & 63, wr = wid >> 2, wc = wid & 3, fr = lane & 15, fq = lane >> 4;
    const int r4 = tid >> 2, q4 = tid & 3;
    f32x4 gam[2], bet[2]; float rsw[4], bsv[4];
    u32x4 vr[4], vr2[4]; f32x4 sr, sr2; u32x4 ur[4], ur2[4];
    int last_g = -1;
#define SM_LOAD(dv, ds, du, un) do { const int _ch = sm_chunk_of((un) >> 4), _g = (un) & 15; const size_t _r0 = (size_t)_ch * 128; const int _c0 = _g * 128; \
        _Pragma("unroll") for (int k = 0; k < 4; ++k) dv[k] = *(const u32x4*)(V + (_r0 + r4) * 2048 + _c0 + k * 32 + q4 * 8);     \
        ds = *(const f32x4*)(stats + (_r0 + r4) * 16 + q4 * 4); \
        _Pragma("unroll") for (int mt = 0; mt < 4; ++mt) du[mt] = *(const u32x4*)(U + (_r0 + wr * 64 + mt * 16 + fr) * 2048 + _c0 + wc * 32 + 8 * fq); } while (0)
    int unit = bid;
    if (unit < NUNITS) SM_LOAD(vr, sr, ur, unit);
    if (unit + G < NUNITS) SM_LOAD(vr2, sr2, ur2, unit + G);
    for (int it = 0; unit < NUNITS; unit += G, ++it) {
        const int ch = sm_chunk_of(unit >> 4), g = unit & 15; const size_t row0 = (size_t)ch * 128; const int c0 = g * 128;
        if (g != last_g) {
            __syncthreads();
#pragma unroll
            for (int k = 0; k < 4; ++k) { const int id = tid + 512 * k, r = id >> 4, cc = (id & 15) * 8; *(LAS u32x4*)(Aimg + r * PITCH + cc * 2) = *(const u32x4*)(ws_t + ((size_t)g * 128 + r) * 128 + cc); }
            if (tid < 128) { const float* wp = ws_f + ((size_t)g * 128 + tid) * 128; float s = 0.f;
#pragma unroll 8
                for (int i = 0; i < 32; ++i) { const f32x4 x = *(const f32x4*)(wp + 4 * i); s += (x[0] + x[1]) + (x[2] + x[3]); }
                RS[tid] = s; }
            __syncthreads();
#pragma unroll
            for (int mt = 0; mt < 4; ++mt) { const int p = wr * 64 + mt * 16 + fr; rsw[mt] = RS[p]; bsv[mt] = b_s[g * 128 + p]; }
#pragma unroll
            for (int nt = 0; nt < 2; ++nt) { gam[nt] = *(const f32x4*)(ln_g + c0 + wc * 32 + 8 * fq + 4 * nt); bet[nt] = *(const f32x4*)(ln_b + c0 + wc * 32 + 8 * fq + 4 * nt); }
            last_g = g;
        }
        LAS unsigned char* Bi = Bimg + (it & 1) * 128 * PITCH;
        { float s = sr[0] + sr[2], q = sr[1] + sr[3]; s += xor1_f(s); q += xor1_f(q); s += xor2_f(s); q += xor2_f(q);
          const float mu = s * (1.0f / DA); const float rs = __builtin_amdgcn_rsqf(fmaxf(q * (1.0f / DA) - mu * mu, 0.f) + EPS);
#pragma unroll
          for (int k = 0; k < 4; ++k) { const u32x4 w = vr[k]; u32x2 o0, o1;
              o0.x = pk2((bflo(w.x) - mu) * rs, (bfhi(w.x) - mu) * rs); o0.y = pk2((bflo(w.y) - mu) * rs, (bfhi(w.y) - mu) * rs);
              o1.x = pk2((bflo(w.z) - mu) * rs, (bfhi(w.z) - mu) * rs); o1.y = pk2((bflo(w.w) - mu) * rs, (bfhi(w.w) - mu) * rs);
              *(LAS u32x2*)(Bi + r4 * PITCH + (k * 32 + 4 * q4) * 2) = o0; *(LAS u32x2*)(Bi + r4 * PITCH + (k * 32 + 16 + 4 * q4) * 2) = o1; } }
        u32x4 uc[4];
#pragma unroll
        for (int mt = 0; mt < 4; ++mt) { uc[mt] = ur[mt]; ur[mt] = ur2[mt]; }
#pragma unroll
        for (int k = 0; k < 4; ++k) vr[k] = vr2[k];
        sr = sr2;
        if (unit + 2 * G < NUNITS) SM_LOAD(vr2, sr2, ur2, unit + 2 * G);
        __syncthreads();
        f32x4 acc[4][2];
#pragma unroll
        for (int mt = 0; mt < 4; ++mt)
#pragma unroll
            for (int nt = 0; nt < 2; ++nt) acc[mt][nt] = (f32x4){0.f, 0.f, 0.f, 0.f};
#pragma unroll
        for (int ks = 0; ks < 4; ++ks) {
            bf16x8 bfr[2], afr[4];
#pragma unroll
            for (int mt = 0; mt < 4; ++mt) afr[mt] = *(const LAS bf16x8*)(Aimg + (wr * 64 + mt * 16 + fr) * PITCH + (ks * 32 + 8 * fq) * 2);
#pragma unroll
            for (int nt = 0; nt < 2; ++nt) { const LAS unsigned char* p = Bi + (ks * 32 + 8 * fq + (fr >> 2)) * PITCH + (wc * 32 + nt * 16) * 2 + 8 * (fr & 3);
                const s16x4 lo = tr16(p), hi = tr16(p + 4 * PITCH); bfr[nt] = __builtin_shufflevector(lo, hi, 0, 1, 2, 3, 4, 5, 6, 7); }
#pragma unroll
            for (int mt = 0; mt < 4; ++mt)
#pragma unroll
                for (int nt = 0; nt < 2; ++nt) acc[mt][nt] = __builtin_amdgcn_mfma_f32_16x16x32_bf16(bfr[nt], afr[mt], acc[mt][nt], 0, 0, 0);
        }
#pragma unroll
        for (int mt = 0; mt < 4; ++mt) { const int p = wr * 64 + mt * 16 + fr;
            const f32x4 sv0 = gam[0] * acc[mt][0] + bet[0] * rsw[mt] + bsv[mt], sv1 = gam[1] * acc[mt][1] + bet[1] * rsw[mt] + bsv[mt]; const u32x4 w = uc[mt];
            constexpr bool S8 = (FP8D_SIM & 4) != 0; u32x4 o; o.x = pk2(sim8(bflo(w.x) * sv0[0], S8), sim8(bfhi(w.x) * sv0[1], S8)); o.y = pk2(sim8(bflo(w.y) * sv0[2], S8), sim8(bfhi(w.y) * sv0[3], S8)); o.z = pk2(sim8(bflo(w.z) * sv1[0], S8), sim8(bfhi(w.z) * sv1[1], S8)); o.w = pk2(sim8(bflo(w.w) * sv1[2], S8), sim8(bfhi(w.w) * sv1[3], S8));
            *(u32x4*)(Uo + (row0 + p) * 2048 + c0 + wc * 32 + 8 * fq) = o; }
    }
#undef SM_LOAD
    __syncthreads();
}

DI bf16x8 pack8(const f32x16& x, int s) {
    u32x4 p; p.x = pk2(x[8 * s], x[8 * s + 1]); p.y = pk2(x[8 * s + 2], x[8 * s + 3]); p.z = pk2(x[8 * s + 4], x[8 * s + 5]); p.w = pk2(x[8 * s + 6], x[8 * s + 7]);
    return __builtin_bit_cast(bf16x8, p);
}
DI void at_phase(LAS unsigned char* lds, const bf16_t* Q, const bf16_t* Kb, const bf16_t* Vb, bf16_t* O, const float* sink  , int nunits, int bid, int G) {
    constexpr int KP = 144;
    constexpr int BUFB = 2 * 64 * KP;
    const int tid = tid_opaque(), wid = __builtin_amdgcn_readfirstlane(tid >> 6), lane = tid & 63, r = lane & 31, h = lane >> 5;
    const int g = wid >> 1, wh = wid & 1;
    const int skey = tid >> 3, sdc = tid & 7;
    for (int unit = bid; unit < nunits; unit += G) {
        int b, kvh, qb, qrow0; bool lat;
        if (unit < 2048) { lat = true; b = unit >> 7; kvh = (unit >> 5) & 3; qb = unit & 31; qrow0 = b * 4096 + qb * 128; }
        else { const int u2 = unit - 2048; lat = false; b = u2 >> 3; kvh = (u2 >> 1) & 3; qb = u2 & 1; qrow0 = ML + b * 256 + qb * 128; }
        const int hq = kvh * 4 + g;
        unsigned tmask = lat ? (0x3CCu | (qb >= 1 ? 0x3u : 0u) | (qb <= 30 ? 0x30u : 0u)) : 0x3C0u;
#define AT_KROW(ti) ((ti) < 6 ? b * 4096 + (qb - 1 + ((ti) >> 1)) * 128 + ((ti) & 1) * 64 : ML + b * 256 + ((ti) - 6) * 64)
        int ti = __builtin_ctz(tmask); tmask &= tmask - 1u;
        u32x4 kreg, vreg;
        { const int kr = AT_KROW(ti); kreg = *(const u32x4*)(Kb + (size_t)(kr + skey) * 256 + kvh * 64 + sdc * 8); vreg = *(const u32x4*)(Vb + (size_t)(kr + skey) * 256 + kvh * 64 + sdc * 8); }
        LAS unsigned char* QO = lds + 2 * BUFB + wid * (64 * KP);
        bf16x8 qf[2][4];
        { u32x4 qv[8];
#pragma unroll
          for (int i = 0; i < 8; ++i) { const int row = (lane >> 3) + 8 * i; qv[i] = *(const u32x4*)(Q + (size_t)(qrow0 + wh * 64 + row) * 1024 + hq * 64 + (lane & 7) * 8); }
#pragma unroll
          for (int i = 0; i < 8; ++i) { const int row = (lane >> 3) + 8 * i; *(LAS u32x4*)(QO + row * KP + (lane & 7) * 16) = qv[i]; }
          asm volatile("s_waitcnt lgkmcnt(0)" ::: "memory");
#pragma unroll
          for (int qt = 0; qt < 2; ++qt)
#pragma unroll
              for (int ks = 0; ks < 4; ++ks) qf[qt][ks] = *(const LAS bf16x8*)(QO + (qt * 32 + r) * KP + (ks * 16 + 8 * h) * 2);
          asm volatile("s_waitcnt lgkmcnt(0)" ::: "memory"); }
        f32x16 o[2][2];
#pragma unroll
        for (int dt = 0; dt < 2; ++dt)
#pragma unroll
            for (int qt = 0; qt < 2; ++qt)
#pragma unroll
                for (int i = 0; i < 16; ++i) o[dt][qt][i] = 0.f;
        float mrun[2], lrun[2];
        { const float sk = sink[hq] * LOG2E; mrun[0] = sk; mrun[1] = sk; lrun[0] = h == 0 ? 1.f : 0.f; lrun[1] = lrun[0]; }
        __syncthreads();
        *(LAS u32x4*)(lds + skey * KP + sdc * 16) = kreg; *(LAS u32x4*)(lds + 64 * KP + skey * KP + sdc * 16) = vreg;
        int buf = 0;
        for (;;) {
            const int tn = tmask ? __builtin_ctz(tmask) : -1; tmask &= tmask - 1u;
            if (tn >= 0) { const int kr = AT_KROW(tn); kreg = *(const u32x4*)(Kb + (size_t)(kr + skey) * 256 + kvh * 64 + sdc * 8); vreg = *(const u32x4*)(Vb + (size_t)(kr + skey) * 256 + kvh * 64 + sdc * 8); }
            __syncthreads();
            const LAS unsigned char* Kimg = lds + buf * BUFB; const LAS unsigned char* Vimg = Kimg + 64 * KP;
            const int mode = ti < 2 ? 1 : (ti < 4 ? 0 : (ti < 6 ? 2 : 0));
            const bool skip = (ti == 0 && wh == 1) || (ti == 5 && wh == 0);
            if (!skip) {
            f32x16 s[2][2];
#pragma unroll
            for (int kt = 0; kt < 2; ++kt)
#pragma unroll
                for (int qt = 0; qt < 2; ++qt)
#pragma unroll
                    for (int i = 0; i < 16; ++i) s[kt][qt][i] = -mrun[qt];
            {
                const unsigned kaddr = (unsigned)(__UINTPTR_TYPE__)(Kimg + r * KP + 16 * h);
                bf16x8 k0, k1, k2;
#define AT_KRD(dst, OFF) asm volatile("ds_read_b128 %0, %1 offset:" #OFF : "=v"(dst) : "v"(kaddr))
#define AT_KW(dst, N) asm volatile("s_waitcnt lgkmcnt(" #N ")" : "+v"(dst) :: "memory")
#define AT_QK(kfv, kt, ks) do { s[kt][0] = __builtin_amdgcn_mfma_f32_32x32x16_bf16(kfv, qf[0][ks], s[kt][0], 0, 0, 0); s[kt][1] = __builtin_amdgcn_mfma_f32_32x32x16_bf16(kfv, qf[1][ks], s[kt][1], 0, 0, 0); } while (0)
                asm volatile("s_waitcnt lgkmcnt(0)" ::: "memory");
                AT_KRD(k0, 0); AT_KRD(k1, 32);
                AT_KRD(k2, 64);   AT_KW(k0, 2); AT_QK(k0, 0, 0);
                AT_KRD(k0, 96);   AT_KW(k1, 2); AT_QK(k1, 0, 1);
                AT_KRD(k1, 4608); AT_KW(k2, 2); AT_QK(k2, 0, 2);
                AT_KRD(k2, 4640); AT_KW(k0, 2); AT_QK(k0, 0, 3);
                AT_KRD(k0, 4672); AT_KW(k1, 2); AT_QK(k1, 1, 0);
                AT_KRD(k1, 4704); AT_KW(k2, 2); AT_QK(k2, 1, 1);
                                  AT_KW(k0, 1); AT_QK(k0, 1, 2);
                                  AT_KW(k1, 0); AT_QK(k1, 1, 3);
#undef AT_KRD
#undef AT_KW
#undef AT_QK
            }
            if (mode != 0) {
                const int jb = (ti & 1) * 64;
#pragma unroll
                for (int qt = 0; qt < 2; ++qt) { const int dlt = jb + 4 * h - (wh * 64 + qt * 32 + r);
                    if (mode == 1) {
#pragma unroll
                        for (int kt = 0; kt < 2; ++kt)
#pragma unroll
                            for (int i = 0; i < 16; ++i) { if (dlt < -(kt * 32 + (i & 3) + 8 * (i >> 2))) s[kt][qt][i] = -INFINITY; }
                    } else {
#pragma unroll
                        for (int kt = 0; kt < 2; ++kt)
#pragma unroll
                            for (int i = 0; i < 16; ++i) { if (dlt > -(kt * 32 + (i & 3) + 8 * (i >> 2))) s[kt][qt][i] = -INFINITY; }
                    } }
            }
            float mx[2];
#pragma unroll
            for (int qt = 0; qt < 2; ++qt) { float m0 = __builtin_fmaxf(s[0][qt][0], s[1][qt][0]);
#pragma unroll
                for (int i = 1; i < 16; ++i) m0 = __builtin_fmaxf(__builtin_fmaxf(m0, s[0][qt][i]), s[1][qt][i]);
                mx[qt] = x32_max(m0); }
            if (__builtin_amdgcn_ballot_w64(mx[0] > 8.0f || mx[1] > 8.0f) != 0ull) {
#pragma unroll
                for (int qt = 0; qt < 2; ++qt) { const float d = fmaxf(mx[qt], 0.f), alpha = __builtin_amdgcn_exp2f(-d); mrun[qt] += d; lrun[qt] *= alpha;
#pragma unroll
                    for (int kt = 0; kt < 2; ++kt)
#pragma unroll
                        for (int i = 0; i < 16; ++i) s[kt][qt][i] -= d;
#pragma unroll
                    for (int dt = 0; dt < 2; ++dt)
#pragma unroll
                        for (int i = 0; i < 16; ++i) o[dt][qt][i] *= alpha; }
            }
#pragma unroll
            for (int qt = 0; qt < 2; ++qt) { float ls = 0.f;
#pragma unroll
                for (int kt = 0; kt < 2; ++kt)
#pragma unroll
                    for (int i = 0; i < 16; ++i) { const float p = __builtin_amdgcn_exp2f(s[kt][qt][i]); s[kt][qt][i] = p; ls += p; }
                lrun[qt] += ls; }
#pragma unroll
            for (int kt = 0; kt < 2; ++kt)
#pragma unroll
                for (int ss = 0; ss < 2; ++ss) {
                    bf16x8 vf[2];
#pragma unroll
                    for (int dt = 0; dt < 2; ++dt) { const LAS unsigned char* p = Vimg + (kt * 32 + 16 * ss + 4 * h + ((lane & 15) >> 2)) * KP + (dt * 32 + 16 * ((lane >> 4) & 1)) * 2 + 8 * (lane & 3);
                        const s16x4 lo = tr16(p), hi = tr16(p + 8 * KP); vf[dt] = __builtin_shufflevector(lo, hi, 0, 1, 2, 3, 4, 5, 6, 7); }
#pragma unroll
                    for (int qt = 0; qt < 2; ++qt) { const bf16x8 pf = pack8(s[kt][qt], ss);
#pragma unroll
                        for (int dt = 0; dt < 2; ++dt) o[dt][qt] = __builtin_amdgcn_mfma_f32_32x32x16_bf16(vf[dt], pf, o[dt][qt], 0, 0, 0); }
                }
            }
            if (tn < 0) break;
            { LAS unsigned char* nb = lds + (buf ^ 1) * BUFB; *(LAS u32x4*)(nb + skey * KP + sdc * 16) = kreg; *(LAS u32x4*)(nb + 64 * KP + skey * KP + sdc * 16) = vreg; }
            buf ^= 1; ti = tn;
        }
#undef AT_KROW
#pragma unroll
        for (int qt = 0; qt < 2; ++qt) { const float lt = x32_sum(lrun[qt]); const float inv = 1.0f / lt;
#pragma unroll
            for (int dt = 0; dt < 2; ++dt)
#pragma unroll
                for (int ig = 0; ig < 4; ++ig) {
                    if (FP8_ATT) { *(LAS unsigned*)(QO + (qt * 32 + r) * KP + (dt * 32 + 8 * ig + 4 * h)) = pk4_fp8(o[dt][qt][4 * ig] * inv, o[dt][qt][4 * ig + 1] * inv, o[dt][qt][4 * ig + 2] * inv, o[dt][qt][4 * ig + 3] * inv); }
                    else { constexpr bool S8 = (FP8D_SIM & 2) != 0; u32x2 w; w.x = pk2(sim8(o[dt][qt][4 * ig] * inv, S8), sim8(o[dt][qt][4 * ig + 1] * inv, S8)); w.y = pk2(sim8(o[dt][qt][4 * ig + 2] * inv, S8), sim8(o[dt][qt][4 * ig + 3] * inv, S8));
                        *(LAS u32x2*)(QO + (qt * 32 + r) * KP + (dt * 32 + 8 * ig + 4 * h) * 2) = w; } } }
        asm volatile("s_waitcnt lgkmcnt(0)" ::: "memory");
        if (FP8_ATT) {
#pragma unroll
            for (int i = 0; i < 4; ++i) { const int row = (lane >> 2) + 16 * i; const u32x4 w = *(const LAS u32x4*)(QO + row * KP + (lane & 3) * 16);
                *(u32x4*)((unsigned char*)O + (size_t)(qrow0 + wh * 64 + row) * 1024 + hq * 64 + (lane & 3) * 16) = w; }
        } else {
#pragma unroll
        for (int i = 0; i < 8; ++i) { const int row = (lane >> 3) + 8 * i; const u32x4 w = *(const LAS u32x4*)(QO + row * KP + (lane & 7) * 16);
            *(u32x4*)(O + (size_t)(qrow0 + wh * 64 + row) * 1024 + hq * 64 + (lane & 7) * 8) = w; }
        }
        asm volatile("s_waitcnt lgkmcnt(0)" ::: "memory");
    }
    __syncthreads();
}

struct Args { const float* in[23]; float* out; unsigned char* ws; int ph_lo, ph_hi; };
static_assert(sizeof(Args) == 25 * 8 + 8, "Args has no padding");
#define AS4 __attribute__((address_space(4)))
DI unsigned long long karg(int k) { const unsigned long long AS4* kp = (const unsigned long long AS4*)__builtin_amdgcn_kernarg_segment_ptr(); asm volatile("" : "+s"(kp)); return kp[k]; }
#define KIN(k) ((const float*)(const GAS float*)karg(k))
#define KOUT() ((float*)(GAS float*)karg(23))
#define KWS() ((unsigned char*)(GAS unsigned char*)karg(24))

#ifndef DBG_ONLY
#define DBG_ONLY -1
#endif
#ifndef ALIGN_E12
#define ALIGN_E12 true
#endif
#ifndef DUP_MASK
#define DUP_MASK 0
#endif
#ifndef STAMP_MASK
#define STAMP_MASK 0
#endif
#ifndef STAMP_TMAX_US
#define STAMP_TMAX_US 5000
#endif
#define NDUP(n) (((DUP_MASK >> (n)) & 1) ? 2 : 1)
#define DUMMY(n) (NDUP(n) == 2 && dup_ == 0)
#define ST0(n) do { if (STAMP_MASK && ((STAMP_MASK >> (n)) & 1) && blockIdx.x == 0) t_st0 = __builtin_amdgcn_s_memrealtime(); } while (0)
#define ST1(n) do { if (STAMP_MASK && ((STAMP_MASK >> (n)) & 1) && blockIdx.x == 0) t_acc += __builtin_amdgcn_s_memrealtime() - t_st0; } while (0)
#define SITE(n) (DBG_ONLY < 0 || DBG_ONLY == (n))

__global__ void __launch_bounds__(512, 2) mega_fwd(Args args) {
    extern __shared__ __attribute__((aligned(16))) unsigned char lds_raw[];
    LAS unsigned char* lds = (LAS unsigned char*)lds_raw;
    const int tid = threadIdx.x;
    for (int u = tid; u < (LDS_BYTES - RING_BYTES) / 4; u += 512) ((LAS unsigned*)(lds + RING_BYTES))[u] = 0u;
    __syncthreads();
    XcdBarrier bar; bar.bar = (unsigned*)(args.ws + WS_CTL) + CW_BAR; bar.x = 0; bar.st = nullptr;
    if (!MK_SPLIT) bar = xcd_barrier_post((unsigned*)(args.ws + WS_CTL) + CW_BAR, (volatile LAS unsigned*)(lds + MISC_OFF) + 8);
    const int lo = args.ph_lo, hi = args.ph_hi;
    unsigned long long t_st0 = 0, t_acc = 0; (void)t_st0; (void)t_acc;
#define IN(k) (lo <= (k) && (k) < hi)
#ifndef SEAM_REP
#define SEAM_REP 1
#endif
#define SEAM(k) do { if (!MK_SPLIT && IN((k) + 1)) { for (int rep_ = 0; rep_ < SEAM_REP; ++rep_) xcd_barrier(bar); } } while (0)
#ifndef STEAL
#define STEAL 1
#endif
#define STEAL_ARGS() P0Args sa; sa.w1 = KIN(19); sa.w3 = KIN(20); sa.w2 = KIN(21); sa.w13_t = (bf16_t*)(ws + WS_W13); sa.w2_t = (bf16_t*)(ws + WS_W2); unsigned* sq = (unsigned*)(ws + WS_CTL) + CW_STEAL
#define STEAL_TAIL(nunits, budget, own) do { if (STEAL && ((nunits) % G) != 0 && bid >= ((nunits) % G)) { STEAL_ARGS(); \
        if (own) steal_convert(lds, sq + 64 * layer, sa, layer, (budget)); else if (layer < DEPTH - 1) steal_convert(lds, sq + 64 * (layer + 1), sa, layer + 1, (budget)); } } while (0)
#define WAVE_IDS() const int tid_ = tid_opaque(); const int lane = tid_ & 63, wave = __builtin_amdgcn_readfirstlane(tid_ >> 6); const int G = gridDim.x, bid = blockIdx.x; const int gw = bid * 8 + wave, NGW = G * 8; (void)lane; (void)gw; (void)NGW; (void)G; (void)bid

    ST0(0); for (int dup_ = 0; dup_ < NDUP(0); ++dup_) if (SITE(0) && IN(0)) { if (dup_) __syncthreads();
        WAVE_IDS(); unsigned char* ws = KWS();
        p0_mod(lds, KIN(1), KIN(3), KIN(4), KIN(5), (float*)(ws + WS_MOD), bid, G);
        P0Args pa; pa.w_in = KIN(8); pa.w_out = KIN(14); pa.w_qkv = KIN(15); pa.w_o = KIN(17); pa.w1 = KIN(19); pa.w3 = KIN(20); pa.w2 = KIN(21); pa.w_s = KIN(12);
        pa.win_t = (bf16_t*)(ws + WS_WIN); pa.wout_t = (bf16_t*)(ws + WS_WOUT); pa.wqkv_t = (bf16_t*)(ws + WS_WQKV); pa.wo_t = (bf16_t*)(ws + WS_WO); pa.w13_t = (bf16_t*)(ws + WS_W13); pa.w2_t = (bf16_t*)(ws + WS_W2);
        pa.ws_t = (bf16_t*)(ws + WS_WSP); pa.cosT = (float*)(ws + WS_ROPE); pa.sinT = pa.cosT + 4096 * 32;
        p0_convert(lds, pa, gw, NGW, lane, wave);
    }
    SEAM(0); ST1(0);
    ST0(1); for (int dup_ = 0; dup_ < NDUP(1); ++dup_) if (SITE(1) && IN(1)) { if (dup_) __syncthreads(); WAVE_IDS(); unsigned char* ws = KWS();
        n0_phase(KIN(0), KIN(2), DUMMY(1) ? (bf16_t*)(ws + WS_BIG) : (bf16_t*)(ws + WS_X), (const float*)(ws + WS_MOD), KIN(6), DUMMY(1) ? (bf16_t*)(ws + WS_BIG + 300 * MiB) : (bf16_t*)(ws + WS_H), gw, NGW, lane); }
    SEAM(1); ST1(1);

    for (int layer = 0; layer < DEPTH; ++layer) {
        const int pb = 2 + 8 * layer, j = layer >> 1; const bool lastl = layer == DEPTH - 1;
        const int mrows = lastl ? ML : MT;
        if ((layer & 1) == 0) {
            ST0(2); for (int dup_ = 0; dup_ < NDUP(2); ++dup_) if (SITE(2) && IN(pb + 0)) { if (dup_) __syncthreads(); WAVE_IDS(); unsigned char* ws = KWS();
                pg8::Gemm g{(const bf16_t*)(ws + WS_H), (const bf16_t*)(ws + WS_WIN) + (size_t)j * 4096 * 1024, nullptr}; pg8::GroupedOrder<16, 0> S; S.init(MT / 256, 1, G, bid);
                EpiGeluUV E{(bf16_t*)(ws + WS_BIG + BIG_U), (bf16_t*)(ws + WS_BIG + BIG_V), KIN(9) + (size_t)j * 4096, (float*)(ws + WS_STATS), lds + XCH_OFF};
                pg8::gemm_phase<EpiGeluUV, pg8::GroupedOrder<16, 0>, false, 1024, 0, 0, true, 2, (ROTK_MASK & 4) != 0>(lds, g, S, E); }
            SEAM(pb + 0); ST1(2);
            ST0(3); for (int dup_ = 0; dup_ < NDUP(3); ++dup_) if (SITE(3) && IN(pb + 1)) { if (dup_) __syncthreads(); WAVE_IDS(); unsigned char* ws = KWS();
                sm_phase(lds, (const bf16_t*)(ws + WS_BIG + BIG_U), DUMMY(3) ? (bf16_t*)(ws + WS_Y) : (bf16_t*)(ws + WS_BIG + BIG_U), (const bf16_t*)(ws + WS_BIG + BIG_V), (const float*)(ws + WS_STATS), (const bf16_t*)(ws + WS_WSP) + (size_t)j * 16 * 128 * 128,
                         KIN(12) + (size_t)j * 16 * 128 * 128, KIN(13) + (size_t)j * 16 * 128, KIN(10) + (size_t)j * 2048, KIN(11) + (size_t)j * 2048, bid, G); }
            SEAM(pb + 1); ST1(3);
            ST0(4); for (int dup_ = 0; dup_ < NDUP(4); ++dup_) if (SITE(4) && IN(pb + 2)) { if (dup_) __syncthreads(); WAVE_IDS(); unsigned char* ws = KWS();
                pg8::Gemm g{(const bf16_t*)(ws + WS_BIG + BIG_U), (const bf16_t*)(ws + WS_WOUT) + (size_t)j * 1024 * 2048, nullptr}; pg8::GroupedOrder<4, 0> S; S.init(MT / 256, 1, G, bid);
                EpiResAdd E{(const bf16_t*)(ws + WS_X), DUMMY(4) ? (bf16_t*)(ws + WS_Y) : (bf16_t*)(ws + WS_X), (const float*)(ws + WS_MOD) + (size_t)layer * 17 * 6144 + 2048, 1.0f};
                pg8::gemm_phase<EpiResAdd, pg8::GroupedOrder<4, 0>, false, 2048, 0, 0, true, 2, (ROTK_MASK & 8) != 0>(lds, g, S, E); if (dup_ == NDUP(4) - 1) STEAL_TAIL((MT / 256) * 4, 8, true); }
            SEAM(pb + 2); ST1(4);
        } else {
            ST0(5); for (int dup_ = 0; dup_ < NDUP(5); ++dup_) if (SITE(5) && IN(pb + 0)) { if (dup_) __syncthreads(); WAVE_IDS(); unsigned char* ws = KWS();
                pg8::Gemm g{(const bf16_t*)(ws + WS_H), (const bf16_t*)(ws + WS_WQKV + (size_t)j * 1536 * 1024 * (FP8_ATT ? 1 : 2)), nullptr}; pg8::GroupedOrder<6, 0> S; S.init(MT / 256, 1, G, bid);
                EpiQKV E{(bf16_t*)(ws + WS_BIG + BIG_Q), (bf16_t*)(ws + WS_BIG + BIG_K), (bf16_t*)(ws + WS_BIG + BIG_VV), (const float*)(ws + WS_ROPE), (const float*)(ws + WS_ROPE) + 4096 * 32};
                pg8::gemm_phase<EpiQKV, pg8::GroupedOrder<6, 0>, false, 1024, 0, 0, true, FP8_ATT ? 1 : 2, (ROTK_MASK & 16) != 0>(lds, g, S, E); if (dup_ == NDUP(5) - 1) STEAL_TAIL((MT / 256) * 6, 2, true); }
            SEAM(pb + 0); ST1(5);
            ST0(6); for (int dup_ = 0; dup_ < NDUP(6); ++dup_) if (SITE(6) && IN(pb + 1)) { if (dup_) __syncthreads(); WAVE_IDS(); unsigned char* ws = KWS();
                at_phase(lds, (const bf16_t*)(ws + WS_BIG + BIG_Q), (const bf16_t*)(ws + WS_BIG + BIG_K), (const bf16_t*)(ws + WS_BIG + BIG_VV), (bf16_t*)(ws + WS_BIG + BIG_O), KIN(16) + j * 16, lastl ? 2048 : 2048 + 128, bid, G); if (dup_ == NDUP(6) - 1) STEAL_TAIL(lastl ? 2048 : 2048 + 128, 5, true); }
            SEAM(pb + 1); ST1(6);
            ST0(7); for (int dup_ = 0; dup_ < NDUP(7); ++dup_) if (SITE(7) && IN(pb + 2)) { if (dup_) __syncthreads(); WAVE_IDS(); unsigned char* ws = KWS();
                pg8::Gemm g{(const bf16_t*)(ws + WS_BIG + BIG_O), (const bf16_t*)(ws + WS_WO + (size_t)j * 1024 * 1024 * (FP8_ATT ? 1 : 2)), nullptr}; pg8::GroupedOrder<4, 0> S; S.init(mrows / 256, 1, G, bid);
                EpiResAdd E{(const bf16_t*)(ws + WS_X), DUMMY(7) ? (bf16_t*)(ws + WS_Y) : (bf16_t*)(ws + WS_X), (const float*)(ws + WS_MOD) + (size_t)layer * 17 * 6144 + 2048, FP8_ATT ? 1.0f / WM_SCALE : 1.0f};
                pg8::gemm_phase<EpiResAdd, pg8::GroupedOrder<4, 0>, false, 1024, 0, 0, true, FP8_ATT ? 1 : 2, (ROTK_MASK & 32) != 0>(lds, g, S, E); if (dup_ == NDUP(7) - 1) STEAL_TAIL((mrows / 256) * 4, 1, true); }
            SEAM(pb + 2); ST1(7);
        }
        ST0(8); for (int dup_ = 0; dup_ < NDUP(8); ++dup_) if (SITE(8) && IN(pb + 3)) { if (dup_) __syncthreads(); WAVE_IDS(); unsigned char* ws = KWS();
            n2_phase(lds, mrows, (const bf16_t*)(ws + WS_X), (const float*)(ws + WS_MOD) + (size_t)layer * 17 * 6144, KIN(7) + layer * 1024, KIN(18) + (size_t)layer * 1024 * 16,
                     (bf16_t*)(ws + WS_H), (float*)(ws + WS_AFF), bid, G); }
        SEAM(pb + 3); ST1(8);
        ST0(9); for (int dup_ = 0; dup_ < NDUP(9); ++dup_) if (SITE(9) && IN(pb + 4)) { if (dup_) __syncthreads(); WAVE_IDS(); unsigned char* ws = KWS();
            const float* aff = (const float*)(ws + WS_AFF); int* rowidx = (int*)(ws + WS_ROWIDX); float* gate = (float*)(ws + WS_GATE); int* tokslot = (int*)(ws + WS_TOKSLOT);
            for (int p = bid; p < 256; p += G) { const int b = p >> 4, e = p & 15; tk_pair(lds, aff, e, b * 4096, e * SLOTS_E + b * CAPL, !lastl, ML + b * 256, e * SLOTS_E + NB * CAPL + b * CAPC, rowidx, gate, tokslot + (size_t)e * MT); }
            if (STEAL && dup_ == NDUP(9) - 1) { STEAL_ARGS(); steal_convert(lds, sq + 64 * layer, sa, layer, STEAL_NCHUNKS); }
        }
        SEAM(pb + 4); ST1(9);
        const int nMe = lastl ? 32 : 34;
        ST0(10); for (int dup_ = 0; dup_ < NDUP(10); ++dup_) if (SITE(10) && IN(pb + 5)) { if (dup_) __syncthreads(); WAVE_IDS(); unsigned char* ws = KWS();
            pg8::Gemm g{(const bf16_t*)(ws + WS_H), (const bf16_t*)(ws + WS_W13 + (size_t)layer * 16 * 4096 * 1024), (const int*)(ws + WS_ROWIDX)}; pg8::GroupedOrder<16, 34> S; S.init(nMe, 16, G, bid);
            EpiSwiGLU E{(unsigned char*)(ws + WS_BIG)};
#if ABL_E1
            { EpiSwiGLU Ed{(unsigned char*)(ws + WS_Y)}; pg8::gemm_phase<EpiSwiGLU, pg8::GroupedOrder<16, 34>, true, 1024, (size_t)4096 * 1024, 0, ALIGN_E12, 1, (ROTK_MASK & 1) != 0, (ABL_E1) & 255>(lds, g, S, Ed); __syncthreads(); }
#endif
            pg8::gemm_phase<EpiSwiGLU, pg8::GroupedOrder<16, 34>, true, 1024, (size_t)4096 * 1024, 0, ALIGN_E12, 1, (ROTK_MASK & 1) != 0>(lds, g, S, E); }
        SEAM(pb + 5); ST1(10);
        ST0(11); for (int dup_ = 0; dup_ < NDUP(11); ++dup_) if (SITE(11) && IN(pb + 6)) { if (dup_) __syncthreads(); WAVE_IDS(); unsigned char* ws = KWS();
            pg8::Gemm g{(const bf16_t*)(ws + WS_BIG), (const bf16_t*)(ws + WS_W2 + (size_t)layer * 16 * 1024 * 2048), nullptr}; pg8::GroupedOrder<4, 34, true> S; S.init(nMe, 16, G, bid);
            EpiGateY E{(unsigned char*)(ws + WS_Y), (const float*)(ws + WS_GATE)};
            pg8::gemm_phase<EpiGateY, pg8::GroupedOrder<4, 34, true>, false, 2048, (size_t)1024 * 2048, 0, ALIGN_E12, 1, (ROTK_MASK & 2) != 0>(lds, g, S, E); if (dup_ == NDUP(11) - 1) STEAL_TAIL(nMe * 4 * 16, 4, false); }
        SEAM(pb + 6); ST1(11);
        ST0(12); for (int dup_ = 0; dup_ < NDUP(12); ++dup_) if (SITE(12) && IN(pb + 7)) { if (dup_) __syncthreads(); WAVE_IDS(); unsigned char* ws = KWS();
            const float* modl = (const float*)(ws + WS_MOD) + (size_t)layer * 17 * 6144;
            if (!lastl) n1_phase(1, MT, (const bf16_t*)(ws + WS_X), DUMMY(12) ? (bf16_t*)(ws + WS_BIG) : (bf16_t*)(ws + WS_X), nullptr, (const unsigned char*)(ws + WS_Y), (const int*)(ws + WS_TOKSLOT), modl, modl + 17 * 6144, KIN(6) + (layer + 1) * 1024,
                                 DUMMY(12) ? (bf16_t*)(ws + WS_BIG + 300 * MiB) : (bf16_t*)(ws + WS_H), gw, NGW, lane, ((layer + 1) & 1) ? (FP8D_SIM & 2) != 0 : (FP8D_SIM & 1) != 0, FP8_ATT && ((layer + 1) & 1));
            else n1_phase(2, ML, (const bf16_t*)(ws + WS_X), nullptr, DUMMY(12) ? (float*)(ws + WS_BIG) : KOUT(), (const unsigned char*)(ws + WS_Y), (const int*)(ws + WS_TOKSLOT), modl, nullptr, KIN(22), nullptr, gw, NGW, lane);
        }
        SEAM(pb + 7); ST1(12);
    }
#undef IN
#undef SEAM
}

extern "C" void kernel_launch(void* const* d_in, const int* in_sizes, int n_in, void* d_out, int out_size, void* d_ws, size_t ws_size, hipStream_t stream) {
    static int grid = 0;
    if (grid == 0) {
        if (n_in != 23 || out_size != ML * D || ws_size < WS_END) { fprintf(stderr, "kernel_launch: unexpected shapes (n_in %d, out %d, ws %zu); nothing launched\n", n_in, out_size, ws_size); grid = -1; return; }
        int dev = 0, cus = 0, per_cu = 0;
        if (hipGetDevice(&dev) != hipSuccess || hipDeviceGetAttribute(&cus, hipDeviceAttributeMultiprocessorCount, dev) != hipSuccess) { grid = -1; return; }
        if (hipFuncSetAttribute((const void*)mega_fwd, hipFuncAttributeMaxDynamicSharedMemorySize, LDS_BYTES) != hipSuccess) { fprintf(stderr, "kernel_launch: hipFuncSetAttribute failed\n"); grid = -1; return; }
        if (hipOccupancyMaxActiveBlocksPerMultiprocessor(&per_cu, (const void*)mega_fwd, 512, LDS_BYTES) != hipSuccess || per_cu < 1)
            fprintf(stderr, "kernel_launch: note: occupancy query reports %d workgroups per CU\n", per_cu);
        (void)hipGetLastError();
        grid = cus;
    }
    if (grid < 0) return;
    if (hipMemsetAsync((char*)d_ws + WS_CTL, 0, CTL_ZERO_BYTES, stream) != hipSuccess) return;
    Args a{};
    for (int i = 0; i < 23; ++i) a.in[i] = (const float*)d_in[i];
    a.out = (float*)d_out; a.ws = (unsigned char*)d_ws;
    constexpr int NPH = 2 + 8 * DEPTH;
#if MK_SPLIT
    for (int p = 0; p < NPH; ++p) { a.ph_lo = p; a.ph_hi = p + 1; hipLaunchKernelGGL(mega_fwd, dim3(grid), dim3(512), LDS_BYTES, stream, a); }
#else
    a.ph_lo = 0; a.ph_hi = NPH;
    hipLaunchKernelGGL(mega_fwd, dim3(grid), dim3(512), LDS_BYTES, stream, a);
#endif
    const hipError_t le = hipPeekAtLastError();
    if (le != hipSuccess) fprintf(stderr, "kernel_launch: launch failed: %s\n", hipGetErrorName(le));
}
```

```cpp
#include <hip/hip_runtime.h>
#include <cstdio>
#include <cstdint>

#define LAS __attribute__((address_space(3)))
#define GAS __attribute__((address_space(1)))
typedef unsigned short bf16_t;
typedef short bf16x8 __attribute__((ext_vector_type(8)));
typedef short s16x4 __attribute__((ext_vector_type(4)));
typedef float f32x4 __attribute__((ext_vector_type(4)));
typedef float f32x2 __attribute__((ext_vector_type(2)));
typedef float f32x16 __attribute__((ext_vector_type(16)));
typedef unsigned u32x4 __attribute__((ext_vector_type(4)));
typedef unsigned u32x2 __attribute__((ext_vector_type(2)));
typedef short v4i16_t __attribute__((ext_vector_type(4)));
#define DI __device__ __forceinline__

#ifndef MK_SPLIT
#define MK_SPLIT 0
#endif

constexpr int D = 1024, NB = 16, SEQ = 4096, CTX = 256, DEPTH = 4;
constexpr int ML = NB * SEQ, MC = NB * CTX, MT = ML + MC;
constexpr int DA = 2048, NE = 16, CAPL = 512, CAPC = 32;
constexpr int SLOTS_E = NB * CAPL + NB * CAPC;
constexpr int NSLOT = NE * SLOTS_E;
constexpr int DFF = 2048, NQKV = 1536;
constexpr float EPS = 1e-6f;
constexpr float LOG2E = 1.4426950408889634f;
constexpr float W13_SCALE = 32.0f, W2_SCALE = 64.0f, Y_SCALE = 32.0f, WM_SCALE = 32.0f;
constexpr float QSCALE = 0.125f * LOG2E;

constexpr size_t MiB = 1u << 20;
constexpr size_t WS_CTL = 0, CTL_ZERO_BYTES = 64 * 1024;
constexpr size_t WS_MOD = 1 * MiB;
constexpr size_t WS_ROPE = 3 * MiB;
constexpr size_t WS_AFF = 4 * MiB;
constexpr size_t WS_TOKSLOT = 9 * MiB;
constexpr size_t WS_ROWIDX = 14 * MiB;
constexpr size_t WS_GATE = 15 * MiB;
constexpr size_t WS_STATS = 16 * MiB;
constexpr size_t WS_XC = 34 * MiB;
constexpr size_t WS_WIN = 50 * MiB;
constexpr size_t WS_WOUT = 66 * MiB;
constexpr size_t WS_WQKV = 74 * MiB;
constexpr size_t WS_WO = 80 * MiB;
constexpr size_t WS_WSP = 84 * MiB;
constexpr size_t WS_W13 = 86 * MiB;
constexpr size_t WS_W2 = 598 * MiB;
constexpr size_t WS_H = 854 * MiB;
constexpr size_t WS_BIG = 990 * MiB;
constexpr size_t WS_Y = 1534 * MiB;
constexpr size_t WS_X = 1806 * MiB;
constexpr size_t WS_END = 1942 * MiB;
constexpr size_t BIG_U = 0, BIG_V = (size_t)MT * 2048 * 2;
constexpr size_t BIG_Q = 0, BIG_K = (size_t)MT * 1024 * 2, BIG_VV = BIG_K + (size_t)MT * 256 * 2, BIG_O = BIG_VV + (size_t)MT * 256 * 2;
static_assert(BIG_O + (size_t)MT * 1024 * 2 <= 544 * MiB && (size_t)NSLOT * 2048 * 2 <= 544 * MiB && BIG_V + (size_t)MT * 2048 * 2 <= 544 * MiB, "big region");
static_assert(WS_STATS + (size_t)MT * 64 * 4 <= WS_XC && WS_AFF + (size_t)MT * 64 <= WS_TOKSLOT && WS_TOKSLOT + (size_t)MT * 64 <= WS_ROWIDX, "ws map");
constexpr int CW_BAR = 4096;
constexpr int CW_STEAL = 1024;

constexpr int RING_BYTES = 131072;
constexpr int MISC_OFF = RING_BYTES + 320;
constexpr int XCH_OFF = RING_BYTES + 1024;
constexpr int LDS_BYTES = 147456;
static_assert(MISC_OFF + 128 <= XCH_OFF && XCH_OFF + 8192 <= LDS_BYTES, "LDS map");

DI unsigned pk2(float lo, float hi) { unsigned r; asm("v_cvt_pk_bf16_f32 %0, %1, %2" : "=v"(r) : "v"(lo), "v"(hi)); return r; }
DI unsigned pk4_fp8(float a, float b, float c, float d) { int p = __builtin_amdgcn_cvt_pk_fp8_f32(a, b, 0, false); p = __builtin_amdgcn_cvt_pk_fp8_f32(c, d, p, true); return (unsigned)p; }
#ifndef POLL_TOP
#define POLL_TOP 0
#endif
#ifndef EARLY_ACQ
#define EARLY_ACQ 1
#endif
#ifndef FLAT_REL
#define FLAT_REL 1
#endif
#ifndef FP8_ATT
#define FP8_ATT 1
#endif
#ifndef ABL_E1
#define ABL_E1 0
#endif
#ifndef ROTK_MASK
#define ROTK_MASK 0
#endif
#ifndef FP8D_SIM
#define FP8D_SIM 0
#endif
DI float sim8(float v, bool on) { if (!FP8D_SIM || !on) return v; const int p = __builtin_amdgcn_cvt_pk_fp8_f32(v, v, 0, false); return __builtin_amdgcn_cvt_f32_fp8(p, 0); }
DI float bflo(unsigned w) { return __uint_as_float(w << 16); }
DI float bfhi(unsigned w) { return __uint_as_float(w & 0xffff0000u); }
typedef unsigned u32v2_t __attribute__((ext_vector_type(2)));
#define DPP_F(v, ctrl) __uint_as_float((unsigned)__builtin_amdgcn_mov_dpp((int)__float_as_uint(v), ctrl, 0xF, 0xF, true))
#define DPP_I(v, ctrl) __builtin_amdgcn_mov_dpp((v), ctrl, 0xF, 0xF, true)
DI float xor1_f(float v) { return DPP_F(v, 0xB1); }
DI float xor2_f(float v) { return DPP_F(v, 0x4E); }
DI float row16_sum(float v) { v += DPP_F(v, 0xB1); v += DPP_F(v, 0x4E); v += DPP_F(v, 0x141); v += DPP_F(v, 0x140); return v; }
DI float row16_max(float v) { v = fmaxf(v, DPP_F(v, 0xB1)); v = fmaxf(v, DPP_F(v, 0x4E)); v = fmaxf(v, DPP_F(v, 0x141)); v = fmaxf(v, DPP_F(v, 0x140)); return v; }
DI int row16_sum_i(int v) { v += DPP_I(v, 0xB1); v += DPP_I(v, 0x4E); v += DPP_I(v, 0x141); v += DPP_I(v, 0x140); return v; }
DI float x16_sum(float v) { const unsigned x = __float_as_uint(v); const u32v2_t r = __builtin_amdgcn_permlane16_swap(x, x, false, false); return __uint_as_float(r[0]) + __uint_as_float(r[1]); }
DI float x32_sum(float v) { const unsigned x = __float_as_uint(v); const u32v2_t r = __builtin_amdgcn_permlane32_swap(x, x, false, false); return __uint_as_float(r[0]) + __uint_as_float(r[1]); }
DI float x32_max(float v) { const unsigned x = __float_as_uint(v); const u32v2_t r = __builtin_amdgcn_permlane32_swap(x, x, false, false); return fmaxf(__uint_as_float(r[0]), __uint_as_float(r[1])); }
DI int x16_sum_i(int v) { const u32v2_t r = __builtin_amdgcn_permlane16_swap((unsigned)v, (unsigned)v, false, false); return (int)(r[0] + r[1]); }
DI int x32_sum_i(int v) { const u32v2_t r = __builtin_amdgcn_permlane32_swap((unsigned)v, (unsigned)v, false, false); return (int)(r[0] + r[1]); }
DI float wave_sum(float v) { return x32_sum(x16_sum(row16_sum(v))); }
DI int wave_sum_i(int v) { return x32_sum_i(x16_sum_i(row16_sum_i(v))); }
DI int tid_opaque() { int t = threadIdx.x; asm volatile("" : "+v"(t)); return t; }
#define LDS_WAIT() asm volatile("s_waitcnt lgkmcnt(0)" ::: "memory")
#define VM_WAIT() asm volatile("s_waitcnt vmcnt(0)" ::: "memory")
#define RLX_AGENT __ATOMIC_RELAXED, __HIP_MEMORY_SCOPE_AGENT

#define XB_TMO      128
#define XB_XCNT(j)  (256  + 64 * (j))
#define XB_XSUB(j)  (1280 + 64 * (j))
#define XB_XGEN(j)  (2304 + 64 * (j))
#define XB_TOP      3328
#define XB_TOPGEN   3392
#define XCD_BAR_WORDS 3456
#define XB_SPIN_CAP (1u << 18)
DI unsigned xb_ld(unsigned* p)              { return __hip_atomic_load(p, __ATOMIC_RELAXED, __HIP_MEMORY_SCOPE_AGENT); }
DI unsigned xb_add(unsigned* p, unsigned v) { return __hip_atomic_fetch_add(p, v, __ATOMIC_RELAXED, __HIP_MEMORY_SCOPE_AGENT); }
DI unsigned xb_xcc_id() { return (unsigned)__builtin_amdgcn_s_getreg((3 << 11) | 20) & 0xFu; }
#define XB_SPIN(cond, bar) do { unsigned _sp = 0; while (cond) { __builtin_amdgcn_s_sleep(1); \
    if ((++_sp & 255u) == 0u) { if (xb_ld(&(bar)[XB_TMO])) break; if (_sp > XB_SPIN_CAP) { atomicAdd(&(bar)[XB_TMO], 1u); break; } } } } while (0)
struct XcdBarrier { unsigned* bar; unsigned x; volatile LAS unsigned* st; };
DI XcdBarrier xcd_barrier_post(unsigned* bar, volatile LAS unsigned* st) {
    XcdBarrier b; b.bar = bar; b.x = (unsigned)__builtin_amdgcn_readfirstlane((int)xb_xcc_id()); b.st = st;
    if (threadIdx.x == 0) (void)xb_add(&bar[XB_XCNT(b.x)], 1u);
    return b;
}
DI void xcd_barrier_complete(unsigned* bar, unsigned x, unsigned& nloc, unsigned& nx) {
    const unsigned G = gridDim.x * gridDim.y * gridDim.z;
    unsigned sum, cnt, mine, sp = 0u;
    for (;;) {
        sum = 0u; cnt = 0u; mine = 0u;
#pragma unroll
        for (unsigned j = 0; j < 16; ++j) { const unsigned c = xb_ld(&bar[XB_XCNT(j)]); sum += c; cnt += (c > 0u) ? 1u : 0u; mine = (j == x) ? c : mine; }
        if (sum == G) break;
        __builtin_amdgcn_s_sleep(1);
        if ((++sp & 255u) == 0u) { if (xb_ld(&bar[XB_TMO])) break; if (sp > XB_SPIN_CAP) { atomicAdd(&bar[XB_TMO], 1u); break; } }
    }
    nloc = mine > 0u ? mine : 1u; nx = cnt > 0u ? cnt : 1u;
}
DI void xcd_barrier(const XcdBarrier& b) {
    asm volatile("s_waitcnt vmcnt(0)" ::: "memory");
    __syncthreads();
    if (threadIdx.x == 0) {
        unsigned* bar = b.bar;
        __builtin_amdgcn_s_waitcnt(0);
        unsigned bx = b.x; asm volatile("" : "+s"(bx));
        unsigned nloc = b.st[0], nx = b.st[1];
        if (nloc == 0u) { xcd_barrier_complete(bar, bx, nloc, nx); b.st[0] = nloc; b.st[1] = nx; }
        if (EARLY_ACQ) __builtin_amdgcn_fence(__ATOMIC_ACQUIRE, "agent");
        const unsigned old = xb_add(&bar[XB_XSUB(bx)], 1u);
        const unsigned gen = old / nloc;
        if (old + 1u == (gen + 1u) * nloc) {
            __builtin_amdgcn_fence(__ATOMIC_RELEASE, "agent");
            asm volatile("s_waitcnt vmcnt(0)" ::: "memory");
            const unsigned og = xb_add(&bar[XB_TOP], 1u);
            const unsigned tg = og / nx;
            if (POLL_TOP) { if (og + 1u != (tg + 1u) * nx) XB_SPIN(xb_ld(&bar[XB_TOP]) < (tg + 1u) * nx, bar); }
            else if (og + 1u == (tg + 1u) * nx) xb_add(&bar[XB_TOPGEN], 1u);
            else XB_SPIN(xb_ld(&bar[XB_TOPGEN]) == tg, bar);
            if (!EARLY_ACQ) __builtin_amdgcn_fence(__ATOMIC_ACQUIRE, "agent");
            if (!FLAT_REL) xb_add(&bar[XB_XGEN(bx)], 1u);
            asm volatile("s_waitcnt vmcnt(0)" ::: "memory");
        } else {
            if (FLAT_REL && POLL_TOP) XB_SPIN(xb_ld(&bar[XB_TOP]) < (gen + 1u) * nx, bar);
            else if (FLAT_REL) XB_SPIN(xb_ld(&bar[XB_TOPGEN]) == gen, bar);
            else XB_SPIN(xb_ld(&bar[XB_XGEN(bx)]) == gen, bar);
            if (!EARLY_ACQ) __builtin_amdgcn_fence(__ATOMIC_ACQUIRE, "agent");
            asm volatile("s_waitcnt vmcnt(0)" ::: "memory");
        }
    }
    __syncthreads();
}

#ifndef FP8_MMA
#define FP8_MMA 3
#endif
#ifndef EPI_TWICE
#define EPI_TWICE 0
#endif
namespace pg8 {
constexpr int BM = 256, BK = 64, HALF = 128, HTB = HALF * BK * 2, STAGE_BYTES = 8 * HTB, NXCD = 8, WGM = 8;
__host__ __device__ __forceinline__ int lds_byte(int r, int c) { const int st = (r >> 4) * 2 + (c >> 5), rr = r & 15, cc = c & 31, ob = rr * 64 + cc * 2; return st * 1024 + (ob ^ (((ob >> 9) & 1) << 5)); }
__host__ __device__ __forceinline__ void stage_rc(int b, int& R, int& C) { const int st = b / 1024, sb = b % 1024, swz = sb ^ (((sb >> 9) & 1) << 5); R = (st >> 1) * 16 + swz / 64; C = (st & 1) * 32 + (swz % 64) / 2; }
__host__ __device__ __forceinline__ int perm32(int rho) { const int n = rho >> 4, i = rho & 15; return 8 * (i >> 2) + 4 * n + (i & 3); }

struct Unit { int pm, pn, e; };
struct Gemm { const bf16_t* A; const bf16_t* Bt; const int* rowidx; };

template <int NN, int MSTRIDE, bool REV = false>
struct GroupedOrder {
    int nM, nwg, G, c;
    __device__ void init(int nM_, int ngroups, int G_, int c_) { nM = nM_; nwg = nM_ * NN * ngroups; G = G_; c = c_; }
    __device__ bool next(int i, Unit& u) const {
        const int L = i * G + c; if (L >= nwg) return false;
        int wgid = L; { const int q = nwg / NXCD, r = nwg % NXCD, xcd = wgid % NXCD; int off = wgid / NXCD; if (REV) off = (xcd < r ? q : q - 1) - off;
            wgid = (xcd < r ? xcd * (q + 1) : r * (q + 1) + (xcd - r) * q) + off; }
        const int per = nM * NN, e = wgid / per, rr = wgid % per;
        constexpr int nig = WGM * NN; const int gid = rr / nig, fm = gid * WGM, gsz = (nM - fm) < WGM ? (nM - fm) : WGM;
        u.pm = e * MSTRIDE + fm + ((rr % nig) % gsz); u.pn = (rr % nig) / gsz; u.e = e; return true;
    }
};

typedef int v8i_t __attribute__((ext_vector_type(8)));
typedef int v4i_t __attribute__((ext_vector_type(4)));
typedef long v2l_t __attribute__((ext_vector_type(2)));
DI const char* sptr(const char* p) {
    const unsigned long long v = (unsigned long long)p; const unsigned lo = (unsigned)__builtin_amdgcn_readfirstlane((int)(unsigned)v), hi = (unsigned)__builtin_amdgcn_readfirstlane((int)(unsigned)(v >> 32));
    return (const char*)(((unsigned long long)hi << 32) | lo); }
DI v8i_t ld32(const LAS unsigned char* p0, const LAS unsigned char* p1) {
    const v4i_t a = *(const LAS v4i_t*)p0, b = *(const LAS v4i_t*)p1; return __builtin_shufflevector(a, b, 0, 1, 2, 3, 4, 5, 6, 7); }
DI f32x4 mma_fp8(const v8i_t X, const v8i_t Y, f32x4 c, const int sc) {
#if FP8_MMA == 3
    asm volatile("v_mfma_scale_f32_16x16x128_f8f6f4 %0, %1, %2, %0, %3, %3 op_sel_hi:[0,0,0]" : "+v"(c) : "v"(X), "v"(Y), "v"(sc));
    return c;
#elif FP8_MMA == 2
    return __builtin_amdgcn_mfma_scale_f32_16x16x128_f8f6f4(X, Y, c, 0, 0, 0, 0x7F7F7F7F, 0, 0x7F7F7F7F);
#else
    const v4i_t xl = __builtin_shufflevector(X, X, 0, 1, 2, 3), xh = __builtin_shufflevector(X, X, 4, 5, 6, 7), yl = __builtin_shufflevector(Y, Y, 0, 1, 2, 3), yh = __builtin_shufflevector(Y, Y, 4, 5, 6, 7);
    const v2l_t x0 = __builtin_bit_cast(v2l_t, xl), x1 = __builtin_bit_cast(v2l_t, xh), y0 = __builtin_bit_cast(v2l_t, yl), y1 = __builtin_bit_cast(v2l_t, yh);
    c = __builtin_amdgcn_mfma_f32_16x16x32_fp8_fp8(x0[0], y0[0], c, 0, 0, 0); c = __builtin_amdgcn_mfma_f32_16x16x32_fp8_fp8(x0[1], y0[1], c, 0, 0, 0);
    c = __builtin_amdgcn_mfma_f32_16x16x32_fp8_fp8(x1[0], y1[0], c, 0, 0, 0); c = __builtin_amdgcn_mfma_f32_16x16x32_fp8_fp8(x1[1], y1[1], c, 0, 0, 0);
    return c;
#endif
}
DI unsigned cvt_pk_bf16(float lo, float hi) { unsigned r; asm volatile("v_cvt_pk_bf16_f32 %0, %1, %2" : "=v"(r) : "v"(lo), "v"(hi)); return r; }

template <class Epi, class Sched, bool GATHER, int K, size_t BSTRIDE, int STAG = 0, bool ALIGN = true, int ESZ = 2, bool ROTK = false, int ABL = 0>
DI void gemm_phase(LAS unsigned char* lds, const Gemm g, const Sched& S, const Epi& E) {
    if constexpr (STAG > 0) { const int ng = (int)((blockIdx.x * 5u) & 7u); for (int i = 0; i < ng; ++i) __builtin_amdgcn_s_sleep(STAG); }
    const int tid = tid_opaque(), wid = __builtin_amdgcn_readfirstlane(tid >> 6), lane = tid & 63, wr = wid >> 2, wc = wid & 3, fr = lane & 15, fq = lane >> 4;
    constexpr int RB = K * ESZ, nt = RB / 128;
    int fp8sc = 0x7F7F7F7F; asm volatile("" : "+v"(fp8sc));
    unsigned voffA[2], voffB[2];
#pragma unroll
    for (int i = 0; i < 2; ++i) { int R, C; stage_rc(tid * 16 + i * 8192, R, C); const int Rb = Epi::PERM ? ((R & ~31) + perm32(R & 31)) : R;
        voffA[i] = (unsigned)(R * RB + C * 2); voffB[i] = (unsigned)(Rb * RB + C * 2); }
    constexpr size_t kstep = (size_t)(BK * 2);
    constexpr size_t hstep = (size_t)HALF * RB;
    constexpr size_t tstep = 2 * hstep;
    const unsigned ldsw = (unsigned)wid * 1024u;
    const int aoff = lds_byte(wr * 64 + fr, fq * 8), boff = lds_byte(wc * 32 + fr, fq * 8);
#define PG8_SA(b, h) (((b) * 2 + (h)) * HTB)
#define PG8_SB(b, h) ((4 + (b) * 2 + (h)) * HTB)
#define PG8_STAGE(bufoff, gbase, voff) do { if constexpr (ABL & 1) break; const char* _gb = sptr((const char*)(gbase)); _Pragma("unroll") for (int _i = 0; _i < 2; ++_i) \
        __builtin_amdgcn_global_load_lds((const unsigned*)(_gb + (voff)[_i]), (LAS unsigned*)(lds + (bufoff) + ldsw + _i * 8192), 16, 0, 0); } while (0)
#define PG8_STAGE_AC(bufoff, kb, h) do { if constexpr (GATHER) PG8_STAGE(bufoff, Ab + (kb), cOff[h]); else PG8_STAGE(bufoff, cA + (h) * hstep + (kb), voffA); } while (0)
#define PG8_STAGE_AN(bufoff, kb, h) do { if constexpr (GATHER) { if (last) PG8_STAGE(bufoff, Ab + (kb), nOff[h]); else PG8_STAGE(bufoff, Ab + (kb), cOff[h]); } \
        else PG8_STAGE(bufoff, (last ? nA : cA) + (h) * hstep + (kb), voffA); } while (0)
#define PG8_LDA(dst, b, h) do { if constexpr ((ABL & 4) || (ABL & 32)) break; if constexpr (ESZ == 2) { _Pragma("unroll") for (int m = 0; m < 4; ++m) _Pragma("unroll") for (int k = 0; k < 2; ++k) dst[m][k] = *(const LAS bf16x8*)(lds + PG8_SA(b, h) + aoff + m * 2048 + k * 1024); } \
        else { _Pragma("unroll") for (int m = 0; m < 4; ++m) dst##8[m] = ld32(lds + PG8_SA(b, h) + aoff + m * 2048, lds + PG8_SA(b, h) + aoff + m * 2048 + 1024); } } while (0)
#define PG8_LDB(dst, b, h) do { if constexpr ((ABL & 4) || (ABL & 16)) break; if constexpr (ESZ == 2) { _Pragma("unroll") for (int n = 0; n < 2; ++n) _Pragma("unroll") for (int k = 0; k < 2; ++k) dst[n][k] = *(const LAS bf16x8*)(lds + PG8_SB(b, h) + boff + n * 2048 + k * 1024); } \
        else { _Pragma("unroll") for (int n = 0; n < 2; ++n) dst##8[n] = ld32(lds + PG8_SB(b, h) + boff + n * 2048, lds + PG8_SB(b, h) + boff + n * 2048 + 1024); } } while (0)
#define PG8_MMA(ai, bj, At, Bt) do { if constexpr (ABL & 2) break; if constexpr (!(ABL & 64)) __builtin_amdgcn_s_setprio(1); _Pragma("unroll") for (int m = 0; m < 4; ++m) _Pragma("unroll") for (int n = 0; n < 2; ++n) { \
        if constexpr (ESZ == 2) { _Pragma("unroll") for (int k = 0; k < 2; ++k) acc[ai][bj][m][n] = __builtin_amdgcn_mfma_f32_16x16x32_bf16(Bt[n][k], At[m][k], acc[ai][bj][m][n], 0, 0, 0); } \
        else acc[ai][bj][m][n] = mma_fp8(Bt##8[n], At##8[m], acc[ai][bj][m][n], fp8sc); } if constexpr (!(ABL & 64)) __builtin_amdgcn_s_setprio(0); } while (0)
#define PG8_WAIT_V(n) asm volatile("s_waitcnt vmcnt(" #n ")" ::: "memory")
#define PG8_WAIT_L(n) asm volatile("s_waitcnt lgkmcnt(" #n ")" ::: "memory")
#define PG8_BAR __builtin_amdgcn_s_barrier()
#define PG8_SCHED __builtin_amdgcn_sched_barrier(0)
#define PG8_AOFF(dst, u) do { int _t = threadIdx.x; asm volatile("" : "+v"(_t)); _Pragma("unroll") for (int _h = 0; _h < 2; ++_h) _Pragma("unroll") for (int _i = 0; _i < 2; ++_i) { int _R, _C; stage_rc(_t * 16 + _i * 8192, _R, _C); \
        const int _row = g.rowidx[(u).pm * BM + _h * HALF + _R]; dst[_h][_i] = (unsigned)_row * (unsigned)RB + (unsigned)_C * 2u; } } while (0)
    Unit cur, nxt; int ui = 0;
    if (!S.next(0, cur)) return;
#define PG8_KOFF(s_, i_) ((size_t)(ROTK ? (((s_) + (i_)) & (nt - 1)) : (i_)) * kstep)
    int rs_c = ROTK ? __builtin_amdgcn_readfirstlane((cur.pm + 2 * cur.pn) & 7) : 0, rs_n = 0; (void)rs_n;
    f32x4 acc[2][2][4][2];
#pragma unroll
    for (int a = 0; a < 2; ++a)
#pragma unroll
        for (int b = 0; b < 2; ++b)
#pragma unroll
            for (int m = 0; m < 4; ++m)
#pragma unroll
                for (int n = 0; n < 2; ++n) acc[a][b][m][n] = (f32x4){0.f, 0.f, 0.f, 0.f};
    bf16x8 At[4][2], B0[2][2], B1[2][2]; v8i_t At8[4], B08[2], B18[2]; (void)At; (void)B0; (void)B1; (void)At8; (void)B08; (void)B18;
    if constexpr (ABL & (4 | 16 | 32 | 128)) { for (int m = 0; m < 4; ++m) { At8[m] = (v8i_t){0, 0, 0, 0, 0, 0, 0, 0}; for (int k = 0; k < 2; ++k) At[m][k] = (bf16x8){0, 0, 0, 0, 0, 0, 0, 0}; } for (int n = 0; n < 2; ++n) { B08[n] = B18[n] = (v8i_t){0, 0, 0, 0, 0, 0, 0, 0}; for (int k = 0; k < 2; ++k) B0[n][k] = B1[n][k] = (bf16x8){0, 0, 0, 0, 0, 0, 0, 0}; } }
    unsigned cOff[2][2], nOff[2][2];
    const char* Ab = (const char*)g.A;
    const char* cA = Ab; const char* nA = Ab;
    if constexpr (GATHER) { PG8_AOFF(cOff, cur); } else { cA = Ab + (size_t)cur.pm * tstep; }
    const char* cB = (const char*)g.Bt + (size_t)cur.e * BSTRIDE + (size_t)cur.pn * tstep;
    { const size_t K0 = PG8_KOFF(rs_c, 0); PG8_STAGE(PG8_SB(0, 0), cB + K0, voffB); PG8_STAGE(PG8_SB(0, 1), cB + hstep + K0, voffB); PG8_STAGE_AC(PG8_SA(0, 0), K0, 0); PG8_STAGE_AC(PG8_SA(0, 1), K0, 1); }
    { const size_t K1 = PG8_KOFF(rs_c, 1); PG8_STAGE(PG8_SB(1, 0), cB + K1, voffB); PG8_STAGE_AC(PG8_SA(1, 0), K1, 0); PG8_STAGE(PG8_SB(1, 1), cB + hstep + K1, voffB); }
    if (wr == 1) PG8_BAR;
    PG8_WAIT_V(8); PG8_BAR;
    PG8_WAIT_V(6); PG8_BAR;
    for (;;) {
        const bool has_next = S.next(ui + 1, nxt);
        const char* nB = has_next ? (const char*)g.Bt + (size_t)nxt.e * BSTRIDE + (size_t)nxt.pn * tstep : cB;
        if constexpr (GATHER) {
            if (has_next) { PG8_AOFF(nOff, nxt); }
            else {
#pragma unroll
                for (int h = 0; h < 2; ++h)
#pragma unroll
                    for (int i = 0; i < 2; ++i) nOff[h][i] = cOff[h][i];
            }
        } else nA = has_next ? Ab + (size_t)nxt.pm * tstep : cA;
        if constexpr (ROTK) rs_n = has_next ? __builtin_amdgcn_readfirstlane((nxt.pm + 2 * nxt.pn) & 7) : rs_c;
#pragma unroll 1
        for (int t = 0; t < nt; t += 2) {
            const bool last = (t == nt - 2);
            const size_t k1 = PG8_KOFF(rs_c, t + 1), k2 = last ? PG8_KOFF(rs_n, 0) : PG8_KOFF(rs_c, t + 2), k3 = last ? PG8_KOFF(rs_n, 1) : PG8_KOFF(rs_c, t + 3);
            const char* b2 = (last ? nB : cB) + k2; const char* b3 = (last ? nB : cB) + k3;
            PG8_LDB(B0, 0, 0); if constexpr (!(ABL & 128)) PG8_LDB(B1, 0, 1); PG8_SCHED; PG8_LDA(At, 0, 0); PG8_STAGE_AC(PG8_SA(1, 1), k1, 1);
            PG8_WAIT_V(8); PG8_WAIT_L(0); PG8_BAR; PG8_MMA(0, 0, At, B0); PG8_MMA(0, 1, At, B1); PG8_BAR; PG8_SCHED;
            PG8_LDA(At, 0, 1); PG8_STAGE(PG8_SB(0, 0), b2, voffB); PG8_STAGE(PG8_SB(0, 1), b2 + hstep, voffB); PG8_STAGE_AN(PG8_SA(0, 0), k2, 0);
            PG8_WAIT_V(8); PG8_WAIT_L(0); PG8_BAR; PG8_MMA(1, 0, At, B0); PG8_MMA(1, 1, At, B1); PG8_BAR; PG8_SCHED;
            PG8_LDB(B0, 1, 0); if constexpr (!(ABL & 128)) PG8_LDB(B1, 1, 1); PG8_SCHED; PG8_LDA(At, 1, 0); PG8_STAGE_AN(PG8_SA(0, 1), k2, 1);
            PG8_WAIT_V(8); PG8_WAIT_L(0); PG8_BAR; PG8_MMA(0, 0, At, B0); PG8_MMA(0, 1, At, B1); PG8_BAR; PG8_SCHED;
            PG8_LDA(At, 1, 1); PG8_STAGE(PG8_SB(1, 0), b3, voffB); PG8_STAGE(PG8_SB(1, 1), b3 + hstep, voffB); PG8_STAGE_AN(PG8_SA(1, 0), k3, 0);
            PG8_WAIT_V(8); PG8_WAIT_L(0); PG8_BAR; PG8_MMA(1, 0, At, B0); PG8_MMA(1, 1, At, B1); PG8_BAR; PG8_SCHED;
        }
        if constexpr (ESZ == 1 && FP8_MMA == 3) asm volatile("s_nop 15\n\ts_nop 15\n\ts_nop 15" ::: "memory");
        if constexpr (ALIGN) { if (wr == 0) PG8_BAR; }
        if constexpr (!(ABL & 8)) E(acc, cur, wr, wc, fr, fq);
        if constexpr (GATHER) { if (EPI_TWICE) { asm volatile("" ::: "memory"); E(acc, cur, wr, wc, fr, fq); } }
        if (!has_next) break;
#pragma unroll
        for (int a = 0; a < 2; ++a)
#pragma unroll
            for (int b = 0; b < 2; ++b)
#pragma unroll
                for (int m = 0; m < 4; ++m)
#pragma unroll
                    for (int n = 0; n < 2; ++n) acc[a][b][m][n] = (f32x4){0.f, 0.f, 0.f, 0.f};
        cur = nxt; cB = nB; cA = nA; ++ui; if constexpr (ROTK) rs_c = rs_n;
        if constexpr (GATHER) {
#pragma unroll
            for (int h = 0; h < 2; ++h)
#pragma unroll
                for (int i = 0; i < 2; ++i) cOff[h][i] = nOff[h][i];
        }
        if constexpr (ALIGN) { if (wr == 1) PG8_BAR; }
    }
    PG8_WAIT_V(0);
    if constexpr (!ALIGN) { if (wr == 0) PG8_BAR; }
    PG8_BAR;
#undef PG8_SA
#undef PG8_SB
#undef PG8_STAGE
#undef PG8_STAGE_AC
#undef PG8_STAGE_AN
#undef PG8_LDA
#undef PG8_LDB
#undef PG8_MMA
#undef PG8_WAIT_V
#undef PG8_WAIT_L
#undef PG8_BAR
#undef PG8_SCHED
#undef PG8_AOFF
#undef PG8_KOFF
}
}

using pg8::Unit;
DI f32x2 gelu_tanh2(f32x2 x) {
    constexpr float K0 = -2.0f * 0.7978845608028654f * LOG2E, K1 = K0 * 0.044715f;
    const f32x2 t = x * ((x * x) * K1 + K0);
    f32x2 e; e.x = __builtin_amdgcn_exp2f(t.x); e.y = __builtin_amdgcn_exp2f(t.y);
    const f32x2 d = e + 1.0f;
    f32x2 rinv; rinv.x = __builtin_amdgcn_rcpf(d.x); rinv.y = __builtin_amdgcn_rcpf(d.y);
    return x * rinv;
}
DI f32x4 gelu_tanh4(f32x4 v) { const f32x2 a = gelu_tanh2((f32x2){v[0], v[1]}), b = gelu_tanh2((f32x2){v[2], v[3]}); return (f32x4){a.x, a.y, b.x, b.y}; }
DI f32x2 silu_mul2(f32x2 a, f32x2 b) {
    const f32x2 t = a * (-LOG2E);
    f32x2 e; e.x = __builtin_amdgcn_exp2f(t.x); e.y = __builtin_amdgcn_exp2f(t.y);
    const f32x2 d = e + 1.0f;
    f32x2 rinv; rinv.x = __builtin_amdgcn_rcpf(d.x); rinv.y = __builtin_amdgcn_rcpf(d.y);
    return (a * b) * rinv;
}
struct EpiGeluUV {
    static constexpr bool PERM = true;
    bf16_t* U; bf16_t* V; const float* bias; float* stats; LAS unsigned char* xl;
    DI void operator()(const f32x4 (&acc)[2][2][4][2], const Unit& u, int wr, int wc, int fr_in, int fq_in) const {
        int fr = fr_in, fq = fq_in; asm volatile("" : "+v"(fr), "+v"(fq));
        const int row0 = u.pm * 256 + wr * 64 + fr; const bool isV = u.pn >= 8;
        bf16_t* base = isV ? V : U; const int col0 = (u.pn & 7) * 256 + wc * 32 + 8 * fq, bcol0 = u.pn * 256 + wc * 32 + 8 * fq;
        f32x4 bv[2][2];
#pragma unroll
        for (int bj = 0; bj < 2; ++bj)
#pragma unroll
            for (int n = 0; n < 2; ++n) bv[bj][n] = *(const f32x4*)(bias + bcol0 + bj * 128 + 4 * n);
#pragma unroll
        for (int ai = 0; ai < 2; ++ai)
#pragma unroll
            for (int m = 0; m < 4; ++m) { const int row = row0 + ai * 128 + m * 16; bf16_t* rowp = base + (size_t)row * 2048 + col0; float s = 0.f, q = 0.f;
#pragma unroll
                for (int bj = 0; bj < 2; ++bj) { const f32x4 v0 = gelu_tanh4(acc[ai][bj][m][0] + bv[bj][0]), v1 = gelu_tanh4(acc[ai][bj][m][1] + bv[bj][1]);
                    s += ((v0[0] + v0[1]) + (v0[2] + v0[3])) + ((v1[0] + v1[1]) + (v1[2] + v1[3]));
                    q += ((v0[0] * v0[0] + v0[1] * v0[1]) + (v0[2] * v0[2] + v0[3] * v0[3])) + ((v1[0] * v1[0] + v1[1] * v1[1]) + (v1[2] * v1[2] + v1[3] * v1[3]));
                    u32x4 w; w.x = pg8::cvt_pk_bf16(v0[0], v0[1]); w.y = pg8::cvt_pk_bf16(v0[2], v0[3]); w.z = pg8::cvt_pk_bf16(v1[0], v1[1]); w.w = pg8::cvt_pk_bf16(v1[2], v1[3]);
                    *(u32x4*)(rowp + bj * 128) = w; }
                if (isV) { s = x32_sum(x16_sum(s)); q = x32_sum(x16_sum(q));
                    if (fq == 0) *(LAS f32x2*)(xl + ((ai * 128 + wr * 64 + m * 16 + fr) * 4 + wc) * 8) = (f32x2){s, q}; }
                asm volatile("" ::: "memory"); }
        if (isV) {
            asm volatile("s_waitcnt lgkmcnt(0)" ::: "memory"); __builtin_amdgcn_s_barrier(); asm volatile("" ::: "memory");
            const int t = (wr * 4 + wc) * 64 + fq * 16 + fr;
            if (t < 256) { const f32x4 a = *(const LAS f32x4*)(xl + t * 32), b = *(const LAS f32x4*)(xl + t * 32 + 16);
                *(f32x2*)(stats + ((size_t)(u.pm * 256 + t) * 8 + (u.pn - 8)) * 2) = (f32x2){(a[0] + a[2]) + (b[0] + b[2]), (a[1] + a[3]) + (b[1] + b[3])}; }
        }
    }
};
struct EpiResAdd {
    static constexpr bool PERM = true;
    const bf16_t* X; bf16_t* Xo; const float* gate; float asc;
    DI void operator()(const f32x4 (&acc)[2][2][4][2], const Unit& u, int wr, int wc, int fr_in, int fq_in) const {
        int fr = fr_in, fq = fq_in; asm volatile("" : "+v"(fr), "+v"(fq));
        const int b = u.pm < 256 ? (u.pm >> 4) : 16;
        const int row0 = u.pm * 256 + wr * 64 + fr, col0 = u.pn * 256 + wc * 32 + 8 * fq;
        f32x4 gv[2][2];
#pragma unroll
        for (int bj = 0; bj < 2; ++bj)
#pragma unroll
            for (int n = 0; n < 2; ++n) gv[bj][n] = *(const f32x4*)(gate + (size_t)b * 6144 + col0 + bj * 128 + 4 * n) * asc;
#pragma unroll
        for (int ai = 0; ai < 2; ++ai) {
            u32x4 xv[4][2];
#pragma unroll
            for (int m = 0; m < 4; ++m)
#pragma unroll
                for (int bj = 0; bj < 2; ++bj) xv[m][bj] = *(const u32x4*)(X + (size_t)(row0 + ai * 128 + m * 16) * D + col0 + bj * 128);
#pragma unroll
            for (int m = 0; m < 4; ++m)
#pragma unroll
                for (int bj = 0; bj < 2; ++bj) { const u32x4 w = xv[m][bj]; const f32x4 a0 = acc[ai][bj][m][0] * gv[bj][0], a1 = acc[ai][bj][m][1] * gv[bj][1];
                    u32x4 o; o.x = pk2(bflo(w.x) + a0[0], bfhi(w.x) + a0[1]); o.y = pk2(bflo(w.y) + a0[2], bfhi(w.y) + a0[3]); o.z = pk2(bflo(w.z) + a1[0], bfhi(w.z) + a1[1]); o.w = pk2(bflo(w.w) + a1[2], bfhi(w.w) + a1[3]);
                    *(u32x4*)(Xo + (size_t)(row0 + ai * 128 + m * 16) * D + col0 + bj * 128) = o; }
            asm volatile("" ::: "memory"); }
    }
};
struct EpiQKV {
    static constexpr bool PERM = true;
    bf16_t *Q, *Kb, *Vb; const float* cosT; const float* sinT;
    DI void operator()(const f32x4 (&acc)[2][2][4][2], const Unit& u, int wr, int wc, int fr_in, int fq_in) const {
        int fr = fr_in, fq = fq_in; asm volatile("" : "+v"(fr), "+v"(fq));
        const int row0 = u.pm * 256 + wr * 64 + fr; const bool lat = u.pm < 256;
        const int cin = wc * 32 + 8 * fq, kk0 = 16 * (wc & 1) + 4 * fq;
        bf16_t* base; int ld; float sc; bool rope;
        constexpr float ws_ = FP8_ATT ? 1.0f / WM_SCALE : 1.0f;
        if (u.pn < 4) { base = Q + u.pn * 256 + cin; ld = 1024; sc = QSCALE * ws_; rope = lat; }
        else if (u.pn == 4) { base = Kb + cin; ld = 256; sc = ws_; rope = lat; }
        else { base = Vb + cin; ld = 256; sc = ws_; rope = false; }
#pragma unroll
        for (int ai = 0; ai < 2; ++ai) {
            f32x4 cs[4], sn[4];
#pragma unroll
            for (int m = 0; m < 4; ++m) { cs[m] = (f32x4){1.f, 1.f, 1.f, 1.f}; sn[m] = (f32x4){0.f, 0.f, 0.f, 0.f};
                if (rope) { const int t = (row0 + ai * 128 + m * 16) & 4095; cs[m] = *(const f32x4*)(cosT + t * 32 + kk0); sn[m] = *(const f32x4*)(sinT + t * 32 + kk0); } }
#pragma unroll
            for (int m = 0; m < 4; ++m) { const int row = row0 + ai * 128 + m * 16; bf16_t* rowp = base + (size_t)row * ld;
#pragma unroll
                for (int bj = 0; bj < 2; ++bj) { const f32x4 x1 = acc[ai][bj][m][0], x2 = acc[ai][bj][m][1];
                    const f32x4 o1 = (x1 * cs[m] - x2 * sn[m]) * sc, o2 = (x1 * sn[m] + x2 * cs[m]) * sc;
                    u32x4 w; w.x = pg8::cvt_pk_bf16(o1[0], o1[1]); w.y = pg8::cvt_pk_bf16(o1[2], o1[3]); w.z = pg8::cvt_pk_bf16(o2[0], o2[1]); w.w = pg8::cvt_pk_bf16(o2[2], o2[3]);
                    *(u32x4*)(rowp + bj * 128) = w; } }
            asm volatile("" ::: "memory"); }
    }
};
struct EpiSwiGLU {
    static constexpr bool PERM = true; static constexpr int NST = 0;
    unsigned char* Hm;
    DI void operator()(const f32x4 (&acc)[2][2][4][2], const Unit& u, int wr, int wc, int fr_in, int fq_in) const {
        int fr = fr_in, fq = fq_in; asm volatile("" : "+v"(fr), "+v"(fq));
        const int row0 = u.pm * 256 + wr * 64 + fr, col0 = u.pn * 128 + wc * 32 + 8 * fq;
        constexpr float is = 1.0f / W13_SCALE;
#pragma unroll
        for (int ai = 0; ai < 2; ++ai)
#pragma unroll
            for (int m = 0; m < 4; ++m) { unsigned char* rowp = Hm + (size_t)(row0 + ai * 128 + m * 16) * 2048 + col0;
                const f32x4 a0 = acc[ai][0][m][0] * is, a1 = acc[ai][0][m][1] * is, b0 = acc[ai][1][m][0] * is, b1 = acc[ai][1][m][1] * is;
                const f32x2 h0 = silu_mul2((f32x2){a0[0], a0[1]}, (f32x2){b0[0], b0[1]}), h1 = silu_mul2((f32x2){a0[2], a0[3]}, (f32x2){b0[2], b0[3]});
                const f32x2 h2 = silu_mul2((f32x2){a1[0], a1[1]}, (f32x2){b1[0], b1[1]}), h3 = silu_mul2((f32x2){a1[2], a1[3]}, (f32x2){b1[2], b1[3]});
                u32x2 w; w.x = pk4_fp8(h0.x, h0.y, h1.x, h1.y); w.y = pk4_fp8(h2.x, h2.y, h3.x, h3.y);
                *(u32x2*)rowp = w; }
    }
};
struct EpiGateY {
    static constexpr bool PERM = true;
    unsigned char* Y; const float* gate;
    DI void operator()(const f32x4 (&acc)[2][2][4][2], const Unit& u, int wr, int wc, int fr_in, int fq_in) const {
        int fr = fr_in, fq = fq_in; asm volatile("" : "+v"(fr), "+v"(fq));
        const int row0 = u.pm * 256 + wr * 64 + fr, col0 = u.pn * 256 + wc * 32 + 8 * fq;
        float gts[2][4];
#pragma unroll
        for (int ai = 0; ai < 2; ++ai)
#pragma unroll
            for (int m = 0; m < 4; ++m) gts[ai][m] = gate[row0 + ai * 128 + m * 16] * (Y_SCALE / W2_SCALE);
#pragma unroll
        for (int ai = 0; ai < 2; ++ai)
#pragma unroll
            for (int m = 0; m < 4; ++m) { const int row = row0 + ai * 128 + m * 16; const float gt = gts[ai][m]; unsigned char* rowp = Y + (size_t)row * 1024 + col0;
#pragma unroll
                for (int bj = 0; bj < 2; ++bj) { const f32x4 v0 = acc[ai][bj][m][0] * gt, v1 = acc[ai][bj][m][1] * gt;
                    u32x2 w; w.x = pk4_fp8(v0[0], v0[1], v0[2], v0[3]); w.y = pk4_fp8(v1[0], v1[1], v1[2], v1[3]);
                    *(u32x2*)(rowp + bj * 128) = w; }
                asm volatile("" ::: "memory"); }
    }
};

DI void p0_mod(LAS unsigned char* lds, const float* c, const float* c_ctx, const float* w_mod, const float* b_mod, float* mod, int bid, int G) {
    LAS float* S = (LAS float*)lds;
    LAS float* P = (LAS float*)(lds + 17 * 1024 * 4);
    const int tid = tid_opaque(), wave = tid >> 6, lane = tid & 63;
    for (int i = tid; i < 17 * 1024; i += 512) { const int r = i >> 10, k = i & 1023; const float v = r < 16 ? c[r * 1024 + k] : c_ctx[k]; S[i] = v / (1.0f + __expf(-v)); }
    __syncthreads();
    const int col = lane & 31, kh = lane >> 5;
    for (int item = bid; item < 4 * 192; item += G) {
        const int l = item / 192, nb = item % 192;
        const float* w = w_mod + ((size_t)l * 1024 + wave * 128 + kh * 64) * 6144 + nb * 32 + col;
        const LAS float* Sk = S + wave * 128 + kh * 64;
        float acc[17];
#pragma unroll
        for (int r = 0; r < 17; ++r) acc[r] = 0.f;
#pragma unroll 1
        for (int k16 = 0; k16 < 64; k16 += 16) {
            float wv[16];
#pragma unroll
            for (int j = 0; j < 16; ++j) wv[j] = w[(size_t)(k16 + j) * 6144];
#pragma unroll
            for (int r = 0; r < 17; ++r) {
#pragma unroll
                for (int j4 = 0; j4 < 4; ++j4) { const f32x4 sv = *(const LAS f32x4*)(Sk + r * 1024 + k16 + 4 * j4); acc[r] += (sv[0] * wv[4 * j4] + sv[1] * wv[4 * j4 + 1]) + (sv[2] * wv[4 * j4 + 2] + sv[3] * wv[4 * j4 + 3]); } }
        }
#pragma unroll
        for (int r = 0; r < 17; ++r) { const float t = x32_sum(acc[r]); if (kh == 0) P[(wave * 17 + r) * 32 + col] = t; }
        __syncthreads();
        for (int o = tid; o < 17 * 32; o += 512) { const int r = o >> 5, nn = o & 31; float sm = 0.f;
#pragma unroll
            for (int w8 = 0; w8 < 8; ++w8) sm += P[(w8 * 17 + r) * 32 + nn];
            mod[((size_t)l * 17 + r) * 6144 + nb * 32 + nn] = sm + b_mod[l * 6144 + nb * 32 + nn]; }
        __syncthreads();
    }
}
DI int qk_phys(int d) { return 8 * ((d & 31) >> 2) + (d & 3) + 4 * (d >> 5); }
DI void cvt_item(const float* src, int ldsrc, int K, bf16_t* dst, int k0, int nsrc0, int ndst0, bool perm, LAS unsigned char* Lt, int lane, bool s8 = false) {
    const int kr = lane >> 4, nq = lane & 15;
    f32x4 v[16];
#pragma unroll
    for (int q = 0; q < 16; ++q) v[q] = *(const f32x4*)(src + (size_t)(k0 + 4 * q + kr) * ldsrc + nsrc0 + 4 * nq);
    int prow[4];
#pragma unroll
    for (int i = 0; i < 4; ++i) { const int n = 4 * nq + i; prow[i] = (perm ? qk_phys(n) : n) * 132; }
#pragma unroll
    for (int q = 0; q < 16; ++q) { const int k = 4 * q + kr; if (FP8D_SIM) { for (int i = 0; i < 4; ++i) v[q][i] = sim8(v[q][i] * 32.0f, s8) * (1.0f / 32.0f); } const unsigned w01 = pk2(v[q][0], v[q][1]), w23 = pk2(v[q][2], v[q][3]);
        *(LAS unsigned short*)(Lt + prow[0] + k * 2) = (unsigned short)(w01 & 0xffffu); *(LAS unsigned short*)(Lt + prow[1] + k * 2) = (unsigned short)(w01 >> 16);
        *(LAS unsigned short*)(Lt + prow[2] + k * 2) = (unsigned short)(w23 & 0xffffu); *(LAS unsigned short*)(Lt + prow[3] + k * 2) = (unsigned short)(w23 >> 16); }
    LDS_WAIT();
    const int c = lane & 7;
#pragma unroll
    for (int j = 0; j < 8; ++j) { const int n = (lane >> 3) + 8 * j; const LAS unsigned* s = (const LAS unsigned*)(Lt + n * 132 + 16 * c);
        u32x4 o; o.x = s[0]; o.y = s[1]; o.z = s[2]; o.w = s[3];
        *(u32x4*)(dst + (size_t)(ndst0 + n) * K + k0 + 8 * c) = o; }
    LDS_WAIT();
}
struct P0Args { const float *w_in, *w_out, *w_qkv, *w_o, *w1, *w3, *w2, *w_s; bf16_t *win_t, *wout_t, *wqkv_t, *wo_t, *w13_t, *w2_t, *ws_t; float* cosT; float* sinT; };
constexpr int EXP_ITEMS = 3 * 8192, STEAL_CHUNK = 16, STEAL_NCHUNKS = EXP_ITEMS / STEAL_CHUNK;
DI void cvt_item8(const float* src, int ldsrc, int K, unsigned char* dst, int k0, int nsrc0, int ndst0, float scale, LAS unsigned char* Lt, int lane, bool perm = false) {
    const int kr = lane >> 4, nq = lane & 15;
    f32x4 v[16];
#pragma unroll
    for (int q = 0; q < 16; ++q) v[q] = *(const f32x4*)(src + (size_t)(k0 + 4 * q + kr) * ldsrc + nsrc0 + 4 * nq);
#pragma unroll
    for (int q = 0; q < 16; ++q) { const int k = 4 * q + kr; const unsigned p = pk4_fp8(v[q][0] * scale, v[q][1] * scale, v[q][2] * scale, v[q][3] * scale);
        LAS unsigned char* b = Lt + (perm ? 8 * (nq & 7) + 4 * (nq >> 3) : 4 * nq) * 68 + k;
        b[0] = (unsigned char)(p & 0xffu); b[68] = (unsigned char)((p >> 8) & 0xffu); b[136] = (unsigned char)((p >> 16) & 0xffu); b[204] = (unsigned char)(p >> 24); }
    LDS_WAIT();
    const int c = lane & 3;
#pragma unroll
    for (int j = 0; j < 4; ++j) { const int n = (lane >> 2) + 16 * j; const LAS unsigned* sp = (const LAS unsigned*)(Lt + n * 68 + 16 * c);
        u32x4 o; o.x = sp[0]; o.y = sp[1]; o.z = sp[2]; o.w = sp[3];
        *(u32x4*)(dst + (size_t)(ndst0 + n) * K + k0 + 16 * c) = o; }
    LDS_WAIT();
}
DI void cvt_expert_item(const P0Args& a, int layer, int it, LAS unsigned char* Lt, int lane) {
    const int which = it >> 13, r = it & 8191, e = r >> 9, q = r & 511; const size_t le = (size_t)layer * 16 + e;
    if (which < 2) { const int kb = q >> 5, nb = q & 31; const int ndst = ((nb * 64) >> 7) * 256 + ((nb * 64) & 127) + which * 128;
        cvt_item8((which ? a.w3 : a.w1) + le * 1024 * 2048, 2048, 1024, (unsigned char*)a.w13_t + le * 4096 * 1024, kb * 64, nb * 64, ndst, W13_SCALE, Lt, lane); }
    else { const int kb = q >> 4, nb = q & 15; cvt_item8(a.w2 + le * 2048 * 1024, 1024, 2048, (unsigned char*)a.w2_t + le * 1024 * 2048, kb * 64, nb * 64, nb * 64, W2_SCALE, Lt, lane); }
}
DI void steal_convert(LAS unsigned char* lds, unsigned* q, const P0Args& a, int layer, int max_chunks) {
    const int tid = tid_opaque(), wave = __builtin_amdgcn_readfirstlane(tid >> 6), lane = tid & 63;
    LAS unsigned* slot = (LAS unsigned*)(lds + 8 * 8448); LAS unsigned char* Lt = lds + wave * 8448;
    for (int n = 0; n < max_chunks; ++n) {
        __syncthreads();
        if (tid == 0) *slot = __hip_atomic_fetch_add(q, 1u, __ATOMIC_RELAXED, __HIP_MEMORY_SCOPE_AGENT);
        __syncthreads();
        const unsigned idx = *slot;
        if (idx >= (unsigned)STEAL_NCHUNKS) break;
#pragma unroll 1
        for (int k = 0; k < 2; ++k) cvt_expert_item(a, layer, (int)idx * STEAL_CHUNK + wave * 2 + k, Lt, lane);
    }
    __syncthreads();
}
DI void p0_convert(LAS unsigned char* lds, const P0Args& a, int gw, int NGW, int lane, int wave) {
    LAS unsigned char* Lt = lds + wave * 8448;
    constexpr int I_IN = 2 * 16 * 64, I_OUT = 2 * 32 * 16, I_QKV = 2 * 16 * 24, I_O = 2 * 16 * 16;
    constexpr int NITEMS = I_IN + I_OUT + I_QKV + I_O;
    for (int it = gw; it < NITEMS; it += NGW) {
        int r = it;
        if (r < I_IN) { const int j = r / 1024, q = r % 1024, kb = q / 64, nb = q % 64;
            cvt_item(a.w_in + (size_t)j * 1024 * 4096, 4096, 1024, a.win_t + (size_t)j * 4096 * 1024, kb * 64, nb * 64, nb * 64, false, Lt, lane, (FP8D_SIM & 1) != 0); continue; } r -= I_IN;
        if (r < I_OUT) { const int j = r / 512, q = r % 512, kb = q / 16, nb = q % 16;
            cvt_item(a.w_out + (size_t)j * 2048 * 1024, 1024, 2048, a.wout_t + (size_t)j * 1024 * 2048, kb * 64, nb * 64, nb * 64, false, Lt, lane, (FP8D_SIM & 4) != 0); continue; } r -= I_OUT;
        if (r < I_QKV) { const int j = r / 384, q = r % 384, kb = q / 24, nb = q % 24;
            if (FP8_ATT) cvt_item8(a.w_qkv + (size_t)j * 1024 * 1536, 1536, 1024, (unsigned char*)a.wqkv_t + (size_t)j * 1536 * 1024, kb * 64, nb * 64, nb * 64, WM_SCALE, Lt, lane, nb < 20);
            else cvt_item(a.w_qkv + (size_t)j * 1024 * 1536, 1536, 1024, a.wqkv_t + (size_t)j * 1536 * 1024, kb * 64, nb * 64, nb * 64, nb < 20, Lt, lane, (FP8D_SIM & 2) != 0);
            continue; } r -= I_QKV;
        if (r < I_O) { const int j = r / 256, q = r % 256, kb = q / 16, nb = q % 16;
            if (FP8_ATT) cvt_item8(a.w_o + (size_t)j * 1024 * 1024, 1024, 1024, (unsigned char*)a.wo_t + (size_t)j * 1024 * 1024, kb * 64, nb * 64, nb * 64, WM_SCALE, Lt, lane);
            else cvt_item(a.w_o + (size_t)j * 1024 * 1024, 1024, 1024, a.wo_t + (size_t)j * 1024 * 1024, kb * 64, nb * 64, nb * 64, false, Lt, lane, (FP8D_SIM & 2) != 0);
            continue; } r -= I_O;
    }
    const int gt = gw * 64 + lane, NT = NGW * 64;
    for (int i = gt; i < 2 * 16 * 128 * 128 / 8; i += NT) { const f32x4 x = *(const f32x4*)(a.w_s + (size_t)i * 8), y = *(const f32x4*)(a.w_s + (size_t)i * 8 + 4);
        u32x4 o; o.x = pk2(x[0], x[1]); o.y = pk2(x[2], x[3]); o.z = pk2(y[0], y[1]); o.w = pk2(y[2], y[3]); *(u32x4*)(a.ws_t + (size_t)i * 8) = o; }
    for (int i = gt; i < 4096 * 32; i += NT) { const int t = i >> 5, kk = i & 31; const int pos = kk < 16 ? (t >> 6) : (t & 63); const int j = kk & 15;
        const float inv = exp2f(-(float)j * (13.287712379549449f / 16.0f)); const float ang = (float)pos * inv; a.cosT[i] = cosf(ang); a.sinT[i] = sinf(ang); }
}

DI void unpack8(const u32x4 w, float (&v)[8]) { v[0] = bflo(w.x); v[1] = bfhi(w.x); v[2] = bflo(w.y); v[3] = bfhi(w.y); v[4] = bflo(w.z); v[5] = bfhi(w.z); v[6] = bflo(w.w); v[7] = bfhi(w.w); }
DI void unpack8_fp8(const u32x2 w, float (&v)[8]) { const f32x2 a = __builtin_amdgcn_cvt_pk_f32_fp8((int)w.x, false), b = __builtin_amdgcn_cvt_pk_f32_fp8((int)w.x, true), c = __builtin_amdgcn_cvt_pk_f32_fp8((int)w.y, false), d = __builtin_amdgcn_cvt_pk_f32_fp8((int)w.y, true);
    v[0] = a.x; v[1] = a.y; v[2] = b.x; v[3] = b.y; v[4] = c.x; v[5] = c.y; v[6] = d.x; v[7] = d.y; }
DI u32x4 pack8f(const float (&v)[8]) { u32x4 o; o.x = pk2(v[0], v[1]); o.y = pk2(v[2], v[3]); o.z = pk2(v[4], v[5]); o.w = pk2(v[6], v[7]); return o; }
DI void load8f(const float* p, float (&v)[8]) { const f32x4 a = *(const f32x4*)p, b = *(const f32x4*)(p + 4); v[0] = a[0]; v[1] = a[1]; v[2] = a[2]; v[3] = a[3]; v[4] = b[0]; v[5] = b[1]; v[6] = b[2]; v[7] = b[3]; }
DI void n0_phase(const float* xin, const float* cin, bf16_t* X, const float* mod_cur, const float* gmix, bf16_t* H, int gw, int NGW, int lane) {
    const int rpw = (MT + NGW - 1) / NGW; const int m0 = gw * rpw; const int m1 = (m0 + rpw) < MT ? (m0 + rpw) : MT;
    int bcur = -1; float av[2][8], shv[2][8];
#pragma unroll
    for (int j = 0; j < 2; ++j)
#pragma unroll
        for (int k = 0; k < 8; ++k) { av[j][k] = 0.f; shv[j][k] = 0.f; }
    f32x4 p0[4], p1[4];
#define N0_LOAD(dst, mm) do { const int _m = (mm); if (_m < m1) { const float* _s = (_m < ML ? xin + (size_t)_m * D : cin + (size_t)(_m - ML) * D) + 8 * lane; \
        dst[0] = *(const f32x4*)_s; dst[1] = *(const f32x4*)(_s + 4); dst[2] = *(const f32x4*)(_s + 512); dst[3] = *(const f32x4*)(_s + 516); } } while (0)
    N0_LOAD(p0, m0); N0_LOAD(p1, m0 + 1);
    for (int m = m0; m < m1; ++m) {
        const int b = m < ML ? (m >> 12) : 16;
        float v[2][8];
#pragma unroll
        for (int j = 0; j < 2; ++j)
#pragma unroll
            for (int k = 0; k < 4; ++k) { v[j][k] = p0[2 * j][k]; v[j][4 + k] = p0[2 * j + 1][k]; }
#pragma unroll
        for (int i = 0; i < 4; ++i) p0[i] = p1[i];
        N0_LOAD(p1, m + 2);
        if (b != bcur) { bcur = b;
#pragma unroll
            for (int j = 0; j < 2; ++j) { const int c = 8 * lane + 512 * j; float g8[8], s8[8]; load8f(gmix + c, g8); load8f(mod_cur + (size_t)b * 6144 + 1024 + c, s8); load8f(mod_cur + (size_t)b * 6144 + c, shv[j]);
#pragma unroll
                for (int k = 0; k < 8; ++k) av[j][k] = g8[k] * (s8[k] + 1.0f); } }
        float ss = 0.f;
#pragma unroll
        for (int j = 0; j < 2; ++j)
#pragma unroll
            for (int k = 0; k < 8; ++k) ss += v[j][k] * v[j][k];
        const float rstd = __builtin_amdgcn_rsqf(wave_sum(ss) * (1.0f / D) + EPS);
#pragma unroll
        for (int j = 0; j < 2; ++j) { const int c = 8 * lane + 512 * j; *(u32x4*)(X + (size_t)m * D + c) = pack8f(v[j]); float h[8];
#pragma unroll
            for (int k = 0; k < 8; ++k) h[k] = sim8(v[j][k] * rstd * av[j][k] + shv[j][k], (FP8D_SIM & 1) != 0);
            *(u32x4*)(H + (size_t)m * D + c) = pack8f(h); }
    }
#undef N0_LOAD
}
DI void n1_phase(int mode, int nrows, const bf16_t* X, bf16_t* Xo, float* out, const unsigned char* Y  , const int* tokslot, const float* mod_prev, const float* mod_cur, const float* gmix, bf16_t* H, int gw, int NGW, int lane, bool s8 = false, bool h8 = false) {
    const int rpw = (nrows + NGW - 1) / NGW; const int m0 = gw * rpw; const int m1 = (m0 + rpw) < nrows ? (m0 + rpw) : nrows;
    if (m0 >= m1) return;
    u32x4 xq[3][2]; int sq[3] = {-1, -1, -1};
#define N1_LOAD(qi, mm) do { const int _m = (mm); if (_m < m1) { xq[qi][0] = *(const u32x4*)(X + (size_t)_m * D + 8 * lane); xq[qi][1] = *(const u32x4*)(X + (size_t)_m * D + 8 * lane + 512); \
        sq[qi] = lane < 16 ? tokslot[(size_t)lane * MT + _m] : -1; } } while (0)
    N1_LOAD(0, m0); N1_LOAD(1, m0 + 1); N1_LOAD(2, m0 + 2);
    int bcur = -1; float g2v[2][8], av[2][8], shv[2][8];
#pragma unroll
    for (int j = 0; j < 2; ++j)
#pragma unroll
        for (int k = 0; k < 8; ++k) { g2v[j][k] = 0.f; av[j][k] = 0.f; shv[j][k] = 0.f; }
    int slotn = sq[0]; unsigned maskn = (unsigned)__builtin_amdgcn_ballot_w64(slotn >= 0) & 0xffffu; int sbn[4]; u32x2 yrn[4][2];
#define N1_GATHER() do { _Pragma("unroll") for (int i = 0; i < 4; ++i) { sbn[i] = -1; if (maskn) { const int e = __builtin_ctz(maskn); sbn[i] = __builtin_amdgcn_readlane(slotn, e); maskn &= maskn - 1u; } \
            const unsigned char* yp = Y + (size_t)(sbn[i] >= 0 ? sbn[i] : 0) * D + 8 * lane; yrn[i][0] = *(const u32x2*)yp; yrn[i][1] = *(const u32x2*)(yp + 512); } } while (0)
    N1_GATHER();
    for (int m = m0; m < m1; ++m) {
        float v[2][8];
        unpack8(xq[0][0], v[0]); unpack8(xq[0][1], v[1]);
        xq[0][0] = xq[1][0]; xq[0][1] = xq[1][1]; xq[1][0] = xq[2][0]; xq[1][1] = xq[2][1];
        const int slot = slotn; sq[0] = sq[1]; sq[1] = sq[2];
        const int b = m < ML ? (m >> 12) : 16;
        unsigned mask = maskn;
        int sb[4]; u32x2 yr[4][2];
#pragma unroll
        for (int i = 0; i < 4; ++i) { sb[i] = sbn[i]; yr[i][0] = yrn[i][0]; yr[i][1] = yrn[i][1]; }
        slotn = (m + 1 < m1) ? sq[0] : -1; maskn = (unsigned)__builtin_amdgcn_ballot_w64(slotn >= 0) & 0xffffu;
        N1_GATHER();
        N1_LOAD(2, m + 3);
        if (b != bcur) { bcur = b;
#pragma unroll
            for (int j = 0; j < 2; ++j) { const int c = 8 * lane + 512 * j; load8f(mod_prev + (size_t)b * 6144 + 5120 + c, g2v[j]);
#pragma unroll
                for (int k = 0; k < 8; ++k) g2v[j][k] *= (1.0f / Y_SCALE);
                if (mode == 1) { float g8[8], s8[8]; load8f(gmix + c, g8); load8f(mod_cur + (size_t)b * 6144 + 1024 + c, s8); load8f(mod_cur + (size_t)b * 6144 + c, shv[j]);
#pragma unroll
                    for (int k = 0; k < 8; ++k) av[j][k] = g8[k] * (s8[k] + 1.0f); }
                else load8f(gmix + c, av[j]); } }
        float a[2][8];
#pragma unroll
        for (int j = 0; j < 2; ++j)
#pragma unroll
            for (int k = 0; k < 8; ++k) a[j][k] = 0.f;
#pragma unroll
        for (int i = 0; i < 4; ++i) if (sb[i] >= 0) {
#pragma unroll
            for (int j = 0; j < 2; ++j) { float y[8]; unpack8_fp8(yr[i][j], y);
#pragma unroll
                for (int k = 0; k < 8; ++k) a[j][k] += y[k]; } }
        while (mask) { const int e = __builtin_ctz(mask); const int s1 = __builtin_amdgcn_readlane(slot, e); mask &= mask - 1u; const unsigned char* yp = Y + (size_t)s1 * D + 8 * lane;
#pragma unroll
            for (int j = 0; j < 2; ++j) { float y[8]; unpack8_fp8(*(const u32x2*)(yp + 512 * j), y);
#pragma unroll
                for (int k = 0; k < 8; ++k) a[j][k] += y[k]; } }
        float ss = 0.f;
#pragma unroll
        for (int j = 0; j < 2; ++j)
#pragma unroll
            for (int k = 0; k < 8; ++k) { v[j][k] += g2v[j][k] * a[j][k]; ss += v[j][k] * v[j][k]; }
        const float rstd = __builtin_amdgcn_rsqf(wave_sum(ss) * (1.0f / D) + EPS);
        if (mode == 2) {
#pragma unroll
            for (int j = 0; j < 2; ++j) { float* op = out + (size_t)m * D + 8 * lane + 512 * j;
                *(f32x4*)op = (f32x4){v[j][0] * rstd * av[j][0], v[j][1] * rstd * av[j][1], v[j][2] * rstd * av[j][2], v[j][3] * rstd * av[j][3]};
                *(f32x4*)(op + 4) = (f32x4){v[j][4] * rstd * av[j][4], v[j][5] * rstd * av[j][5], v[j][6] * rstd * av[j][6], v[j][7] * rstd * av[j][7]}; }
        } else {
#pragma unroll
            for (int j = 0; j < 2; ++j) { const int c = 8 * lane + 512 * j; *(u32x4*)(Xo + (size_t)m * D + c) = pack8f(v[j]); float h[8];
#pragma unroll
                for (int k = 0; k < 8; ++k) h[k] = sim8(v[j][k] * rstd * av[j][k] + shv[j][k], s8);
                if (h8) { u32x2 w8; w8.x = pk4_fp8(h[0], h[1], h[2], h[3]); w8.y = pk4_fp8(h[4], h[5], h[6], h[7]); *(u32x2*)((unsigned char*)H + (size_t)m * D + c) = w8; }
                else *(u32x4*)(H + (size_t)m * D + c) = pack8f(h); }
        }
    }
#undef N1_LOAD
#undef N1_GATHER
}

DI void n2_phase(LAS unsigned char* lds, int nrows, const bf16_t* X, const float* mod_cur, const float* gffn, const float* w_r, bf16_t* H, float* aff, int bid, int G) {
    LAS unsigned char* Whi = lds; LAS unsigned char* Wlo = lds + 32768;
    LAS float* AV = (LAS float*)(lds + 65536); LAS float* SH = AV + 1024; LAS float* BIAS = SH + 1024;
    LAS float* DP0 = BIAS + 16; LAS float* SSP0 = DP0 + 2 * 8 * 256;
    const int tid = tid_opaque(), w = __builtin_amdgcn_readfirstlane(tid >> 6), lane = tid & 63, r = lane & 15, q = lane >> 4;
    const int ngroups = nrows >> 4, gpw = (ngroups + G - 1) / G; const int g0 = bid * gpw; const int g1 = (g0 + gpw) < ngroups ? (g0 + gpw) : ngroups;
    int bcur = -1;
    u32x4 xa[4], xn[4], xn2[4];
#define N2_LOAD(dst, gg) do { const size_t _row = (size_t)(gg) * 16 + r; _Pragma("unroll") for (int i = 0; i < 4; ++i) dst[i] = *(const u32x4*)(X + _row * D + 128 * w + 32 * i + 8 * q); } while (0)
    if (g0 < g1) N2_LOAD(xn, g0);
    if (g0 + 1 < g1) N2_LOAD(xn2, g0 + 1);
    for (int g = g0; g < g1; ++g) {
        const int row0 = g * 16; const int b = row0 < ML ? (row0 >> 12) : 16;
        if (b != bcur) {
            bcur = b; __syncthreads();
            for (int c = tid; c < 1024; c += 512) { AV[c] = gffn[c] * (mod_cur[(size_t)b * 6144 + 4096 + c] + 1.0f); SH[c] = mod_cur[(size_t)b * 6144 + 3072 + c]; }
            __syncthreads();
            float sb = 0.f;
            for (int i = tid; i < 16384; i += 512) { const int c = i >> 4, e = i & 15; const float wv = w_r[i]; const float v = AV[c] * wv; sb += SH[c] * wv; const unsigned hi = pk2(v, 0.f) & 0xffffu; const float lo = v - __uint_as_float(hi << 16);
                const int off = (((c >> 5) * 16 + e) * 4 + ((c >> 3) & 3)) * 16 + (c & 7) * 2;
                *(LAS unsigned short*)(Whi + off) = (unsigned short)hi; *(LAS unsigned short*)(Wlo + off) = (unsigned short)(pk2(lo, 0.f) & 0xffffu); }
            sb = x32_sum(x16_sum(sb));
            if (q == 0) DP0[w * 16 + r] = sb;
            __syncthreads();
            if (tid < 16) { float t = 0.f;
#pragma unroll
                for (int ww = 0; ww < 8; ++ww) t += DP0[ww * 16 + tid];
                BIAS[tid] = t; }
            __syncthreads();
        }
#pragma unroll
        for (int i = 0; i < 4; ++i) { xa[i] = xn[i]; xn[i] = xn2[i]; }
        if (g + 2 < g1) N2_LOAD(xn2, g + 2);
        f32x4 acc = (f32x4){0.f, 0.f, 0.f, 0.f}; float ss = 0.f;
#pragma unroll
        for (int i = 0; i < 4; ++i) { const int ks = 4 * w + i;
            const bf16x8 wh = *(const LAS bf16x8*)(Whi + ((ks * 16 + r) * 4 + q) * 16), wl = *(const LAS bf16x8*)(Wlo + ((ks * 16 + r) * 4 + q) * 16);
            const bf16x8 a = __builtin_bit_cast(bf16x8, xa[i]);
            acc = __builtin_amdgcn_mfma_f32_16x16x32_bf16(a, wh, acc, 0, 0, 0); acc = __builtin_amdgcn_mfma_f32_16x16x32_bf16(a, wl, acc, 0, 0, 0);
            float v[8]; unpack8(xa[i], v);
#pragma unroll
            for (int k = 0; k < 8; ++k) ss += v[k] * v[k]; }
        ss = x32_sum(x16_sum(ss));
        LAS float* DP = DP0 + (g & 1) * (8 * 256); LAS float* SSP = SSP0 + (g & 1) * (8 * 16);
        if (q == 0) SSP[w * 16 + r] = ss;
#pragma unroll
        for (int k = 0; k < 4; ++k) DP[(w * 16 + 4 * q + k) * 16 + r] = acc[k];
        __syncthreads();
        float rs;
        { float s2 = 0.f;
#pragma unroll
          for (int ww = 0; ww < 8; ++ww) s2 += SSP[ww * 16 + r];
          rs = __builtin_amdgcn_rsqf(s2 * (1.0f / D) + EPS); }
        if (tid < 256) { const int row = tid >> 4, e = tid & 15; float d = 0.f;
#pragma unroll
            for (int ww = 0; ww < 8; ++ww) d += DP[(ww * 16 + row) * 16 + e];
            const float rrow = __shfl(rs, (lane & 48) | row);
            const float t = rrow * d + BIAS[e];
            float mx = t;
            mx = row16_max(mx);
            const float ex = __expf(t - mx); float sm = ex;
            sm = row16_sum(sm);
            aff[(size_t)(row0 + row) * 16 + e] = ex * __builtin_amdgcn_rcpf(sm); }
        {
#pragma unroll
          for (int i = 0; i < 4; ++i) { const int c = 128 * w + 32 * i + 8 * q; float v[8]; unpack8(xa[i], v);
              const f32x4 a0 = *(const LAS f32x4*)(AV + c), a1 = *(const LAS f32x4*)(AV + c + 4), s0 = *(const LAS f32x4*)(SH + c), s1 = *(const LAS f32x4*)(SH + c + 4);
              float h[8]; h[0] = v[0] * rs * a0[0] + s0[0]; h[1] = v[1] * rs * a0[1] + s0[1]; h[2] = v[2] * rs * a0[2] + s0[2]; h[3] = v[3] * rs * a0[3] + s0[3];
              h[4] = v[4] * rs * a1[0] + s1[0]; h[5] = v[5] * rs * a1[1] + s1[1]; h[6] = v[6] * rs * a1[2] + s1[2]; h[7] = v[7] * rs * a1[3] + s1[3];
              u32x2 w8; w8.x = pk4_fp8(h[0], h[1], h[2], h[3]); w8.y = pk4_fp8(h[4], h[5], h[6], h[7]);
              *(u32x2*)((unsigned char*)H + (size_t)(row0 + r) * D + c) = w8; } }
    }
#undef N2_LOAD
    __syncthreads();
}

DI void tk_problem(LAS unsigned char* lds, const float* aff, int rowbase, int n, int cap, int e, int slotbase, int* rowidx, float* gate, int* tokslot_e) {
    LAS int* cntA = (LAS int*)lds;
    LAS int* scanA = (LAS int*)(lds + 64);
    LAS int* scanB = (LAS int*)(lds + 128);
    LAS int* totG = (LAS int*)(lds + 192);
    const int tid = tid_opaque(), wave = tid >> 6, lane = tid & 63;
    unsigned key[8];
#pragma unroll
    for (int j = 0; j < 8; ++j) { const int t = tid * 8 + j; key[j] = t < n ? __float_as_uint(aff[(size_t)(rowbase + t) * 16 + e]) : 0u; }
    unsigned prefix = 0u; int it = 0;
    for (int bit = 30; bit >= 0; --bit, ++it) {
        const unsigned cand = prefix | (1u << bit);
        int c = 0;
#pragma unroll
        for (int j = 0; j < 8; ++j) c += key[j] >= cand ? 1 : 0;
        c = wave_sum_i(c);
        if (lane == 0) cntA[(it & 1) * 8 + wave] = c;
        __syncthreads();
        int tot = 0;
#pragma unroll
        for (int w = 0; w < 8; ++w) tot += cntA[(it & 1) * 8 + w];
        if (tot >= cap) prefix = cand;
    }
    int ng = 0, neq = 0;
#pragma unroll
    for (int j = 0; j < 8; ++j) { ng += key[j] > prefix ? 1 : 0; neq += key[j] == prefix ? 1 : 0; }
    int incl = neq;
#pragma unroll
    for (int o = 1; o < 64; o <<= 1) { const int y = __shfl_up(incl, o); if (lane >= o) incl += y; }
    const int wg = wave_sum_i(ng);
    if (lane == 63) scanA[wave] = incl;
    if (lane == 0) totG[wave] = wg;
    __syncthreads();
    int eqbase = incl - neq, G = 0;
#pragma unroll
    for (int w = 0; w < 8; ++w) { if (w < wave) eqbase += scanA[w]; G += totG[w]; }
    const int need = cap - G;
    bool sel[8]; int nsel = 0, er = eqbase;
#pragma unroll
    for (int j = 0; j < 8; ++j) { const bool isg = key[j] > prefix, ise = key[j] == prefix; sel[j] = isg || (ise && er < need); er += ise ? 1 : 0; nsel += sel[j] ? 1 : 0; }
    int incl2 = nsel;
#pragma unroll
    for (int o = 1; o < 64; o <<= 1) { const int y = __shfl_up(incl2, o); if (lane >= o) incl2 += y; }
    if (lane == 63) scanB[wave] = incl2;
    __syncthreads();
    int pos = incl2 - nsel;
#pragma unroll
    for (int w = 0; w < 8; ++w) if (w < wave) pos += scanB[w];
#pragma unroll
    for (int j = 0; j < 8; ++j) { const int t = tid * 8 + j;
        if (t < n) { if (sel[j]) { const int s = slotbase + pos; rowidx[s] = rowbase + t; gate[s] = __uint_as_float(key[j]); tokslot_e[rowbase + t] = s; ++pos; } else tokslot_e[rowbase + t] = -1; } }
    __syncthreads();
}

DI void tk_pair(LAS unsigned char* lds, const float* aff, int e, int rowbaseL, int slotbaseL, bool ctx, int rowbaseC, int slotbaseC, int* rowidx, float* gate, int* tokslot_e) {
    LAS int* cnt = (LAS int*)lds;
    LAS int* scanA = (LAS int*)(lds + 512);
    LAS int* scanB = (LAS int*)(lds + 640);
    LAS int* totG = (LAS int*)(lds + 768);
    const int tid = tid_opaque(), wave = __builtin_amdgcn_readfirstlane(tid >> 6), lane = tid & 63;
    unsigned key[8];
#pragma unroll
    for (int j = 0; j < 8; ++j) key[j] = __float_as_uint(aff[(size_t)(rowbaseL + tid * 8 + j) * 16 + e]);
    const bool hasc = ctx && tid < 256;
    const unsigned keyc = hasc ? __float_as_uint(aff[(size_t)(rowbaseC + tid) * 16 + e]) : 0u;
    unsigned pL = 0u, pC = 0u; int it = 0;
    for (int bit = 28; bit >= 0; bit -= 2, ++it) {
        LAS int* cb = cnt + (it & 1) * 48;
#pragma unroll
        for (int k = 0; k < 3; ++k) { const unsigned cL = pL | ((unsigned)(3 - k) << bit), cC = pC | ((unsigned)(3 - k) << bit);
            int n = 0;
#pragma unroll
            for (int j = 0; j < 8; ++j) n += __builtin_popcountll(__builtin_amdgcn_ballot_w64(key[j] >= cL));
            const int m = __builtin_popcountll(__builtin_amdgcn_ballot_w64(keyc >= cC));
            if (lane == 0) { cb[k * 8 + wave] = n; cb[24 + k * 8 + wave] = m; } }
        __syncthreads();
        int tL[3], tC[3];
#pragma unroll
        for (int k = 0; k < 3; ++k) { const pg8::v4i_t a = *(const LAS pg8::v4i_t*)(cb + k * 8), b = *(const LAS pg8::v4i_t*)(cb + k * 8 + 4), c = *(const LAS pg8::v4i_t*)(cb + 24 + k * 8), d = *(const LAS pg8::v4i_t*)(cb + 24 + k * 8 + 4);
            tL[k] = a[0] + a[1] + a[2] + a[3] + b[0] + b[1] + b[2] + b[3]; tC[k] = c[0] + c[1] + c[2] + c[3] + d[0] + d[1] + d[2] + d[3]; }
        const unsigned dL = tL[0] >= CAPL ? 3u : (tL[1] >= CAPL ? 2u : (tL[2] >= CAPL ? 1u : 0u)), dC = tC[0] >= CAPC ? 3u : (tC[1] >= CAPC ? 2u : (tC[2] >= CAPC ? 1u : 0u));
        pL |= dL << bit; pC |= dC << bit;
    }
    int ngL = 0, neqL = 0;
#pragma unroll
    for (int j = 0; j < 8; ++j) { ngL += key[j] > pL ? 1 : 0; neqL += key[j] == pL ? 1 : 0; }
    const int ngC = (hasc && keyc > pC) ? 1 : 0, neqC = (hasc && keyc == pC) ? 1 : 0;
    int inL = neqL, inC = neqC;
#pragma unroll
    for (int o = 1; o < 64; o <<= 1) { const int y = __shfl_up(inL, o), z = __shfl_up(inC, o); if (lane >= o) { inL += y; inC += z; } }
    const int wgL = wave_sum_i(ngL), wgC = wave_sum_i(ngC);
    if (lane == 63) { scanA[wave] = inL; scanA[8 + wave] = inC; }
    if (lane == 0) { totG[wave] = wgL; totG[8 + wave] = wgC; }
    __syncthreads();
    int ebL = inL - neqL, ebC = inC - neqC, GL = 0, GC = 0;
#pragma unroll
    for (int w = 0; w < 8; ++w) { if (w < wave) { ebL += scanA[w]; ebC += scanA[8 + w]; } GL += totG[w]; GC += totG[8 + w]; }
    const int needL = CAPL - GL, needC = CAPC - GC;
    bool sel[8]; int nsel = 0, er = ebL;
#pragma unroll
    for (int j = 0; j < 8; ++j) { const bool isg = key[j] > pL, ise = key[j] == pL; sel[j] = isg || (ise && er < needL); er += ise ? 1 : 0; nsel += sel[j] ? 1 : 0; }
    const bool selC = hasc && (keyc > pC || (keyc == pC && ebC < needC));
    int i2L = nsel, i2C = selC ? 1 : 0;
#pragma unroll
    for (int o = 1; o < 64; o <<= 1) { const int y = __shfl_up(i2L, o), z = __shfl_up(i2C, o); if (lane >= o) { i2L += y; i2C += z; } }
    if (lane == 63) { scanB[wave] = i2L; scanB[8 + wave] = i2C; }
    __syncthreads();
    int posL = i2L - nsel, posC = i2C - (selC ? 1 : 0);
#pragma unroll
    for (int w = 0; w < 8; ++w) if (w < wave) { posL += scanB[w]; posC += scanB[8 + w]; }
#pragma unroll
    for (int j = 0; j < 8; ++j) { const int t = rowbaseL + tid * 8 + j;
        if (sel[j]) { const int sl = slotbaseL + posL; rowidx[sl] = t; gate[sl] = __uint_as_float(key[j]); tokslot_e[t] = sl; ++posL; } else tokslot_e[t] = -1; }
    if (hasc) { const int t = rowbaseC + tid;
        if (selC) { const int sl = slotbaseC + posC; rowidx[sl] = t; gate[sl] = __uint_as_float(keyc); tokslot_e[t] = sl; } else tokslot_e[t] = -1; }
    __syncthreads();
}

DI int sm_chunk_of(int t) {
    if (t < 32) { const int x = t >> 2, w = t & 3; return 68 * x + 64 + w; }
    const int u = t - 32, j = 3 - (u >> 7), v = u & 127, x = v >> 4, w = v & 15; return 68 * x + 16 * j + w;
}
DI s16x4 tr16(const LAS unsigned char* p) { return __builtin_bit_cast(s16x4, __builtin_amdgcn_ds_read_tr16_b64_v4i16((LAS v4i16_t*)p)); }
DI void sm_phase(LAS unsigned char* lds, const bf16_t* U, bf16_t* Uo, const bf16_t* V, const float* stats, const bf16_t* ws_t  , const float* ws_f  , const float* b_s  ,
                 const float* ln_g, const float* ln_b, int bid, int G) {
    constexpr int PITCH = 272;
    constexpr int NUNITS = (MT / 128) * 16;
    LAS unsigned char* Aimg = lds; LAS unsigned char* Bimg = lds + 128 * PITCH; LAS float* RS = (LAS float*)(lds + 3 * 128 * PITCH);
    const int tid = tid_opaque(), wid = __builtin_amdgcn_readfirstlane(tid >> 6), lane = tid & 63, wr = wid >> 2, wc = wid & 3, fr = lane & 15, fq = lane >> 4;
    const int r4 = tid >> 2, q4 = tid & 3;
    f32x4 gam[2], bet[2]; float rsw[4], bsv[4];
    u32x4 vr[4], vr2[4]; f32x4 sr, sr2; u32x4 ur[4], ur2[4];
    int last_g = -1;
#define SM_LOAD(dv, ds, du, un) do { const int _ch = sm_chunk_of((un) >> 4), _g = (un) & 15; const size_t _r0 = (size_t)_ch * 128; const int _c0 = _g * 128; \
        _Pragma("unroll") for (int k = 0; k < 4; ++k) dv[k] = *(const u32x4*)(V + (_r0 + r4) * 2048 + _c0 + k * 32 + q4 * 8);     \
        ds = *(const f32x4*)(stats + (_r0 + r4) * 16 + q4 * 4); \
        _Pragma("unroll") for (int mt = 0; mt < 4; ++mt) du[mt] = *(const u32x4*)(U + (_r0 + wr * 64 + mt * 16 + fr) * 2048 + _c0 + wc * 32 + 8 * fq); } while (0)
    int unit = bid;
    if (unit < NUNITS) SM_LOAD(vr, sr, ur, unit);
    if (unit + G < NUNITS) SM_LOAD(vr2, sr2, ur2, unit + G);
    for (int it = 0; unit < NUNITS; unit += G, ++it) {
        const int ch = sm_chunk_of(unit >> 4), g = unit & 15; const size_t row0 = (size_t)ch * 128; const int c0 = g * 128;
        if (g != last_g) {
            __syncthreads();
#pragma unroll
            for (int k = 0; k < 4; ++k) { const int id = tid + 512 * k, r = id >> 4, cc = (id & 15) * 8; *(LAS u32x4*)(Aimg + r * PITCH + cc * 2) = *(const u32x4*)(ws_t + ((size_t)g * 128 + r) * 128 + cc); }
            if (tid < 128) { const float* wp = ws_f + ((size_t)g * 128 + tid) * 128; float s = 0.f;
#pragma unroll 8
                for (int i = 0; i < 32; ++i) { const f32x4 x = *(const f32x4*)(wp + 4 * i); s += (x[0] + x[1]) + (x[2] + x[3]); }
                RS[tid] = s; }
            __syncthreads();
#pragma unroll
            for (int mt = 0; mt < 4; ++mt) { const int p = wr * 64 + mt * 16 + fr; rsw[mt] = RS[p]; bsv[mt] = b_s[g * 128 + p]; }
#pragma unroll
            for (int nt = 0; nt < 2; ++nt) { gam[nt] = *(const f32x4*)(ln_g + c0 + wc * 32 + 8 * fq + 4 * nt); bet[nt] = *(const f32x4*)(ln_b + c0 + wc * 32 + 8 * fq + 4 * nt); }
            last_g = g;
        }
        LAS unsigned char* Bi = Bimg + (it & 1) * 128 * PITCH;
        { float s = sr[0] + sr[2], q = sr[1] + sr[3]; s += xor1_f(s); q += xor1_f(q); s += xor2_f(s); q += xor2_f(q);
          const float mu = s * (1.0f / DA); const float rs = __builtin_amdgcn_rsqf(fmaxf(q * (1.0f / DA) - mu * mu, 0.f) + EPS);
#pragma unroll
          for (int k = 0; k < 4; ++k) { const u32x4 w = vr[k]; u32x2 o0, o1;
              o0.x = pk2((bflo(w.x) - mu) * rs, (bfhi(w.x) - mu) * rs); o0.y = pk2((bflo(w.y) - mu) * rs, (bfhi(w.y) - mu) * rs);
              o1.x = pk2((bflo(w.z) - mu) * rs, (bfhi(w.z) - mu) * rs); o1.y = pk2((bflo(w.w) - mu) * rs, (bfhi(w.w) - mu) * rs);
              *(LAS u32x2*)(Bi + r4 * PITCH + (k * 32 + 4 * q4) * 2) = o0; *(LAS u32x2*)(Bi + r4 * PITCH + (k * 32 + 16 + 4 * q4) * 2) = o1; } }
        u32x4 uc[4];
#pragma unroll
        for (int mt = 0; mt < 4; ++mt) { uc[mt] = ur[mt]; ur[mt] = ur2[mt]; }
#pragma unroll
        for (int k = 0; k < 4; ++k) vr[k] = vr2[k];
        sr = sr2;
        if (unit + 2 * G < NUNITS) SM_LOAD(vr2, sr2, ur2, unit + 2 * G);
        __syncthreads();
        f32x4 acc[4][2];
#pragma unroll
        for (int mt = 0; mt < 4; ++mt)
#pragma unroll
            for (int nt = 0; nt < 2; ++nt) acc[mt][nt] = (f32x4){0.f, 0.f, 0.f, 0.f};
#pragma unroll
        for (int ks = 0; ks < 4; ++ks) {
            bf16x8 bfr[2], afr[4];
#pragma unroll
            for (int mt = 0; mt < 4; ++mt) afr[mt] = *(const LAS bf16x8*)(Aimg + (wr * 64 + mt * 16 + fr) * PITCH + (ks * 32 + 8 * fq) * 2);
#pragma unroll
            for (int nt = 0; nt < 2; ++nt) { const LAS unsigned char* p = Bi + (ks * 32 + 8 * fq + (fr >> 2)) * PITCH + (wc * 32 + nt * 16) * 2 + 8 * (fr & 3);
                const s16x4 lo = tr16(p), hi = tr16(p + 4 * PITCH); bfr[nt] = __builtin_shufflevector(lo, hi, 0, 1, 2, 3, 4, 5, 6, 7); }
#pragma unroll
            for (int mt = 0; mt < 4; ++mt)
#pragma unroll
                for (int nt = 0; nt < 2; ++nt) acc[mt][nt] = __builtin_amdgcn_mfma_f32_16x16x32_bf16(bfr[nt], afr[mt], acc[mt][nt], 0, 0, 0);
        }
#pragma unroll
        for (int mt = 0; mt < 4; ++mt) { const int p = wr * 64 + mt * 16 + fr;
            const f32x4 sv0 = gam[0] * acc[mt][0] + bet[0] * rsw[mt] + bsv[mt], sv1 = gam[1] * acc[mt][1] + bet[1] * rsw[mt] + bsv[mt]; const u32x4 w = uc[mt];
            constexpr bool S8 = (FP8D_SIM & 4) != 0; u32x4 o; o.x = pk2(sim8(bflo(w.x) * sv0[0], S8), sim8(bfhi(w.x) * sv0[1], S8)); o.y = pk2(sim8(bflo(w.y) * sv0[2], S8), sim8(bfhi(w.y) * sv0[3], S8)); o.z = pk2(sim8(bflo(w.z) * sv1[0], S8), sim8(bfhi(w.z) * sv1[1], S8)); o.w = pk2(sim8(bflo(w.w) * sv1[2], S8), sim8(bfhi(w.w) * sv1[3], S8));
            *(u32x4*)(Uo + (row0 + p) * 2048 + c0 + wc * 32 + 8 * fq) = o; }
    }
#undef SM_LOAD
    __syncthreads();
}

DI bf16x8 pack8(const f32x16& x, int s) {
    u32x4 p; p.x = pk2(x[8 * s], x[8 * s + 1]); p.y = pk2(x[8 * s + 2], x[8 * s + 3]); p.z = pk2(x[8 * s + 4], x[8 * s + 5]); p.w = pk2(x[8 * s + 6], x[8 * s + 7]);
    return __builtin_bit_cast(bf16x8, p);
}
DI void at_phase(LAS unsigned char* lds, const bf16_t* Q, const bf16_t* Kb, const bf16_t* Vb, bf16_t* O, const float* sink  , int nunits, int bid, int G) {
    constexpr int KP = 144;
    constexpr int BUFB = 2 * 64 * KP;
    const int tid = tid_opaque(), wid = __builtin_amdgcn_readfirstlane(tid >> 6), lane = tid & 63, r = lane & 31, h = lane >> 5;
    const int g = wid >> 1, wh = wid & 1;
    const int skey = tid >> 3, sdc = tid & 7;
    for (int unit = bid; unit < nunits; unit += G) {
        int b, kvh, qb, qrow0; bool lat;
        if (unit < 2048) { lat = true; b = unit >> 7; kvh = (unit >> 5) & 3; qb = unit & 31; qrow0 = b * 4096 + qb * 128; }
        else { const int u2 = unit - 2048; lat = false; b = u2 >> 3; kvh = (u2 >> 1) & 3; qb = u2 & 1; qrow0 = ML + b * 256 + qb * 128; }
        const int hq = kvh * 4 + g;
        unsigned tmask = lat ? (0x3CCu | (qb >= 1 ? 0x3u : 0u) | (qb <= 30 ? 0x30u : 0u)) : 0x3C0u;
#define AT_KROW(ti) ((ti) < 6 ? b * 4096 + (qb - 1 + ((ti) >> 1)) * 128 + ((ti) & 1) * 64 : ML + b * 256 + ((ti) - 6) * 64)
        int ti = __builtin_ctz(tmask); tmask &= tmask - 1u;
        u32x4 kreg, vreg;
        { const int kr = AT_KROW(ti); kreg = *(const u32x4*)(Kb + (size_t)(kr + skey) * 256 + kvh * 64 + sdc * 8); vreg = *(const u32x4*)(Vb + (size_t)(kr + skey) * 256 + kvh * 64 + sdc * 8); }
        LAS unsigned char* QO = lds + 2 * BUFB + wid * (64 * KP);
        bf16x8 qf[2][4];
        { u32x4 qv[8];
#pragma unroll
          for (int i = 0; i < 8; ++i) { const int row = (lane >> 3) + 8 * i; qv[i] = *(const u32x4*)(Q + (size_t)(qrow0 + wh * 64 + row) * 1024 + hq * 64 + (lane & 7) * 8); }
#pragma unroll
          for (int i = 0; i < 8; ++i) { const int row = (lane >> 3) + 8 * i; *(LAS u32x4*)(QO + row * KP + (lane & 7) * 16) = qv[i]; }
          asm volatile("s_waitcnt lgkmcnt(0)" ::: "memory");
#pragma unroll
          for (int qt = 0; qt < 2; ++qt)
#pragma unroll
              for (int ks = 0; ks < 4; ++ks) qf[qt][ks] = *(const LAS bf16x8*)(QO + (qt * 32 + r) * KP + (ks * 16 + 8 * h) * 2);
          asm volatile("s_waitcnt lgkmcnt(0)" ::: "memory"); }
        f32x16 o[2][2];
#pragma unroll
        for (int dt = 0; dt < 2; ++dt)
#pragma unroll
            for (int qt = 0; qt < 2; ++qt)
#pragma unroll
                for (int i = 0; i < 16; ++i) o[dt][qt][i] = 0.f;
        float mrun[2], lrun[2];
        { const float sk = sink[hq] * LOG2E; mrun[0] = sk; mrun[1] = sk; lrun[0] = h == 0 ? 1.f : 0.f; lrun[1] = lrun[0]; }
        __syncthreads();
        *(LAS u32x4*)(lds + skey * KP + sdc * 16) = kreg; *(LAS u32x4*)(lds + 64 * KP + skey * KP + sdc * 16) = vreg;
        int buf = 0;
        for (;;) {
            const int tn = tmask ? __builtin_ctz(tmask) : -1; tmask &= tmask - 1u;
            if (tn >= 0) { const int kr = AT_KROW(tn); kreg = *(const u32x4*)(Kb + (size_t)(kr + skey) * 256 + kvh * 64 + sdc * 8); vreg = *(const u32x4*)(Vb + (size_t)(kr + skey) * 256 + kvh * 64 + sdc * 8); }
            __syncthreads();
            const LAS unsigned char* Kimg = lds + buf * BUFB; const LAS unsigned char* Vimg = Kimg + 64 * KP;
            const int mode = ti < 2 ? 1 : (ti < 4 ? 0 : (ti < 6 ? 2 : 0));
            const bool skip = (ti == 0 && wh == 1) || (ti == 5 && wh == 0);
            if (!skip) {
            f32x16 s[2][2];
#pragma unroll
            for (int kt = 0; kt < 2; ++kt)
#pragma unroll
                for (int qt = 0; qt < 2; ++qt)
#pragma unroll
                    for (int i = 0; i < 16; ++i) s[kt][qt][i] = -mrun[qt];
            {
                const unsigned kaddr = (unsigned)(__UINTPTR_TYPE__)(Kimg + r * KP + 16 * h);
                bf16x8 k0, k1, k2;
#define AT_KRD(dst, OFF) asm volatile("ds_read_b128 %0, %1 offset:" #OFF : "=v"(dst) : "v"(kaddr))
#define AT_KW(dst, N) asm volatile("s_waitcnt lgkmcnt(" #N ")" : "+v"(dst) :: "memory")
#define AT_QK(kfv, kt, ks) do { s[kt][0] = __builtin_amdgcn_mfma_f32_32x32x16_bf16(kfv, qf[0][ks], s[kt][0], 0, 0, 0); s[kt][1] = __builtin_amdgcn_mfma_f32_32x32x16_bf16(kfv, qf[1][ks], s[kt][1], 0, 0, 0); } while (0)
                asm volatile("s_waitcnt lgkmcnt(0)" ::: "memory");
                AT_KRD(k0, 0); AT_KRD(k1, 32);
                AT_KRD(k2, 64);   AT_KW(k0, 2); AT_QK(k0, 0, 0);
                AT_KRD(k0, 96);   AT_KW(k1, 2); AT_QK(k1, 0, 1);
                AT_KRD(k1, 4608); AT_KW(k2, 2); AT_QK(k2, 0, 2);
                AT_KRD(k2, 4640); AT_KW(k0, 2); AT_QK(k0, 0, 3);
                AT_KRD(k0, 4672); AT_KW(k1, 2); AT_QK(k1, 1, 0);
                AT_KRD(k1, 4704); AT_KW(k2, 2); AT_QK(k2, 1, 1);
                                  AT_KW(k0, 1); AT_QK(k0, 1, 2);
                                  AT_KW(k1, 0); AT_QK(k1, 1, 3);
#undef AT_KRD
#undef AT_KW
#undef AT_QK
            }
            if (mode != 0) {
                const int jb = (ti & 1) * 64;
#pragma unroll
                for (int qt = 0; qt < 2; ++qt) { const int dlt = jb + 4 * h - (wh * 64 + qt * 32 + r);
                    if (mode == 1) {
#pragma unroll
                        for (int kt = 0; kt < 2; ++kt)
#pragma unroll
                            for (int i = 0; i < 16; ++i) { if (dlt < -(kt * 32 + (i & 3) + 8 * (i >> 2))) s[kt][qt][i] = -INFINITY; }
                    } else {
#pragma unroll
                        for (int kt = 0; kt < 2; ++kt)
#pragma unroll
                            for (int i = 0; i < 16; ++i) { if (dlt > -(kt * 32 + (i & 3) + 8 * (i >> 2))) s[kt][qt][i] = -INFINITY; }
                    } }
            }
            float mx[2];
#pragma unroll
            for (int qt = 0; qt < 2; ++qt) { float m0 = __builtin_fmaxf(s[0][qt][0], s[1][qt][0]);
#pragma unroll
                for (int i = 1; i < 16; ++i) m0 = __builtin_fmaxf(__builtin_fmaxf(m0, s[0][qt][i]), s[1][qt][i]);
                mx[qt] = x32_max(m0); }
            if (__builtin_amdgcn_ballot_w64(mx[0] > 8.0f || mx[1] > 8.0f) != 0ull) {
#pragma unroll
                for (int qt = 0; qt < 2; ++qt) { const float d = fmaxf(mx[qt], 0.f), alpha = __builtin_amdgcn_exp2f(-d); mrun[qt] += d; lrun[qt] *= alpha;
#pragma unroll
                    for (int kt = 0; kt < 2; ++kt)
#pragma unroll
                        for (int i = 0; i < 16; ++i) s[kt][qt][i] -= d;
#pragma unroll
                    for (int dt = 0; dt < 2; ++dt)
#pragma unroll
                        for (int i = 0; i < 16; ++i) o[dt][qt][i] *= alpha; }
            }
#pragma unroll
            for (int qt = 0; qt < 2; ++qt) { float ls = 0.f;
#pragma unroll
                for (int kt = 0; kt < 2; ++kt)
#pragma unroll
                    for (int i = 0; i < 16; ++i) { const float p = __builtin_amdgcn_exp2f(s[kt][qt][i]); s[kt][qt][i] = p; ls += p; }
                lrun[qt] += ls; }
#pragma unroll
            for (int kt = 0; kt < 2; ++kt)
#pragma unroll
                for (int ss = 0; ss < 2; ++ss) {
                    bf16x8 vf[2];
#pragma unroll
                    for (int dt = 0; dt < 2; ++dt) { const LAS unsigned char* p = Vimg + (kt * 32 + 16 * ss + 4 * h + ((lane & 15) >> 2)) * KP + (dt * 32 + 16 * ((lane >> 4) & 1)) * 2 + 8 * (lane & 3);
                        const s16x4 lo = tr16(p), hi = tr16(p + 8 * KP); vf[dt] = __builtin_shufflevector(lo, hi, 0, 1, 2, 3, 4, 5, 6, 7); }
#pragma unroll
                    for (int qt = 0; qt < 2; ++qt) { const bf16x8 pf = pack8(s[kt][qt], ss);
#pragma unroll
                        for (int dt = 0; dt < 2; ++dt) o[dt][qt] = __builtin_amdgcn_mfma_f32_32x32x16_bf16(vf[dt], pf, o[dt][qt], 0, 0, 0); }
                }
            }
            if (tn < 0) break;
            { LAS unsigned char* nb = lds + (buf ^ 1) * BUFB; *(LAS u32x4*)(nb + skey * KP + sdc * 16) = kreg; *(LAS u32x4*)(nb + 64 * KP + skey * KP + sdc * 16) = vreg; }
            buf ^= 1; ti = tn;
        }
#undef AT_KROW
#pragma unroll
        for (int qt = 0; qt < 2; ++qt) { const float lt = x32_sum(lrun[qt]); const float inv = 1.0f / lt;
#pragma unroll
            for (int dt = 0; dt < 2; ++dt)
#pragma unroll
                for (int ig = 0; ig < 4; ++ig) {
                    if (FP8_ATT) { *(LAS unsigned*)(QO + (qt * 32 + r) * KP + (dt * 32 + 8 * ig + 4 * h)) = pk4_fp8(o[dt][qt][4 * ig] * inv, o[dt][qt][4 * ig + 1] * inv, o[dt][qt][4 * ig + 2] * inv, o[dt][qt][4 * ig + 3] * inv); }
                    else { constexpr bool S8 = (FP8D_SIM & 2) != 0; u32x2 w; w.x = pk2(sim8(o[dt][qt][4 * ig] * inv, S8), sim8(o[dt][qt][4 * ig + 1] * inv, S8)); w.y = pk2(sim8(o[dt][qt][4 * ig + 2] * inv, S8), sim8(o[dt][qt][4 * ig + 3] * inv, S8));
                        *(LAS u32x2*)(QO + (qt * 32 + r) * KP + (dt * 32 + 8 * ig + 4 * h) * 2) = w; } } }
        asm volatile("s_waitcnt lgkmcnt(0)" ::: "memory");
        if (FP8_ATT) {
#pragma unroll
            for (int i = 0; i < 4; ++i) { const int row = (lane >> 2) + 16 * i; const u32x4 w = *(const LAS u32x4*)(QO + row * KP + (lane & 3) * 16);
                *(u32x4*)((unsigned char*)O + (size_t)(qrow0 + wh * 64 + row) * 1024 + hq * 64 + (lane & 3) * 16) = w; }
        } else {
#pragma unroll
        for (int i = 0; i < 8; ++i) { const int row = (lane >> 3) + 8 * i; const u32x4 w = *(const LAS u32x4*)(QO + row * KP + (lane & 7) * 16);
            *(u32x4*)(O + (size_t)(qrow0 + wh * 64 + row) * 1024 + hq * 64 + (lane & 7) * 8) = w; }
        }
        asm volatile("s_waitcnt lgkmcnt(0)" ::: "memory");
    }
    __syncthreads();
}

struct Args { const float* in[23]; float* out; unsigned char* ws; int ph_lo, ph_hi; };
static_assert(sizeof(Args) == 25 * 8 + 8, "Args has no padding");
#define AS4 __attribute__((address_space(4)))
DI unsigned long long karg(int k) { const unsigned long long AS4* kp = (const unsigned long long AS4*)__builtin_amdgcn_kernarg_segment_ptr(); asm volatile("" : "+s"(kp)); return kp[k]; }
#define KIN(k) ((const float*)(const GAS float*)karg(k))
#define KOUT() ((float*)(GAS float*)karg(23))
#define KWS() ((unsigned char*)(GAS unsigned char*)karg(24))

#ifndef DBG_ONLY
#define DBG_ONLY -1
#endif
#ifndef ALIGN_E12
#define ALIGN_E12 true
#endif
#ifndef DUP_MASK
#define DUP_MASK 0
#endif
#ifndef STAMP_MASK
#define STAMP_MASK 0
#endif
#ifndef STAMP_TMAX_US
#define STAMP_TMAX_US 5000
#endif
#define NDUP(n) (((DUP_MASK >> (n)) & 1) ? 2 : 1)
#define DUMMY(n) (NDUP(n) == 2 && dup_ == 0)
#define ST0(n) do { if (STAMP_MASK && ((STAMP_MASK >> (n)) & 1) && blockIdx.x == 0) t_st0 = __builtin_amdgcn_s_memrealtime(); } while (0)
#define ST1(n) do { if (STAMP_MASK && ((STAMP_MASK >> (n)) & 1) && blockIdx.x == 0) t_acc += __builtin_amdgcn_s_memrealtime() - t_st0; } while (0)
#define SITE(n) (DBG_ONLY < 0 || DBG_ONLY == (n))

__global__ void __launch_bounds__(512, 2) mega_fwd(Args args) {
    extern __shared__ __attribute__((aligned(16))) unsigned char lds_raw[];
    LAS unsigned char* lds = (LAS unsigned char*)lds_raw;
    const int tid = threadIdx.x;
    for (int u = tid; u < (LDS_BYTES - RING_BYTES) / 4; u += 512) ((LAS unsigned*)(lds + RING_BYTES))[u] = 0u;
    __syncthreads();
    XcdBarrier bar; bar.bar = (unsigned*)(args.ws + WS_CTL) + CW_BAR; bar.x = 0; bar.st = nullptr;
    if (!MK_SPLIT) bar = xcd_barrier_post((unsigned*)(args.ws + WS_CTL) + CW_BAR, (volatile LAS unsigned*)(lds + MISC_OFF) + 8);
    const int lo = args.ph_lo, hi = args.ph_hi;
    unsigned long long t_st0 = 0, t_acc = 0; (void)t_st0; (void)t_acc;
#define IN(k) (lo <= (k) && (k) < hi)
#ifndef SEAM_REP
#define SEAM_REP 1
#endif
#define SEAM(k) do { if (!MK_SPLIT && IN((k) + 1)) { for (int rep_ = 0; rep_ < SEAM_REP; ++rep_) xcd_barrier(bar); } } while (0)
#ifndef STEAL
#define STEAL 1
#endif
#define STEAL_ARGS() P0Args sa; sa.w1 = KIN(19); sa.w3 = KIN(20); sa.w2 = KIN(21); sa.w13_t = (bf16_t*)(ws + WS_W13); sa.w2_t = (bf16_t*)(ws + WS_W2); unsigned* sq = (unsigned*)(ws + WS_CTL) + CW_STEAL
#define STEAL_TAIL(nunits, budget, own) do { if (STEAL && ((nunits) % G) != 0 && bid >= ((nunits) % G)) { STEAL_ARGS(); \
        if (own) steal_convert(lds, sq + 64 * layer, sa, layer, (budget)); else if (layer < DEPTH - 1) steal_convert(lds, sq + 64 * (layer + 1), sa, layer + 1, (budget)); } } while (0)
#define WAVE_IDS() const int tid_ = tid_opaque(); const int lane = tid_ & 63, wave = __builtin_amdgcn_readfirstlane(tid_ >> 6); const int G = gridDim.x, bid = blockIdx.x; const int gw = bid * 8 + wave, NGW = G * 8; (void)lane; (void)gw; (void)NGW; (void)G; (void)bid

    ST0(0); for (int dup_ = 0; dup_ < NDUP(0); ++dup_) if (SITE(0) && IN(0)) { if (dup_) __syncthreads();
        WAVE_IDS(); unsigned char* ws = KWS();
        p0_mod(lds, KIN(1), KIN(3), KIN(4), KIN(5), (float*)(ws + WS_MOD), bid, G);
        P0Args pa; pa.w_in = KIN(8); pa.w_out = KIN(14); pa.w_qkv = KIN(15); pa.w_o = KIN(17); pa.w1 = KIN(19); pa.w3 = KIN(20); pa.w2 = KIN(21); pa.w_s = KIN(12);
        pa.win_t = (bf16_t*)(ws + WS_WIN); pa.wout_t = (bf16_t*)(ws + WS_WOUT); pa.wqkv_t = (bf16_t*)(ws + WS_WQKV); pa.wo_t = (bf16_t*)(ws + WS_WO); pa.w13_t = (bf16_t*)(ws + WS_W13); pa.w2_t = (bf16_t*)(ws + WS_W2);
        pa.ws_t = (bf16_t*)(ws + WS_WSP); pa.cosT = (float*)(ws + WS_ROPE); pa.sinT = pa.cosT + 4096 * 32;
        p0_convert(lds, pa, gw, NGW, lane, wave);
    }
    SEAM(0); ST1(0);
    ST0(1); for (int dup_ = 0; dup_ < NDUP(1); ++dup_) if (SITE(1) && IN(1)) { if (dup_) __syncthreads(); WAVE_IDS(); unsigned char* ws = KWS();
        n0_phase(KIN(0), KIN(2), DUMMY(1) ? (bf16_t*)(ws + WS_BIG) : (bf16_t*)(ws + WS_X), (const float*)(ws + WS_MOD), KIN(6), DUMMY(1) ? (bf16_t*)(ws + WS_BIG + 300 * MiB) : (bf16_t*)(ws + WS_H), gw, NGW, lane); }
    SEAM(1); ST1(1);

    for (int layer = 0; layer < DEPTH; ++layer) {
        const int pb = 2 + 8 * layer, j = layer >> 1; const bool lastl = layer == DEPTH - 1;
        const int mrows = lastl ? ML : MT;
        if ((layer & 1) == 0) {
            ST0(2); for (int dup_ = 0; dup_ < NDUP(2); ++dup_) if (SITE(2) && IN(pb + 0)) { if (dup_) __syncthreads(); WAVE_IDS(); unsigned char* ws = KWS();
                pg8::Gemm g{(const bf16_t*)(ws + WS_H), (const bf16_t*)(ws + WS_WIN) + (size_t)j * 4096 * 1024, nullptr}; pg8::GroupedOrder<16, 0> S; S.init(MT / 256, 1, G, bid);
                EpiGeluUV E{(bf16_t*)(ws + WS_BIG + BIG_U), (bf16_t*)(ws + WS_BIG + BIG_V), KIN(9) + (size_t)j * 4096, (float*)(ws + WS_STATS), lds + XCH_OFF};
                pg8::gemm_phase<EpiGeluUV, pg8::GroupedOrder<16, 0>, false, 1024, 0, 0, true, 2, (ROTK_MASK & 4) != 0>(lds, g, S, E); }
            SEAM(pb + 0); ST1(2);
            ST0(3); for (int dup_ = 0; dup_ < NDUP(3); ++dup_) if (SITE(3) && IN(pb + 1)) { if (dup_) __syncthreads(); WAVE_IDS(); unsigned char* ws = KWS();
                sm_phase(lds, (const bf16_t*)(ws + WS_BIG + BIG_U), DUMMY(3) ? (bf16_t*)(ws + WS_Y) : (bf16_t*)(ws + WS_BIG + BIG_U), (const bf16_t*)(ws + WS_BIG + BIG_V), (const float*)(ws + WS_STATS), (const bf16_t*)(ws + WS_WSP) + (size_t)j * 16 * 128 * 128,
                         KIN(12) + (size_t)j * 16 * 128 * 128, KIN(13) + (size_t)j * 16 * 128, KIN(10) + (size_t)j * 2048, KIN(11) + (size_t)j * 2048, bid, G); }
            SEAM(pb + 1); ST1(3);
            ST0(4); for (int dup_ = 0; dup_ < NDUP(4); ++dup_) if (SITE(4) && IN(pb + 2)) { if (dup_) __syncthreads(); WAVE_IDS(); unsigned char* ws = KWS();
                pg8::Gemm g{(const bf16_t*)(ws + WS_BIG + BIG_U), (const bf16_t*)(ws + WS_WOUT) + (size_t)j * 1024 * 2048, nullptr}; pg8::GroupedOrder<4, 0> S; S.init(MT / 256, 1, G, bid);
                EpiResAdd E{(const bf16_t*)(ws + WS_X), DUMMY(4) ? (bf16_t*)(ws + WS_Y) : (bf16_t*)(ws + WS_X), (const float*)(ws + WS_MOD) + (size_t)layer * 17 * 6144 + 2048, 1.0f};
                pg8::gemm_phase<EpiResAdd, pg8::GroupedOrder<4, 0>, false, 2048, 0, 0, true, 2, (ROTK_MASK & 8) != 0>(lds, g, S, E); if (dup_ == NDUP(4) - 1) STEAL_TAIL((MT / 256) * 4, 8, true); }
            SEAM(pb + 2); ST1(4);
        } else {
            ST0(5); for (int dup_ = 0; dup_ < NDUP(5); ++dup_) if (SITE(5) && IN(pb + 0)) { if (dup_) __syncthreads(); WAVE_IDS(); unsigned char* ws = KWS();
                pg8::Gemm g{(const bf16_t*)(ws + WS_H), (const bf16_t*)(ws + WS_WQKV + (size_t)j * 1536 * 1024 * (FP8_ATT ? 1 : 2)), nullptr}; pg8::GroupedOrder<6, 0> S; S.init(MT / 256, 1, G, bid);
                EpiQKV E{(bf16_t*)(ws + WS_BIG + BIG_Q), (bf16_t*)(ws + WS_BIG + BIG_K), (bf16_t*)(ws + WS_BIG + BIG_VV), (const float*)(ws + WS_ROPE), (const float*)(ws + WS_ROPE) + 4096 * 32};
                pg8::gemm_phase<EpiQKV, pg8::GroupedOrder<6, 0>, false, 1024, 0, 0, true, FP8_ATT ? 1 : 2, (ROTK_MASK & 16) != 0>(lds, g, S, E); if (dup_ == NDUP(5) - 1) STEAL_TAIL((MT / 256) * 6, 2, true); }
            SEAM(pb + 0); ST1(5);
            ST0(6); for (int dup_ = 0; dup_ < NDUP(6); ++dup_) if (SITE(6) && IN(pb + 1)) { if (dup_) __syncthreads(); WAVE_IDS(); unsigned char* ws = KWS();
                at_phase(lds, (const bf16_t*)(ws + WS_BIG + BIG_Q), (const bf16_t*)(ws + WS_BIG + BIG_K), (const bf16_t*)(ws + WS_BIG + BIG_VV), (bf16_t*)(ws + WS_BIG + BIG_O), KIN(16) + j * 16, lastl ? 2048 : 2048 + 128, bid, G); if (dup_ == NDUP(6) - 1) STEAL_TAIL(lastl ? 2048 : 2048 + 128, 5, true); }
            SEAM(pb + 1); ST1(6);
            ST0(7); for (int dup_ = 0; dup_ < NDUP(7); ++dup_) if (SITE(7) && IN(pb + 2)) { if (dup_) __syncthreads(); WAVE_IDS(); unsigned char* ws = KWS();
                pg8::Gemm g{(const bf16_t*)(ws + WS_BIG + BIG_O), (const bf16_t*)(ws + WS_WO + (size_t)j * 1024 * 1024 * (FP8_ATT ? 1 : 2)), nullptr}; pg8::GroupedOrder<4, 0> S; S.init(mrows / 256, 1, G, bid);
                EpiResAdd E{(const bf16_t*)(ws + WS_X), DUMMY(7) ? (bf16_t*)(ws + WS_Y) : (bf16_t*)(ws + WS_X), (const float*)(ws + WS_MOD) + (size_t)layer * 17 * 6144 + 2048, FP8_ATT ? 1.0f / WM_SCALE : 1.0f};
                pg8::gemm_phase<EpiResAdd, pg8::GroupedOrder<4, 0>, false, 1024, 0, 0, true, FP8_ATT ? 1 : 2, (ROTK_MASK & 32) != 0>(lds, g, S, E); if (dup_ == NDUP(7) - 1) STEAL_TAIL((mrows / 256) * 4, 1, true); }
            SEAM(pb + 2); ST1(7);
        }
        ST0(8); for (int dup_ = 0; dup_ < NDUP(8); ++dup_) if (SITE(8) && IN(pb + 3)) { if (dup_) __syncthreads(); WAVE_IDS(); unsigned char* ws = KWS();
            n2_phase(lds, mrows, (const bf16_t*)(ws + WS_X), (const float*)(ws + WS_MOD) + (size_t)layer * 17 * 6144, KIN(7) + layer * 1024, KIN(18) + (size_t)layer * 1024 * 16,
                     (bf16_t*)(ws + WS_H), (float*)(ws + WS_AFF), bid, G); }
        SEAM(pb + 3); ST1(8);
        ST0(9); for (int dup_ = 0; dup_ < NDUP(9); ++dup_) if (SITE(9) && IN(pb + 4)) { if (dup_) __syncthreads(); WAVE_IDS(); unsigned char* ws = KWS();
            const float* aff = (const float*)(ws + WS_AFF); int* rowidx = (int*)(ws + WS_ROWIDX); float* gate = (float*)(ws + WS_GATE); int* tokslot = (int*)(ws + WS_TOKSLOT);
            for (int p = bid; p < 256; p += G) { const int b = p >> 4, e = p & 15; tk_pair(lds, aff, e, b * 4096, e * SLOTS_E + b * CAPL, !lastl, ML + b * 256, e * SLOTS_E + NB * CAPL + b * CAPC, rowidx, gate, tokslot + (size_t)e * MT); }
            if (STEAL && dup_ == NDUP(9) - 1) { STEAL_ARGS(); steal_convert(lds, sq + 64 * layer, sa, layer, STEAL_NCHUNKS); }
        }
        SEAM(pb + 4); ST1(9);
        const int nMe = lastl ? 32 : 34;
        ST0(10); for (int dup_ = 0; dup_ < NDUP(10); ++dup_) if (SITE(10) && IN(pb + 5)) { if (dup_) __syncthreads(); WAVE_IDS(); unsigned char* ws = KWS();
            pg8::Gemm g{(const bf16_t*)(ws + WS_H), (const bf16_t*)(ws + WS_W13 + (size_t)layer * 16 * 4096 * 1024), (const int*)(ws + WS_ROWIDX)}; pg8::GroupedOrder<16, 34> S; S.init(nMe, 16, G, bid);
            EpiSwiGLU E{(unsigned char*)(ws + WS_BIG)};
#if ABL_E1
            { EpiSwiGLU Ed{(unsigned char*)(ws + WS_Y)}; pg8::gemm_phase<EpiSwiGLU, pg8::GroupedOrder<16, 34>, true, 1024, (size_t)4096 * 1024, 0, ALIGN_E12, 1, (ROTK_MASK & 1) != 0, (ABL_E1) & 255>(lds, g, S, Ed); __syncthreads(); }
#endif
            pg8::gemm_phase<EpiSwiGLU, pg8::GroupedOrder<16, 34>, true, 1024, (size_t)4096 * 1024, 0, ALIGN_E12, 1, (ROTK_MASK & 1) != 0>(lds, g, S, E); }
        SEAM(pb + 5); ST1(10);
        ST0(11); for (int dup_ = 0; dup_ < NDUP(11); ++dup_) if (SITE(11) && IN(pb + 6)) { if (dup_) __syncthreads(); WAVE_IDS(); unsigned char* ws = KWS();
            pg8::Gemm g{(const bf16_t*)(ws + WS_BIG), (const bf16_t*)(ws + WS_W2 + (size_t)layer * 16 * 1024 * 2048), nullptr}; pg8::GroupedOrder<4, 34, true> S; S.init(nMe, 16, G, bid);
            EpiGateY E{(unsigned char*)(ws + WS_Y), (const float*)(ws + WS_GATE)};
            pg8::gemm_phase<EpiGateY, pg8::GroupedOrder<4, 34, true>, false, 2048, (size_t)1024 * 2048, 0, ALIGN_E12, 1, (ROTK_MASK & 2) != 0>(lds, g, S, E); if (dup_ == NDUP(11) - 1) STEAL_TAIL(nMe * 4 * 16, 4, false); }
        SEAM(pb + 6); ST1(11);
        ST0(12); for (int dup_ = 0; dup_ < NDUP(12); ++dup_) if (SITE(12) && IN(pb + 7)) { if (dup_) __syncthreads(); WAVE_IDS(); unsigned char* ws = KWS();
            const float* modl = (const float*)(ws + WS_MOD) + (size_t)layer * 17 * 6144;
            if (!lastl) n1_phase(1, MT, (const bf16_t*)(ws + WS_X), DUMMY(12) ? (bf16_t*)(ws + WS_BIG) : (bf16_t*)(ws + WS_X), nullptr, (const unsigned char*)(ws + WS_Y), (const int*)(ws + WS_TOKSLOT), modl, modl + 17 * 6144, KIN(6) + (layer + 1) * 1024,
                                 DUMMY(12) ? (bf16_t*)(ws + WS_BIG + 300 * MiB) : (bf16_t*)(ws + WS_H), gw, NGW, lane, ((layer + 1) & 1) ? (FP8D_SIM & 2) != 0 : (FP8D_SIM & 1) != 0, FP8_ATT && ((layer + 1) & 1));
            else n1_phase(2, ML, (const bf16_t*)(ws + WS_X), nullptr, DUMMY(12) ? (float*)(ws + WS_BIG) : KOUT(), (const unsigned char*)(ws + WS_Y), (const int*)(ws + WS_TOKSLOT), modl, nullptr, KIN(22), nullptr, gw, NGW, lane);
        }
        SEAM(pb + 7); ST1(12);
    }
#undef IN
#undef SEAM
}

extern "C" void kernel_launch(void* const* d_in, const int* in_sizes, int n_in, void* d_out, int out_size, void* d_ws, size_t ws_size, hipStream_t stream) {
    static int grid = 0;
    if (grid == 0) {
        if (n_in != 23 || out_size != ML * D || ws_size < WS_END) { fprintf(stderr, "kernel_launch: unexpected shapes (n_in %d, out %d, ws %zu); nothing launched\n", n_in, out_size, ws_size); grid = -1; return; }
        int dev = 0, cus = 0, per_cu = 0;
        if (hipGetDevice(&dev) != hipSuccess || hipDeviceGetAttribute(&cus, hipDeviceAttributeMultiprocessorCount, dev) != hipSuccess) { grid = -1; return; }
        if (hipFuncSetAttribute((const void*)mega_fwd, hipFuncAttributeMaxDynamicSharedMemorySize, LDS_BYTES) != hipSuccess) { fprintf(stderr, "kernel_launch: hipFuncSetAttribute failed\n"); grid = -1; return; }
        if (hipOccupancyMaxActiveBlocksPerMultiprocessor(&per_cu, (const void*)mega_fwd, 512, LDS_BYTES) != hipSuccess || per_cu < 1)
            fprintf(stderr, "kernel_launch: note: occupancy query reports %d workgroups per CU\n", per_cu);
        (void)hipGetLastError();
        grid = cus;
    }
    if (grid < 0) return;
    if (hipMemsetAsync((char*)d_ws + WS_CTL, 0, CTL_ZERO_BYTES, stream) != hipSuccess) return;
    Args a{};
    for (int i = 0; i < 23; ++i) a.in[i] = (const float*)d_in[i];
    a.out = (float*)d_out; a.ws = (unsigned char*)d_ws;
    constexpr int NPH = 2 + 8 * DEPTH;
#if MK_SPLIT
    for (int p = 0; p < NPH; ++p) { a.ph_lo = p; a.ph_hi = p + 1; hipLaunchKernelGGL(mega_fwd, dim3(grid), dim3(512), LDS_BYTES, stream, a); }
#else
    a.ph_lo = 0; a.ph_hi = NPH;
    hipLaunchKernelGGL(mega_fwd, dim3(grid), dim3(512), LDS_BYTES, stream, a);
#endif
    const hipError_t le = hipPeekAtLastError();
    if (le != hipSuccess) fprintf(stderr, "kernel_launch: launch failed: %s\n", hipGetErrorName(le));
}
```
